# Optimizing an MI355X kernel written in HIP

```python
import jax, jax.numpy as jnp
from jax import lax
import numpy as np

D_MODEL = 2048
BATCH = 1
SEQ = 8192
DEPTH = 2

GRID_W = 64
N_MIXERS = 2
N_NA_LAYERS = (DEPTH + 1) // 2
N_RWKV_LAYERS = DEPTH // 2
NA_HEADS = 32
NA_HEAD_DIM = D_MODEL // NA_HEADS
NA_WIN_R = 8
NA_WIN_C = 16
NA_QBLK_C = 16
NA_BAND_C = NA_QBLK_C + NA_WIN_C
RWKV_HEAD_DIM = 64
RWKV_HEADS = D_MODEL // RWKV_HEAD_DIM
DECAY_LORA = 96
ICLR_LORA = 96
GATE_LORA = 256
GN_EPS = 64e-5
MOE_GROUPS = 4
MOE_EXPERTS_PER_GROUP = 8
MOE_TOPK = 2
MOE_D_FF = 512
RMS_EPS = 1e-6

kernel_name = "hybrid_natten_rwkv7_hmoe_encoder"


def rmsnorm(h, g):
    h32 = h.astype(jnp.float32)
    out = h32 * lax.rsqrt(jnp.mean(h32 * h32, axis=-1, keepdims=True) + RMS_EPS) * g.astype(jnp.float32)
    return out.astype(h.dtype)


def _na_column_tables():
    n_cb = GRID_W // NA_QBLK_C
    qc = np.arange(GRID_W).reshape(n_cb, NA_QBLK_C)
    band_start = np.clip(np.arange(n_cb) * NA_QBLK_C - NA_WIN_C // 2, 0, GRID_W - NA_BAND_C)
    band_cols = band_start[:, None] + np.arange(NA_BAND_C)[None, :]
    win_start = np.clip(qc - NA_WIN_C // 2, 0, GRID_W - NA_WIN_C)
    kc = band_cols[:, None, :]
    mask = (kc >= win_start[..., None]) & (kc < win_start[..., None] + NA_WIN_C)
    rel = np.clip(kc - qc[..., None], -(NA_WIN_C - 1), NA_WIN_C - 1) + (NA_WIN_C - 1)
    return band_cols, mask, rel


def neighbourhood_attention(h, w_qkv, b_qkv, rpb, w_o, b_o):
    bsz, n, d = h.shape
    rows = n // GRID_W
    wr = min(NA_WIN_R, rows)
    band_cols, col_mask, col_rel = _na_column_tables()
    n_cb = band_cols.shape[0]
    qkv = (h @ w_qkv + b_qkv).reshape(bsz, rows, GRID_W, 3, NA_HEADS, NA_HEAD_DIM)
    q = qkv[..., 0, :, :] * (NA_HEAD_DIM ** -0.5)
    k = qkv[..., 1, :, :]
    v = qkv[..., 2, :, :]
    k_band = k[:, :, band_cols]
    v_band = v[:, :, band_cols]
    q_rows = jnp.moveaxis(q.reshape(bsz, rows, n_cb, NA_QBLK_C, NA_HEADS, NA_HEAD_DIM), 1, 0)
    mask_j = jnp.asarray(col_mask)[:, :, None, :]
    rpb_cols = rpb[:, :, jnp.asarray(col_rel)]

    def one_row(args):
        r, q_r = args
        rs = jnp.clip(r - wr // 2, 0, rows - wr)
        k_r = lax.dynamic_slice_in_dim(k_band, rs, wr, axis=1)
        v_r = lax.dynamic_slice_in_dim(v_band, rs, wr, axis=1)
        s = jnp.einsum('bcqhd,brckhd->bhcqrk', q_r, k_r).astype(jnp.float32)
        row_idx = rs + jnp.arange(wr) - r + (NA_WIN_R - 1)
        bias = jnp.transpose(jnp.take(rpb_cols, row_idx, axis=1), (0, 2, 3, 1, 4))
        s = s + bias[None].astype(jnp.float32)
        s = jnp.where(mask_j[None, None], s, -jnp.inf)
        shp = s.shape
        p = jax.nn.softmax(s.reshape(shp[:4] + (wr * NA_BAND_C,)), axis=-1).reshape(shp).astype(v_r.dtype)
        o = jnp.einsum('bhcqrk,brckhd->bcqhd', p, v_r)
        return o.reshape(bsz, GRID_W, d)

    out = lax.map(one_row, (jnp.arange(rows), q_rows))
    out = jnp.moveaxis(out, 0, 1).reshape(bsz, n, d)
    return out @ w_o + b_o


def _heads(t):
    return t.reshape(t.shape[:-1] + (RWKV_HEADS, RWKV_HEAD_DIM))


def rwkv7_bidirectional(h, tm_mix, w_r, w_k, w_v, w_o, w0, w1, w2, a0, a1, a2,
                        g1, g2, k_k, k_a, r_k, lnx_w, lnx_b):
    bsz, n, d = h.shape
    f32 = jnp.float32
    h_prev = jnp.pad(h, ((0, 0), (1, 0), (0, 0)))[:, :-1]
    h_next = jnp.pad(h, ((0, 0), (0, 1), (0, 0)))[:, 1:]
    xx = 0.5 * (h_prev + h_next) - h
    xr, xw, xk, xv, xa, xg = [h + xx * tm_mix[i] for i in range(6)]
    r = xr @ w_r
    k = xk @ w_k
    v = xv @ w_v
    g = jax.nn.sigmoid(xg @ g1) @ g2
    lw = jnp.tanh(jnp.einsum('bnd,zdr->zbnr', xw, w1))
    w_log = -jax.nn.softplus(-(w0[:, None, None, :] + jnp.einsum('zbnr,zrd->zbnd', lw, w2))) - 0.5
    decay = jnp.exp(-jnp.exp(w_log.astype(f32)))
    a = jax.nn.sigmoid(a0[:, None, None, :] + jnp.einsum('zbnr,zrd->zbnd', jnp.einsum('bnd,zdr->zbnr', xa, a1), a2))
    kk = _heads((k * k_k).astype(f32))
    kk = kk / jnp.maximum(jnp.linalg.norm(kk, axis=-1, keepdims=True), 1e-12)
    k_dir = k[None] * (1.0 + (a - 1.0) * k_a)

    def shared(t):
        return jnp.moveaxis(jnp.stack([t, jnp.flip(t, axis=1)]).astype(f32), 2, 0)

    def own(t):
        return jnp.moveaxis(jnp.stack([t[0], jnp.flip(t[1], axis=1)]).astype(f32), 2, 0)

    xs = (shared(_heads(r)), own(_heads(decay)), own(_heads(k_dir)),
          shared(_heads(v)), shared(kk), own(_heads(a)))

    def step(S, inp):
        r_t, w_t, k_t, v_t, kk_t, a_t = inp
        sa = jnp.einsum('zbhvk,zbhk->zbhv', S, -kk_t)
        S = S * w_t[..., None, :] + sa[..., :, None] * (kk_t * a_t)[..., None, :] + v_t[..., :, None] * k_t[..., None, :]
        y = jnp.einsum('zbhvk,zbhk->zbhv', S, r_t)
        return S, y

    S0 = jnp.zeros((2, bsz, RWKV_HEADS, RWKV_HEAD_DIM, RWKV_HEAD_DIM), f32)
    _, ys = lax.scan(step, S0, xs)
    ys = jnp.moveaxis(ys, 0, 2)
    y = ys[0] + jnp.flip(ys[1], axis=1)
    mu = jnp.mean(y, axis=-1, keepdims=True)
    var = jnp.mean(jnp.square(y - mu), axis=-1, keepdims=True)
    yn = ((y - mu) * lax.rsqrt(var + GN_EPS)).reshape(bsz, n, d) * lnx_w + lnx_b
    bonus = jnp.sum(jnp.sum(_heads(r)[None] * _heads(k_dir) * r_k, axis=-1, keepdims=True) * _heads(v)[None], axis=0)
    out = ((yn + bonus.reshape(bsz, n, d)) * g) @ w_o
    return out.astype(h.dtype)


def hierarchical_moe(h, w_rg, b_rg, w_re, b_re, w_gate, w_up, w_down):
    bsz, n, d = h.shape
    xt = h.reshape(-1, d)
    g_prob = jax.nn.softmax((xt @ w_rg + b_rg).astype(jnp.float32), axis=-1)
    g_w, g_idx = lax.top_k(g_prob, 1)
    e_logits = (jnp.einsum('td,gde->tge', xt, w_re) + b_re).astype(jnp.float32)
    e_sel = jnp.take_along_axis(e_logits, g_idx[:, :, None], axis=1)[:, 0]
    e_w, e_idx = lax.top_k(jax.nn.softmax(e_sel, axis=-1), MOE_TOPK)
    e_w = e_w / jnp.sum(e_w, axis=-1, keepdims=True)
    e_comb = jnp.sum(jax.nn.one_hot(e_idx, MOE_EXPERTS_PER_GROUP, dtype=jnp.float32) * e_w[..., None], axis=1)
    comb = (jax.nn.one_hot(g_idx[:, 0], MOE_GROUPS, dtype=jnp.float32)[:, :, None] * e_comb[:, None, :]
            * g_w[:, :, None]).astype(h.dtype)
    out = jnp.zeros_like(xt)
    for gi in range(MOE_GROUPS):
        hg = jnp.einsum('td,edf->etf', xt, w_gate[gi])
        hu = jnp.einsum('td,edf->etf', xt, w_up[gi])
        act = jax.nn.silu(hg) * hu * comb[:, gi, :].T[:, :, None]
        out = out + jnp.einsum('etf,efd->td', act, w_down[gi])
    return out.reshape(bsz, n, d)


def setup_inputs(seed: int = 0) -> dict:
    key = jax.random.key(seed)
    keys = iter(jax.random.split(key, 48))
    f32 = jnp.float32
    D = D_MODEL

    def nrm(shape, scale):
        return jax.random.normal(next(keys), shape, f32) * scale

    def unif(shape, lo, hi):
        return jax.random.uniform(next(keys), shape, f32, lo, hi)

    G, E, F = MOE_GROUPS, MOE_EXPERTS_PER_GROUP, MOE_D_FF
    return {
        "x": nrm((BATCH, SEQ, D), 1.0),
        "ln1_g": 1.0 + nrm((DEPTH, D), 0.02),
        "ln2_g": 1.0 + nrm((DEPTH, D), 0.02),
        "lnf_g": 1.0 + nrm((D,), 0.02),
        "na_w_qkv": nrm((N_NA_LAYERS, D, 3 * D), D ** -0.5),
        "na_b_qkv": nrm((N_NA_LAYERS, 3 * D), 0.02),
        "na_rpb": nrm((N_NA_LAYERS, NA_HEADS, 2 * NA_WIN_R - 1, 2 * NA_WIN_C - 1), 0.02),
        "na_w_o": nrm((N_NA_LAYERS, D, D), D ** -0.5),
        "na_b_o": nrm((N_NA_LAYERS, D), 0.02),
        "rw_mix": unif((N_RWKV_LAYERS, 6, D), 0.0, 1.0),
        "rw_w_r": nrm((N_RWKV_LAYERS, D, D), D ** -0.5),
        "rw_w_k": nrm((N_RWKV_LAYERS, D, D), D ** -0.5),
        "rw_w_v": nrm((N_RWKV_LAYERS, D, D), D ** -0.5),
        "rw_w_o": nrm((N_RWKV_LAYERS, D, D), D ** -0.5),
        "rw_w0": unif((N_RWKV_LAYERS, 2, D), -6.0, -1.0),
        "rw_w1": nrm((N_RWKV_LAYERS, 2, D, DECAY_LORA), D ** -0.5),
        "rw_w2": nrm((N_RWKV_LAYERS, 2, DECAY_LORA, D), 0.1 * DECAY_LORA ** -0.5),
        "rw_a0": nrm((N_RWKV_LAYERS, 2, D), 0.5),
        "rw_a1": nrm((N_RWKV_LAYERS, 2, D, ICLR_LORA), D ** -0.5),
        "rw_a2": nrm((N_RWKV_LAYERS, 2, ICLR_LORA, D), 0.1 * ICLR_LORA ** -0.5),
        "rw_g1": nrm((N_RWKV_LAYERS, D, GATE_LORA), D ** -0.5),
        "rw_g2": nrm((N_RWKV_LAYERS, GATE_LORA, D), GATE_LORA ** -0.5),
        "rw_k_k": 0.85 + nrm((N_RWKV_LAYERS, D), 0.05),
        "rw_k_a": 1.0 + nrm((N_RWKV_LAYERS, D), 0.05),
        "rw_r_k": nrm((N_RWKV_LAYERS, RWKV_HEADS, RWKV_HEAD_DIM), 0.1),
        "rw_lnx_w": 1.0 + nrm((N_RWKV_LAYERS, D), 0.02),
        "rw_lnx_b": nrm((N_RWKV_LAYERS, D), 0.02),
        "moe_w_rg": nrm((DEPTH, D, G), D ** -0.5),
        "moe_b_rg": nrm((DEPTH, G), 0.01),
        "moe_w_re": nrm((DEPTH, G, D, E), D ** -0.5),
        "moe_b_re": nrm((DEPTH, G, E), 0.01),
        "moe_w_gate": nrm((DEPTH, G, E, D, F), D ** -0.5),
        "moe_w_up": nrm((DEPTH, G, E, D, F), D ** -0.5),
        "moe_w_down": nrm((DEPTH, G, E, F, D), F ** -0.5),
    }


def reference(x, ln1_g, ln2_g, lnf_g, na_w_qkv, na_b_qkv, na_rpb, na_w_o, na_b_o,
              rw_mix, rw_w_r, rw_w_k, rw_w_v, rw_w_o, rw_w0, rw_w1, rw_w2, rw_a0, rw_a1, rw_a2,
              rw_g1, rw_g2, rw_k_k, rw_k_a, rw_r_k, rw_lnx_w, rw_lnx_b,
              moe_w_rg, moe_b_rg, moe_w_re, moe_b_re, moe_w_gate, moe_w_up, moe_w_down):
    h = x
    for i in range(DEPTH):
        j = i // N_MIXERS
        hn = rmsnorm(h, ln1_g[i])
        if i % N_MIXERS == 0:
            mix = neighbourhood_attention(hn, na_w_qkv[j], na_b_qkv[j], na_rpb[j], na_w_o[j], na_b_o[j])
        else:
            mix = rwkv7_bidirectional(hn, rw_mix[j], rw_w_r[j], rw_w_k[j], rw_w_v[j], rw_w_o[j],
                                      rw_w0[j], rw_w1[j], rw_w2[j], rw_a0[j], rw_a1[j], rw_a2[j],
                                      rw_g1[j], rw_g2[j], rw_k_k[j], rw_k_a[j], rw_r_k[j],
                                      rw_lnx_w[j], rw_lnx_b[j])
        h = h + mix
        h = h + hierarchical_moe(rmsnorm(h, ln2_g[i]), moe_w_rg[i], moe_b_rg[i], moe_w_re[i], moe_b_re[i],
                                 moe_w_gate[i], moe_w_up[i], moe_w_down[i])
    return rmsnorm(h, lnf_g)
```

```cpp
#include <hip/hip_runtime.h>
#include <cstdint>
#include <cstdio>

#define LAS __attribute__((address_space(3)))
typedef unsigned short bf16_t;
typedef short bf16x8 __attribute__((ext_vector_type(8)));
typedef float f32x4 __attribute__((ext_vector_type(4)));
typedef float f32x16 __attribute__((ext_vector_type(16)));
typedef unsigned u32x4 __attribute__((ext_vector_type(4)));
typedef unsigned u32x2 __attribute__((ext_vector_type(2)));

constexpr int T = 8192, D = 2048, NH = 32, HD = 64, GW = 64, ROWS = 128;
constexpr int NEXP = 32, FF = 512;
constexpr int NTHR = 512;
#ifndef MK_FUSED
#define MK_FUSED 1
#endif

constexpr size_t MiB = 1u << 20;
constexpr size_t WS_CTL = 0;
constexpr size_t WS_LIST = 1 * MiB;
constexpr size_t WS_CW = 3 * MiB;
constexpr size_t WS_RGF = 3 * MiB + 256 * 1024;
constexpr size_t WS_REF = 3 * MiB + 384 * 1024;
constexpr size_t WS_WQKV = 4 * MiB;
constexpr size_t WS_WONA = 28 * MiB;
constexpr size_t WS_WR = 36 * MiB, WS_WK = 44 * MiB, WS_WV = 52 * MiB, WS_WORW = 60 * MiB;
constexpr size_t WS_W1T = 68 * MiB, WS_A1T = 69 * MiB, WS_G1T = 70 * MiB;
constexpr size_t WS_W2T = 71 * MiB, WS_A2T = 72 * MiB;
constexpr size_t WS_G2T = 73 * MiB;
constexpr size_t WS_GB = 74 * MiB;
constexpr size_t WS_FB = 138 * MiB;
constexpr size_t WS_GYB = 330 * MiB;
constexpr size_t WS_HS = 394 * MiB;
constexpr size_t WS_HB = 458 * MiB;
constexpr size_t WS_HN = 522 * MiB;
constexpr size_t WS_SBON = 522 * MiB;
constexpr size_t WS_ACT = 554 * MiB;
constexpr size_t WS_ACT1 = 666 * MiB;
constexpr size_t WS_Y = 570 * MiB;
constexpr size_t WS_Z = 570 * MiB;
constexpr size_t WS_FYB = 602 * MiB;
constexpr size_t WS_Q = 634 * MiB, WS_K = 666 * MiB, WS_VT = 698 * MiB, WS_AO = 730 * MiB;
constexpr size_t WS_MIX = 698 * MiB;
constexpr size_t WS_G = 698 * MiB;
constexpr size_t WS_R = 890 * MiB, WS_K2 = 922 * MiB, WS_V2 = 954 * MiB;
constexpr size_t WS_LW = 986 * MiB, WS_LA = 990 * MiB, WS_GL = 994 * MiB;
constexpr size_t WS_END = 998 * MiB;

constexpr int CW_BAR = 4096;
constexpr int CW_CNT0 = 16384, CW_CNT1 = 16384 + 64;
constexpr int CW_MOEQ = 20480;
constexpr int CW_MOEMT = 24576;

constexpr int LDS_MISC = 159744;
constexpr int LDS_PREF = LDS_MISC;
constexpr int LDS_XB = LDS_MISC + 256;
constexpr int LDS_SEG = LDS_MISC + 512;
constexpr int LDS_ELEND = LDS_MISC + 1024;
constexpr int LDS_TILE_E = LDS_MISC + 2048;
constexpr int LDS_MOEQ = LDS_MISC + 3072;
constexpr int LDS_TILE_NV = LDS_MISC + 2560;
constexpr int LDS_TILE_LO = LDS_MISC + 3200;
constexpr int LDS_BYTES = 163840;

struct Params {
    const float* in[34];
    float* out;
    unsigned char* ws;
};
typedef const __attribute__((address_space(4))) Params CPar;

typedef float f32x2_t __attribute__((ext_vector_type(2)));
typedef __bf16 bf16x2_t __attribute__((ext_vector_type(2)));
__device__ __forceinline__ unsigned pk2(float lo, float hi) { const f32x2_t v = {lo, hi}; return __builtin_bit_cast(unsigned, __builtin_convertvector(v, bf16x2_t)); }
__device__ __forceinline__ unsigned f2bf(float f) { return pk2(f, 0.f) & 0xffffu; }
__device__ __forceinline__ float bflo(unsigned u) { return __builtin_bit_cast(float, u << 16); }
__device__ __forceinline__ float bfhi(unsigned u) { return __builtin_bit_cast(float, u & 0xffff0000u); }
__device__ __forceinline__ float bf2f(bf16_t b) { return __builtin_bit_cast(float, (unsigned)b << 16); }
__device__ __forceinline__ void lds_barrier() { asm volatile("s_waitcnt lgkmcnt(0)" ::: "memory"); __builtin_amdgcn_s_barrier(); asm volatile("" ::: "memory"); }
__device__ __forceinline__ float wave_sum(float v) {
#pragma unroll
    for (int o = 32; o; o >>= 1) v += __shfl_xor(v, o);
    return v;
}
__device__ __forceinline__ int otid() { int t = threadIdx.x; asm volatile("" : "+v"(t)); return t; }
__device__ __forceinline__ float tanhf_(float x) { return 1.f - 2.f * __builtin_amdgcn_rcpf(1.f + __expf(2.f * x)); }
__device__ __forceinline__ float sigmoidf_(float x) { return __builtin_amdgcn_rcpf(1.f + __expf(-x)); }

#define XB_TMO      128
#define XB_XCNT(j)  (256  + 64 * (j))
#define XB_XSUB(j)  (1280 + 64 * (j))
#define XB_XGEN(j)  (2304 + 64 * (j))
#define XB_TOP      3328
#define XB_TOPGEN   3392
#define XCD_BAR_WORDS 3456
#define XB_SPIN_CAP (1u << 18)
__device__ __forceinline__ unsigned xb_ld(unsigned* p)              { return __hip_atomic_load(p, __ATOMIC_RELAXED, __HIP_MEMORY_SCOPE_AGENT); }
__device__ __forceinline__ unsigned xb_add(unsigned* p, unsigned v) { return __hip_atomic_fetch_add(p, v, __ATOMIC_RELAXED, __HIP_MEMORY_SCOPE_AGENT); }
__device__ __forceinline__ unsigned xb_xcc_id() { return (unsigned)__builtin_amdgcn_s_getreg((3 << 11) | 20) & 0xFu; }
#define XB_SPIN(cond, bar) do { unsigned _sp = 0; while (cond) { __builtin_amdgcn_s_sleep(1); \
    if ((++_sp & 255u) == 0u) { if (xb_ld(&(bar)[XB_TMO])) break; if (_sp > XB_SPIN_CAP) { atomicAdd(&(bar)[XB_TMO], 1u); break; } } } } while (0)
struct XcdBarrier { unsigned* bar; unsigned x; volatile LAS unsigned* st; };
__device__ __forceinline__ XcdBarrier xcd_barrier_post(unsigned* bar, volatile LAS unsigned* st) {
    XcdBarrier b; b.bar = bar; b.x = xb_xcc_id(); b.st = st;
    if (threadIdx.x == 0) (void)xb_add(&bar[XB_XCNT(b.x)], 1u);
    return b;
}
__device__ __forceinline__ void xcd_barrier_complete(unsigned* bar, unsigned x, unsigned& nloc, unsigned& nx) {
    const unsigned G = gridDim.x * gridDim.y * gridDim.z;
    unsigned sum, cnt, mine, sp = 0u;
    for (;;) {
        sum = 0u; cnt = 0u; mine = 0u;
#pragma unroll
        for (unsigned j = 0; j < 16; ++j) { const unsigned c = xb_ld(&bar[XB_XCNT(j)]); sum += c; cnt += (c > 0u) ? 1u : 0u; mine = (j == x) ? c : mine; }
        if (sum == G) break;
        __builtin_amdgcn_s_sleep(1);
        if ((++sp & 255u) == 0u) { if (xb_ld(&bar[XB_TMO])) break; if (sp > XB_SPIN_CAP) { atomicAdd(&bar[XB_TMO], 1u); break; } }
    }
    nloc = mine > 0u ? mine : 1u; nx = cnt > 0u ? cnt : 1u;
}
__device__ __forceinline__ void xcd_barrier(const XcdBarrier& b) {
    asm volatile("s_waitcnt vmcnt(0)" ::: "memory");
    __syncthreads();
    if (threadIdx.x == 0) {
        unsigned* bar = b.bar;
        __builtin_amdgcn_s_waitcnt(0);
        unsigned nloc = b.st[0], nx = b.st[1];
        if (nloc == 0u) { xcd_barrier_complete(bar, b.x, nloc, nx); b.st[0] = nloc; b.st[1] = nx; }
        const unsigned old = xb_add(&bar[XB_XSUB(b.x)], 1u);
        const unsigned gen = old / nloc;
        if (old + 1u == (gen + 1u) * nloc) {
            __builtin_amdgcn_fence(__ATOMIC_RELEASE, "agent");
            asm volatile("s_waitcnt vmcnt(0)" ::: "memory");
            const unsigned og = xb_add(&bar[XB_TOP], 1u);
            const unsigned tg = og / nx;
            if (og + 1u == (tg + 1u) * nx) xb_add(&bar[XB_TOPGEN], 1u);
            else XB_SPIN(xb_ld(&bar[XB_TOPGEN]) == tg, bar);
            __builtin_amdgcn_fence(__ATOMIC_ACQUIRE, "agent");
            xb_add(&bar[XB_XGEN(b.x)], 1u);
            asm volatile("s_waitcnt vmcnt(0)" ::: "memory");
        } else {
            XB_SPIN(xb_ld(&bar[XB_XGEN(b.x)]) == gen, bar);
            __builtin_amdgcn_fence(__ATOMIC_ACQUIRE, "agent");
            asm volatile("s_waitcnt vmcnt(0)" ::: "memory");
        }
    }
    __syncthreads();
}

template <class Epi>
__device__ __forceinline__ void gemm_tile_moe(const int tid, LAS char* lds, const bf16_t* __restrict__ A, int lda, const int* __restrict__ rows, int nvalid, int rshift,
                                              const float* __restrict__ bsrc, int ldn, int K, const Epi& epi) {
    const int lane = tid & 63, wid = tid >> 6, wm = wid >> 1, wn = wid & 1;
    const int srow = tid >> 3, sch = tid & 7;
    unsigned offA[4];
#pragma unroll
    for (int i = 0; i < 4; ++i) {
        const int r = srow + i * 64;
        const int rr = r < nvalid ? r : 0;
        offA[i] = (unsigned)(rows[rr] >> rshift) * (unsigned)lda + sch * 8;
    }
#define MOE_KEY(r_) ((((r_) >> 2) & 7) ^ ((((r_) >> 1) & 1) << 2))
    const unsigned ldsw = srow * 128 + ((sch ^ MOE_KEY(srow)) << 4);
    const int nq = tid & 31, kq = tid >> 5;
    unsigned ldsb[4];
#pragma unroll
    for (int c = 0; c < 4; ++c) { const int rho = nq * 4 + c; ldsb[c] = 32768u + rho * 128 + ((((kq >> 1)) ^ MOE_KEY(rho)) << 4) + (kq & 1) * 8; }
    const float* bp = bsrc + (size_t)(kq * 4) * ldn;
    const int l31 = lane & 31, lh = lane >> 5, key = MOE_KEY(l31);
    const unsigned ra = (wm * 64 + l31) * 128;
    const unsigned rb = 32768 + (wn * 64 + l31) * 128;
    unsigned kc[4];
#pragma unroll
    for (int ks = 0; ks < 4; ++ks) kc[ks] = ((ks * 2 + lh) ^ key) << 4;
    f32x16 acc[2][2];
#pragma unroll
    for (int mi = 0; mi < 2; ++mi)
#pragma unroll
        for (int nj = 0; nj < 2; ++nj)
#pragma unroll
            for (int e = 0; e < 16; ++e) acc[mi][nj][e] = 0.f;
    u32x4 xa[4], ya[4]; f32x4 xb[4], yb[4];
    const int nt = K >> 6;
#define MOE_LOAD(ra_, rb_, tt) do { _Pragma("unroll") for (int i = 0; i < 4; ++i) { ra_[i] = *(const u32x4*)(A + offA[i] + (tt) * 64); rb_[i] = *(const f32x4*)(bp + (size_t)((tt) * 64 + i) * ldn); } } while (0)
#define MOE_STORE(ra_, rb_, so_) do { _Pragma("unroll") for (int i = 0; i < 4; ++i) *(LAS u32x4*)(lds + (so_) + ldsw + i * 8192) = ra_[i]; \
        _Pragma("unroll") for (int c = 0; c < 4; ++c) { u32x2 o; o.x = pk2(rb_[0][c], rb_[1][c]); o.y = pk2(rb_[2][c], rb_[3][c]); *(LAS u32x2*)(lds + (so_) + ldsb[c]) = o; } } while (0)
#define MOE_FRAGS(so_, ks, AF, BQ) do { _Pragma("unroll") for (int mi = 0; mi < 2; ++mi) AF[mi] = *(const LAS bf16x8*)(lds + (so_) + ra + mi * 4096 + kc[ks]); \
        _Pragma("unroll") for (int nj = 0; nj < 2; ++nj) BQ[nj] = *(const LAS bf16x8*)(lds + (so_) + rb + nj * 4096 + kc[ks]); } while (0)
#define MOE_MMA(AF, BQ) do { _Pragma("unroll") for (int mi = 0; mi < 2; ++mi) _Pragma("unroll") for (int nj = 0; nj < 2; ++nj) \
        acc[mi][nj] = __builtin_amdgcn_mfma_f32_32x32x16_bf16(BQ[nj], AF[mi], acc[mi][nj], 0, 0, 0); } while (0)
#define MOE_SB __builtin_amdgcn_sched_barrier(0)
#define MOE_COMPUTE(so_) do { bf16x8 afA[2], bqA[2], afB[2], bqB[2]; \
        MOE_FRAGS(so_, 0, afA, bqA); MOE_FRAGS(so_, 1, afB, bqB); MOE_SB; MOE_MMA(afA, bqA); MOE_SB; \
        MOE_FRAGS(so_, 2, afA, bqA); MOE_SB; MOE_MMA(afB, bqB); MOE_SB; \
        MOE_FRAGS(so_, 3, afB, bqB); MOE_SB; MOE_MMA(afA, bqA); MOE_SB; MOE_MMA(afB, bqB); } while (0)
#define MOE_STEP(tt, SA_, SB_, LA_, LB_) do { \
        if ((tt) + 2 < nt) MOE_LOAD(LA_, LB_, (tt) + 2); \
        __builtin_amdgcn_sched_barrier(0); \
        MOE_COMPUTE(((tt) & 1) * 49152u); \
        __builtin_amdgcn_sched_barrier(0); \
        if ((tt) + 1 < nt) MOE_STORE(SA_, SB_, (((tt) + 1) & 1) * 49152u); \
        __syncthreads(); } while (0)
    MOE_LOAD(xa, xb, 0);
    MOE_STORE(xa, xb, 0u);
    if (nt > 1) MOE_LOAD(xa, xb, 1);
    __syncthreads();
    for (int t = 0; t < nt; t += 8) {
        MOE_STEP(t, xa, xb, ya, yb); MOE_STEP(t + 1, ya, yb, xa, xb); MOE_STEP(t + 2, xa, xb, ya, yb); MOE_STEP(t + 3, ya, yb, xa, xb);
        MOE_STEP(t + 4, xa, xb, ya, yb); MOE_STEP(t + 5, ya, yb, xa, xb); MOE_STEP(t + 6, xa, xb, ya, yb); MOE_STEP(t + 7, ya, yb, xa, xb);
    }
#undef MOE_STEP
#undef MOE_COMPUTE
#undef MOE_FRAGS
#undef MOE_MMA
#undef MOE_SB
#undef MOE_LOAD
#undef MOE_STORE
#undef MOE_KEY
    epi(acc, wm, wn, l31, lh);
}

struct EpiMoeGU2 {
    bf16_t* act; const float* cw; const int* rows; int nvalid; int f0; LAS char* lds; int tid;
    __device__ __forceinline__ void operator()(const f32x16 (&acc)[2][2], int wm, int wn, int l31, int lh) const {
#pragma unroll
        for (int mi = 0; mi < 2; ++mi) {
            const int ml = wm * 64 + mi * 32 + l31;
            const float w = ml < nvalid ? cw[rows[ml]] : 0.f;
#pragma unroll
            for (int rg = 0; rg < 4; ++rg) {
                float o[4];
#pragma unroll
                for (int e = 0; e < 4; ++e) { const float g = acc[mi][0][4 * rg + e], u = acc[mi][1][4 * rg + e]; o[e] = g * sigmoidf_(g) * u * w; }
                u32x2 ov; ov.x = pk2(o[0], o[1]); ov.y = pk2(o[2], o[3]);
                *(LAS u32x2*)(lds + ml * 144 + (wn * 32 + 8 * rg + 4 * lh) * 2) = ov;
            }
        }
        __syncthreads();
#pragma unroll
        for (int i = 0; i < 4; ++i) {
            const int row = (tid >> 3) + 64 * i, pc = tid & 7;
            if (row < nvalid) {
                const u32x4 v = *(const LAS u32x4*)(lds + row * 144 + pc * 16);
                *(u32x4*)(act + (size_t)rows[row] * FF + f0 + pc * 8) = v;
            }
        }
        __syncthreads();
    }
};
typedef __attribute__((address_space(1))) unsigned gu32;
struct EpiMoeGU3 {
    bf16_t* act; const float* cw; const int* rows; int nvalid; int f0; LAS char* lds; int tid; gu32* mtc;
    template <class H> __device__ __forceinline__ void operator()(const f32x16 (&acc)[2][2], int wm, int wn, int l31, int lh, const H& hook) const {
#pragma unroll
        for (int mi = 0; mi < 2; ++mi) {
            const int ml = wm * 64 + mi * 32 + l31;
            const float w = ml < nvalid ? cw[rows[ml]] : 0.f;
#pragma unroll
            for (int rg = 0; rg < 4; ++rg) {
                float o[4];
#pragma unroll
                for (int e = 0; e < 4; ++e) { const float g = acc[mi][0][4 * rg + e], u = acc[mi][1][4 * rg + e]; o[e] = g * sigmoidf_(g) * u * w; }
                u32x2 ov; ov.x = pk2(o[0], o[1]); ov.y = pk2(o[2], o[3]);
                *(LAS u32x2*)(lds + ml * 144 + (wn * 32 + 8 * rg + 4 * lh) * 2) = ov;
            }
        }
        __syncthreads();
        const __amdgpu_buffer_rsrc_t rs = __builtin_amdgcn_make_buffer_rsrc((void*)act, 0, 2 * T * FF * 2, 0x00020000);
#pragma unroll
        for (int i = 0; i < 4; ++i) {
            const int row = (tid >> 3) + 64 * i, pc = tid & 7;
            if (row < nvalid) {
                const u32x4 v = *(const LAS u32x4*)(lds + row * 144 + pc * 16);
                __builtin_amdgcn_raw_buffer_store_b128(v, rs, (rows[row] * FF + f0 + pc * 8) * 2, 0,   16);
            }
        }
        asm volatile("" ::: "memory");
        if (hook()) asm volatile("s_waitcnt vmcnt(16)" ::: "memory");
        else asm volatile("s_waitcnt vmcnt(0)" ::: "memory");
        if ((tid & 63) == 0) (void)__hip_atomic_fetch_add(mtc, 1u, __ATOMIC_RELAXED, __HIP_MEMORY_SCOPE_AGENT);
        __syncthreads();
    }
};
struct EpiMoeD2 {
    bf16_t* y; const int* rows; int nvalid; int n0; LAS char* lds; int tid;
    __device__ __forceinline__ void operator()(const f32x16 (&acc)[2][2], int wm, int wn, int l31, int lh) const { (*this)(acc, wm, wn, l31, lh, [] { return 0; }); }
    template <class H> __device__ __forceinline__ void operator()(const f32x16 (&acc)[2][2], int wm, int wn, int l31, int lh, const H& hook) const {
#pragma unroll
        for (int mi = 0; mi < 2; ++mi) {
            const int ml = wm * 64 + mi * 32 + l31;
#pragma unroll
            for (int nj = 0; nj < 2; ++nj)
#pragma unroll
                for (int rg = 0; rg < 4; ++rg) {
                    u32x2 o; o.x = pk2(acc[mi][nj][4 * rg], acc[mi][nj][4 * rg + 1]); o.y = pk2(acc[mi][nj][4 * rg + 2], acc[mi][nj][4 * rg + 3]);
                    *(LAS u32x2*)(lds + ml * 272 + (wn * 64 + nj * 32 + 8 * rg + 4 * lh) * 2) = o;
                }
        }
        __syncthreads();
        (void)hook();
#pragma unroll
        for (int i = 0; i < 8; ++i) {
            const int row = (tid >> 4) + 32 * i, pc = tid & 15;
            if (row < nvalid) {
                const u32x4 v = *(const LAS u32x4*)(lds + row * 272 + pc * 16);
                *(u32x4*)(y + (size_t)rows[row] * D + n0 + pc * 8) = v;
            }
        }
        __syncthreads();
    }
};
namespace pg8 {
#define PG8_LAS __attribute__((address_space(3)))
typedef unsigned short bf16_t;
typedef short bf16x8 __attribute__((ext_vector_type(8)));
typedef float f32x4 __attribute__((ext_vector_type(4)));
typedef unsigned u32x4 __attribute__((ext_vector_type(4)));
constexpr int BM = 256, BK = 64, HALF = 128, HTB = HALF * BK * 2  , STAGE_BYTES = 8 * HTB, NXCD = 8, WGM = 8;

__host__ __device__ __forceinline__ int lds_byte(int r, int c) { const int st = (r >> 4) * 2 + (c >> 5), rr = r & 15, cc = c & 31, ob = rr * 64 + cc * 2; return st * 1024 + (ob ^ (((ob >> 9) & 1) << 5)); }
__host__ __device__ __forceinline__ void stage_rc(int b, int& R, int& C) { const int st = b / 1024, sb = b % 1024, swz = sb ^ (((sb >> 9) & 1) << 5); R = (st >> 1) * 16 + swz / 64; C = (st & 1) * 32 + (swz % 64) / 2; }
__host__ __device__ __forceinline__ int perm32(int rho) { const int n = rho >> 4, i = rho & 15; return 8 * (i >> 2) + 4 * n + (i & 3); }

struct Unit { int pm, pn; };
struct Gemm { const bf16_t* A; const bf16_t* Bt; int M, N, K; };

struct StaticOrder {
    int nM, nN, nwg, G, c;
    __host__ __device__ void init(int M, int N, int G_, int c_) { nM = M / BM; nN = N / BM; nwg = nM * nN; G = G_; c = c_; }
    __host__ __device__ bool next(int i, Unit& u) const {
        const long L = (long)i * G + c; if (L >= nwg) return false;
        int wgid = (int)L; { const int q = nwg / NXCD, r = nwg % NXCD, xcd = wgid % NXCD, off = wgid / NXCD; wgid = (xcd < r ? xcd * (q + 1) : r * (q + 1) + (xcd - r) * q) + off; }
        const int nig = WGM * nN, gid = wgid / nig, fm = gid * WGM, gsz = (nM - fm) < WGM ? (nM - fm) : WGM;
        u.pm = fm + ((wgid % nig) % gsz); u.pn = (wgid % nig) / gsz; return true;
    }
    __device__ __forceinline__ void a_ready(const Unit&) const {}
    __device__ __forceinline__ void done(const Unit&) const {}
};

__device__ __forceinline__ unsigned cvt_pk_bf16(float lo, float hi) { unsigned r; asm volatile("v_cvt_pk_bf16_f32 %0, %1, %2" : "=v"(r) : "v"(lo), "v"(hi)); return r; }

template <class Epi, class Sched, bool ALIGN_EPI = false, bool SP2 = false>
__device__ __forceinline__ void gemm_phase(const int tid, PG8_LAS unsigned char* lds, const Gemm g, const Sched& S, const Epi& E) {
    const int wid = __builtin_amdgcn_readfirstlane(tid >> 6), lane = tid & 63, wr = wid >> 2, wc = wid & 3, fr = lane & 15, fq = lane >> 4;
    const int K = g.K, nt = K / BK;
    unsigned voffA[2], voffB[2];
#pragma unroll
    for (int i = 0; i < 2; ++i) { int R, C; stage_rc(tid * 16 + i * 8192, R, C); const int Rb = Epi::PERM ? ((R & ~31) + perm32(R & 31)) : R;
        voffA[i] = (unsigned)(R * K + C) * 2u; voffB[i] = (unsigned)(Rb * K + C) * 2u; }
    const size_t kstep = (size_t)(BK * 2);
    const size_t hstep = (size_t)HALF * K * 2;
    const size_t tstep = 2 * hstep;
    const unsigned ldsw = (unsigned)wid * 1024u;
    const int aoff = lds_byte(wr * 64 + fr, fq * 8), boff = lds_byte(wc * 32 + fr, fq * 8);
#define PG8_SA(b, h) (((b) * 2 + (h)) * HTB)
#define PG8_SB(b, h) ((4 + (b) * 2 + (h)) * HTB)
#define PG8_STAGE(bufoff, gbase, voff) do { _Pragma("unroll") for (int _i = 0; _i < 2; ++_i) \
        __builtin_amdgcn_global_load_lds((const unsigned*)((const char*)(gbase) + (voff)[_i]), (PG8_LAS unsigned*)(lds + (bufoff) + ldsw + _i * 8192), 16, 0, 0); } while (0)
#define PG8_LDA(dst, b, h) do { _Pragma("unroll") for (int m = 0; m < 4; ++m) _Pragma("unroll") for (int k = 0; k < 2; ++k) dst[m][k] = *(const PG8_LAS bf16x8*)(lds + PG8_SA(b, h) + aoff + m * 2048 + k * 1024); } while (0)
#define PG8_LDB(dst, b, h) do { _Pragma("unroll") for (int n = 0; n < 2; ++n) _Pragma("unroll") for (int k = 0; k < 2; ++k) dst[n][k] = *(const PG8_LAS bf16x8*)(lds + PG8_SB(b, h) + boff + n * 2048 + k * 1024); } while (0)
#define PG8_MMA(ai, bj, At, Bt) do { __builtin_amdgcn_s_setprio(1); _Pragma("unroll") for (int m = 0; m < 4; ++m) _Pragma("unroll") for (int n = 0; n < 2; ++n) _Pragma("unroll") for (int k = 0; k < 2; ++k) \
        acc[ai][bj][m][n] = __builtin_amdgcn_mfma_f32_16x16x32_bf16(Bt[n][k], At[m][k], acc[ai][bj][m][n], 0, 0, 0); __builtin_amdgcn_s_setprio(0); } while (0)
#define PG8_WAIT_V(n) asm volatile("s_waitcnt vmcnt(" #n ")" ::: "memory")
#define PG8_WAIT_L(n) asm volatile("s_waitcnt lgkmcnt(" #n ")" ::: "memory")
#define PG8_BAR __builtin_amdgcn_s_barrier()
#define PG8_SCHED __builtin_amdgcn_sched_barrier(0)
    Unit cur, nxt; int ui = 0;
    if (!S.next(0, cur)) return;
    f32x4 acc[2][2][4][2];
#pragma unroll
    for (int a = 0; a < 2; ++a)
#pragma unroll
        for (int b = 0; b < 2; ++b)
#pragma unroll
            for (int m = 0; m < 4; ++m)
#pragma unroll
                for (int n = 0; n < 2; ++n) acc[a][b][m][n] = (f32x4){0.f, 0.f, 0.f, 0.f};
    bf16x8 At[4][2], B0[2][2], B1[2][2];
    const char* cA = (const char*)g.A + (size_t)cur.pm * tstep; const char* cB = (const char*)g.Bt + (size_t)cur.pn * tstep;
    S.a_ready(cur);
    if constexpr (SP2) {
        PG8_STAGE(PG8_SB(0, 0), cB, voffB); PG8_STAGE(PG8_SB(0, 1), cB + hstep, voffB); PG8_STAGE(PG8_SA(0, 0), cA, voffA); PG8_STAGE(PG8_SA(0, 1), cA + hstep, voffA);
        if (wr == 1) PG8_BAR;
        PG8_WAIT_V(2); PG8_BAR;
        PG8_STAGE(PG8_SB(1, 0), cB + kstep, voffB); PG8_STAGE(PG8_SA(1, 0), cA + kstep, voffA); PG8_STAGE(PG8_SB(1, 1), cB + hstep + kstep, voffB);
        PG8_WAIT_V(6); PG8_BAR;
    } else {
        PG8_STAGE(PG8_SB(0, 0), cB, voffB); PG8_STAGE(PG8_SA(0, 0), cA, voffA); PG8_STAGE(PG8_SB(0, 1), cB + hstep, voffB); PG8_STAGE(PG8_SA(0, 1), cA + hstep, voffA);
        if (wr == 1) PG8_BAR;
        PG8_WAIT_V(4); PG8_BAR;
        PG8_STAGE(PG8_SB(1, 0), cB + kstep, voffB); PG8_STAGE(PG8_SA(1, 0), cA + kstep, voffA); PG8_STAGE(PG8_SB(1, 1), cB + hstep + kstep, voffB);
        PG8_WAIT_V(6); PG8_BAR;
    }
    for (;;) {
        const bool has_next = S.next(ui + 1, nxt);
        const char* nA = has_next ? (const char*)g.A + (size_t)nxt.pm * tstep : cA; const char* nB = has_next ? (const char*)g.Bt + (size_t)nxt.pn * tstep : cB;
        for (int t = 0; t < nt; t += 2) {
            const bool last = (t == nt - 2);
            const char* a1 = cA + (size_t)(t + 1) * kstep;
            const char* a2 = last ? nA : cA + (size_t)(t + 2) * kstep; const char* b2 = last ? nB : cB + (size_t)(t + 2) * kstep;
            const char* a3 = a2 + kstep; const char* b3 = b2 + kstep;
            if (last && has_next) S.a_ready(nxt);
            if constexpr (SP2) {
            PG8_LDB(B0, 0, 0); PG8_LDB(B1, 0, 1); PG8_SCHED; PG8_LDA(At, 0, 0); PG8_STAGE(PG8_SA(1, 1), a1 + hstep, voffA);
            PG8_WAIT_V(8); PG8_WAIT_L(0); PG8_BAR; PG8_MMA(0, 0, At, B0); PG8_MMA(0, 1, At, B1); PG8_BAR; PG8_SCHED;
            PG8_LDA(At, 0, 1); PG8_STAGE(PG8_SB(0, 0), b2, voffB); PG8_STAGE(PG8_SB(0, 1), b2 + hstep, voffB); PG8_STAGE(PG8_SA(0, 0), a2, voffA);
            PG8_WAIT_V(8); PG8_WAIT_L(0); PG8_BAR; PG8_MMA(1, 0, At, B0); PG8_MMA(1, 1, At, B1); PG8_BAR; PG8_SCHED;
            PG8_LDB(B0, 1, 0); PG8_LDB(B1, 1, 1); PG8_SCHED; PG8_LDA(At, 1, 0); PG8_STAGE(PG8_SA(0, 1), a2 + hstep, voffA);
            PG8_WAIT_V(8); PG8_WAIT_L(0); PG8_BAR; PG8_MMA(0, 0, At, B0); PG8_MMA(0, 1, At, B1); PG8_BAR; PG8_SCHED;
            PG8_LDA(At, 1, 1); PG8_STAGE(PG8_SB(1, 0), b3, voffB); PG8_STAGE(PG8_SB(1, 1), b3 + hstep, voffB); PG8_STAGE(PG8_SA(1, 0), a3, voffA);
            PG8_WAIT_V(8); PG8_WAIT_L(0); PG8_BAR; PG8_MMA(1, 0, At, B0); PG8_MMA(1, 1, At, B1); PG8_BAR; PG8_SCHED;
            } else {
            PG8_LDB(B0, 0, 0); PG8_SCHED; PG8_LDA(At, 0, 0); PG8_STAGE(PG8_SA(1, 1), a1 + hstep, voffA);
            PG8_WAIT_L(8); PG8_BAR; PG8_WAIT_L(0); PG8_MMA(0, 0, At, B0); PG8_BAR; PG8_SCHED;
            PG8_LDB(B1, 0, 1); PG8_STAGE(PG8_SB(0, 0), b2, voffB);
            PG8_BAR; PG8_WAIT_L(0); PG8_MMA(0, 1, At, B1); PG8_BAR;
            PG8_LDA(At, 0, 1); PG8_STAGE(PG8_SA(0, 0), a2, voffA);
            PG8_BAR; PG8_WAIT_L(0); PG8_MMA(1, 0, At, B0); PG8_BAR; PG8_SCHED;
            PG8_STAGE(PG8_SB(0, 1), b2 + hstep, voffB);
            PG8_WAIT_V(6); PG8_BAR; PG8_MMA(1, 1, At, B1); PG8_BAR;
            PG8_LDB(B0, 1, 0); PG8_SCHED; PG8_LDA(At, 1, 0); PG8_STAGE(PG8_SA(0, 1), a2 + hstep, voffA);
            PG8_WAIT_L(8); PG8_BAR; PG8_WAIT_L(0); PG8_MMA(0, 0, At, B0); PG8_BAR; PG8_SCHED;
            PG8_LDB(B1, 1, 1); PG8_STAGE(PG8_SB(1, 0), b3, voffB);
            PG8_BAR; PG8_WAIT_L(0); PG8_MMA(0, 1, At, B1); PG8_BAR;
            PG8_LDA(At, 1, 1); PG8_STAGE(PG8_SA(1, 0), a3, voffA);
            PG8_BAR; PG8_WAIT_L(0); PG8_MMA(1, 0, At, B0); PG8_BAR; PG8_SCHED;
            PG8_STAGE(PG8_SB(1, 1), b3 + hstep, voffB);
            PG8_WAIT_V(6); PG8_BAR; PG8_MMA(1, 1, At, B1); PG8_BAR;
            }
        }
        if constexpr (ALIGN_EPI) { if (wr == 0) PG8_BAR; }
        if constexpr (!Epi::AFTER_DRAIN) { E(acc, cur, wr, wc, fr, fq); S.done(cur); }
        if (!has_next) break;
#pragma unroll
        for (int a = 0; a < 2; ++a)
#pragma unroll
            for (int b = 0; b < 2; ++b)
#pragma unroll
                for (int m = 0; m < 4; ++m)
#pragma unroll
                    for (int n = 0; n < 2; ++n) acc[a][b][m][n] = (f32x4){0.f, 0.f, 0.f, 0.f};
        cur = nxt; cA = nA; cB = nB; ++ui;
        if constexpr (ALIGN_EPI) { if (wr == 1) PG8_BAR; }
    }
    PG8_WAIT_V(0);
    if constexpr (!ALIGN_EPI) { if (wr == 0) PG8_BAR; }
    PG8_BAR;
    if constexpr (Epi::AFTER_DRAIN) { E.fused(acc, cur, wr, wc, fr, fq, lds, wid, lane); S.done(cur); }
#undef PG8_SA
#undef PG8_SB
#undef PG8_STAGE
#undef PG8_LDA
#undef PG8_LDB
#undef PG8_MMA
#undef PG8_WAIT_V
#undef PG8_WAIT_L
#undef PG8_BAR
#undef PG8_SCHED
}

struct PEpiQK {
    static constexpr bool PERM = true, AFTER_DRAIN = false;
    bf16_t* q; bf16_t* k; const float* bias;
    __device__ __forceinline__ void operator()(const f32x4 (&acc)[2][2][4][2], const Unit& u, int wr, int wc, int fr, int fq) const {
        const int row0 = u.pm * BM + wr * 64 + fr, colt = u.pn * BM;
        const bool isq = colt < 2048; const float sc = isq ? 0.125f : 1.f;
        const int cbase = (isq ? colt : colt - 2048) + wc * 32 + 8 * fq, bcol = colt + wc * 32 + 8 * fq;
#pragma unroll
        for (int bj = 0; bj < 2; ++bj) {
            const f32x4 b0 = *(const f32x4*)(bias + bcol + bj * HALF), b1 = *(const f32x4*)(bias + bcol + bj * HALF + 4);
            const int kc = cbase + bj * HALF, hh = kc >> 6, d0 = kc & 63;
#pragma unroll
            for (int ai = 0; ai < 2; ++ai)
#pragma unroll
                for (int m = 0; m < 4; ++m) {
                    const f32x4 v0 = (acc[ai][bj][m][0] + b0) * sc, v1 = (acc[ai][bj][m][1] + b1) * sc;
                    u32x4 w; w.x = cvt_pk_bf16(v0[0], v0[1]); w.y = cvt_pk_bf16(v0[2], v0[3]); w.z = cvt_pk_bf16(v1[0], v1[1]); w.w = cvt_pk_bf16(v1[2], v1[3]);
                    const int tok = row0 + ai * HALF + m * 16;
                    if (isq) *(u32x4*)(q + (size_t)tok * 2048 + kc) = w;
                    else { const int R = tok >> 6, c = tok & 63;
                        *(u32x4*)(k + ((((((size_t)(R * 32 + hh) * 8 + (c >> 3)) * 2 + ((c >> 2) & 1)) * 2 + (d0 >> 5)) * 4 + (c & 3)) * 4 + ((d0 >> 3) & 3)) * 8) = w; }
                }
        }
    }
};
struct PEpiVT {
    static constexpr bool PERM = true, AFTER_DRAIN = false;
    bf16_t* vt; const float* bias;
    __device__ __forceinline__ void operator()(const f32x4 (&acc)[2][2][4][2], const Unit& u, int wr, int wc, int fr, int fq) const {
        const int row0 = u.pm * BM + wr * 64 + fr, col0 = u.pn * BM + wc * 32 + 8 * fq;
#pragma unroll
        for (int ai = 0; ai < 2; ++ai)
#pragma unroll
            for (int m = 0; m < 4; ++m) {
                const int c = row0 + ai * HALF + m * 16; const float b = bias[c];
#pragma unroll
                for (int bj = 0; bj < 2; ++bj) {
                    const f32x4 v0 = acc[ai][bj][m][0] + b, v1 = acc[ai][bj][m][1] + b;
                    u32x4 w; w.x = cvt_pk_bf16(v0[0], v0[1]); w.y = cvt_pk_bf16(v0[2], v0[3]); w.z = cvt_pk_bf16(v1[0], v1[1]); w.w = cvt_pk_bf16(v1[2], v1[3]);
                    { const int tok = col0 + bj * HALF, R = tok >> 6, cgp = (tok & 63) >> 3;
                      *(u32x4*)(vt + ((((size_t)(R * 32 + (c >> 6)) * 8 + cgp) * 64 + (c & 63)) * 8)) = w; }
                }
            }
    }
};
struct PEpiResid {
    static constexpr bool PERM = false, AFTER_DRAIN = false;
    const float* src; float* dst; const float* bias;
    __device__ __forceinline__ void operator()(const f32x4 (&acc)[2][2][4][2], const Unit& u, int wr, int wc, int fr, int fq) const {
        const int row0 = u.pm * BM + wr * 64 + fr, col0 = u.pn * BM + wc * 32 + 4 * fq;
        f32x4 bv[2][2];
#pragma unroll
        for (int bj = 0; bj < 2; ++bj)
#pragma unroll
            for (int n = 0; n < 2; ++n) bv[bj][n] = bias ? *(const f32x4*)(bias + col0 + bj * HALF + n * 16) : (f32x4){0.f, 0.f, 0.f, 0.f};
#pragma unroll
        for (int ai = 0; ai < 2; ++ai)
#pragma unroll
            for (int mh = 0; mh < 2; ++mh) {
                f32x4 sv[2][2][2];
#pragma unroll
                for (int ml = 0; ml < 2; ++ml)
#pragma unroll
                    for (int bj = 0; bj < 2; ++bj)
#pragma unroll
                        for (int n = 0; n < 2; ++n) sv[ml][bj][n] = *(const f32x4*)(src + (size_t)(row0 + ai * HALF + (mh * 2 + ml) * 16) * 2048 + col0 + bj * HALF + n * 16);
                asm volatile("" ::: "memory");
#pragma unroll
                for (int ml = 0; ml < 2; ++ml)
#pragma unroll
                    for (int bj = 0; bj < 2; ++bj)
#pragma unroll
                        for (int n = 0; n < 2; ++n) *(f32x4*)(dst + (size_t)(row0 + ai * HALF + (mh * 2 + ml) * 16) * 2048 + col0 + bj * HALF + n * 16) = sv[ml][bj][n] + acc[ai][bj][mh * 2 + ml][n] + bv[bj][n];
                asm volatile("" ::: "memory");
            }
    }
};
struct PEpiRwkv {
    static constexpr bool PERM = true, AFTER_DRAIN = false;
    bf16_t* rkv;
    bf16_t* lw; bf16_t* la; bf16_t* gl;
    __device__ __forceinline__ void operator()(const f32x4 (&acc)[2][2][4][2], const Unit& u, int wr, int wc, int fr, int fq) const {
        const int which = u.pm >> 5, row0 = (u.pm & 31) * BM + wr * 64 + fr;
#pragma unroll
        for (int bj = 0; bj < 2; ++bj)
#pragma unroll
            for (int ai = 0; ai < 2; ++ai)
#pragma unroll
                for (int m = 0; m < 4; ++m) {
                    f32x4 v0 = acc[ai][bj][m][0], v1 = acc[ai][bj][m][1];
                    const int t = row0 + ai * HALF + m * 16;
                    bf16_t* dp;
                    if (which < 3) dp = rkv + (size_t)which * 8192 * 2048 + (size_t)t * 2048 + (u.pn - which * 8) * BM + bj * HALF + wc * 32 + 8 * fq;
                    else {
                        const int j = bj * HALF + wc * 32 + 8 * fq;
#pragma unroll
                        for (int e = 0; e < 4; ++e) {
                            if (which == 3) { v0[e] = tanhf_(v0[e]); v1[e] = tanhf_(v1[e]); }
                            else if (which == 5) { v0[e] = __builtin_amdgcn_rcpf(1.f + __expf(-v0[e])); v1[e] = __builtin_amdgcn_rcpf(1.f + __expf(-v1[e])); }
                        }
                        dp = which == 5 ? gl + (size_t)t * 256 + j : (which == 3 ? lw : la) + ((((size_t)(j >> 7) * 512 + (t >> 4)) * 4 + ((j & 127) >> 5)) * 64 + ((j >> 3) & 3) * 16 + (t & 15)) * 8;
                    }
                    u32x4 w; w.x = cvt_pk_bf16(v0[0], v0[1]); w.y = cvt_pk_bf16(v0[2], v0[3]); w.z = cvt_pk_bf16(v1[0], v1[1]); w.w = cvt_pk_bf16(v1[2], v1[3]);
                    *(u32x4*)dp = w;
                }
    }
};
struct PEpiPlain {
    static constexpr bool PERM = true, AFTER_DRAIN = false;
    bf16_t* dst;
    __device__ __forceinline__ void operator()(const f32x4 (&acc)[2][2][4][2], const Unit& u, int wr, int wc, int fr, int fq) const {
        const int row0 = u.pm * BM + wr * 64 + fr, col0 = u.pn * BM + wc * 32 + 8 * fq;
#pragma unroll
        for (int ai = 0; ai < 2; ++ai)
#pragma unroll
            for (int m = 0; m < 4; ++m)
#pragma unroll
                for (int bj = 0; bj < 2; ++bj) {
                    const f32x4 v0 = acc[ai][bj][m][0], v1 = acc[ai][bj][m][1];
                    u32x4 w; w.x = cvt_pk_bf16(v0[0], v0[1]); w.y = cvt_pk_bf16(v0[2], v0[3]); w.z = cvt_pk_bf16(v1[0], v1[1]); w.w = cvt_pk_bf16(v1[2], v1[3]);
                    *(u32x4*)(dst + (size_t)(row0 + ai * HALF + m * 16) * 2048 + col0 + bj * HALF) = w;
                }
    }
};
struct RwkvOrder {
    int G, c;
    __device__ bool next(int i, Unit& u) const {
        const int L = i * G + ((c & 7) * (G >> 3) + (c >> 3));
        if (L >= 864) return false;
        if (L < 768) { const int which = L >> 8, r = L & 255; u.pm = which * 32 + (r >> 3); u.pn = which * 8 + (r & 7); }
        else { const int r = L - 768, which = 3 + (r >> 5); u.pm = which * 32 + (r & 31); u.pn = 32 + (which - 3); }
        return true;
    }
    __device__ __forceinline__ void a_ready(const Unit&) const {}
    __device__ __forceinline__ void done(const Unit&) const {}
};
}

struct ConvJob { const float* src; bf16_t* dst; int ldn, Kreal, Nreal, k0, n0, ldk, mode; };
constexpr int CONV_LDS = 64 * 132 * 4;
__device__ __forceinline__ void conv_load(const int tid, const ConvJob& j, f32x4 (&w)[4]) {
    const int kq = tid >> 5, nc = (tid & 31) * 4;
#pragma unroll
    for (int i = 0; i < 4; ++i) {
        const int k = j.k0 + kq * 4 + i;
        w[i] = (f32x4){0.f, 0.f, 0.f, 0.f};
        if (k < j.Kreal && j.n0 + nc < j.Nreal) w[i] = *(const f32x4*)(j.src + (size_t)k * j.ldn + j.n0 + nc);
    }
}
__device__ __forceinline__ void conv_stage(const int tid, LAS char* lb, const f32x4 (&w)[4]) {
    const int kq = tid >> 5, nc = (tid & 31) * 4;
#pragma unroll
    for (int i = 0; i < 4; ++i) *(LAS f32x4*)(lb + ((kq * 4 + i) * 132 + nc) * 4) = w[i];
}
__device__ __forceinline__ void conv_finish(const int tid, const LAS char* lb, const ConvJob& j) {
    const int n = tid >> 2, part = tid & 3;
    float w[16];
#pragma unroll
    for (int i = 0; i < 16; ++i) w[i] = *(const LAS float*)(lb + ((part * 16 + i) * 132 + n) * 4);
    u32x4 o0, o1;
    o0.x = pk2(w[0], w[1]); o0.y = pk2(w[2], w[3]); o0.z = pk2(w[4], w[5]); o0.w = pk2(w[6], w[7]);
    o1.x = pk2(w[8], w[9]); o1.y = pk2(w[10], w[11]); o1.z = pk2(w[12], w[13]); o1.w = pk2(w[14], w[15]);
    if (j.mode == 3) {
        const int nn = j.n0 + n, kk = j.k0 + part * 16;
        bf16_t* dp = j.dst + ((((size_t)(nn >> 4) * 4 + (kk >> 5)) * 64 + ((kk >> 3) & 3) * 16 + (nn & 15)) * 8);
        *(u32x4*)dp = o0; *(u32x4*)(dp + 128) = o1;
    } else {
        bf16_t* dp = j.dst + (size_t)(j.n0 + n) * j.ldk + j.k0 + part * 16;
        *(u32x4*)dp = o0; *(u32x4*)(dp + 8) = o1;
    }
}
__device__ __forceinline__ ConvJob conv_decode(CPar& p, int id) {
    unsigned char* ws = p.ws;
    if (id < 1536) { const int kt = id / 48, nt = id % 48; return ConvJob{p.in[4], (bf16_t*)(ws + WS_WQKV), 3 * D, D, 3 * D, kt * 64, nt * 128, D, 0}; }
    id -= 1536;
    if (id < 2560) {
        const int w = id / 512, r = id % 512, kt = r / 16, nt = r % 16;
        const float* src = w == 0 ? p.in[7] : w == 1 ? p.in[10] : w == 2 ? p.in[11] : w == 3 ? p.in[12] : p.in[13];
        const size_t off = w == 0 ? WS_WONA : w == 1 ? WS_WR : w == 2 ? WS_WK : w == 3 ? WS_WV : WS_WORW;
        return ConvJob{src, (bf16_t*)(ws + off), D, D, D, kt * 64, nt * 128, D, 0};
    }
    id -= 2560;
    if (id < 128) {
        const int which = id / 64, r = id % 64, z = r / 32, kt = r % 32;
        const float* src = (which == 0 ? p.in[15] : p.in[18]) + (size_t)z * D * 96;
        bf16_t* dst = (bf16_t*)(ws + (which == 0 ? WS_W1T : WS_A1T)) + (size_t)z * 128 * D;
        return ConvJob{src, dst, 96, D, 96, kt * 64, 0, D, 0};
    }
    id -= 128;
    if (id < 64) { const int kt = id / 2, nt = id % 2; return ConvJob{p.in[20], (bf16_t*)(ws + WS_G1T), 256, D, 256, kt * 64, nt * 128, D, 0}; }
    id -= 64;
    if (id < 128) {
        const int which = id / 64, r = id % 64, z = r / 32, r2 = r % 32, kt = r2 / 16, nt = r2 % 16;
        const float* src = (which == 0 ? p.in[16] : p.in[19]) + (size_t)z * 96 * D;
        bf16_t* dst = (bf16_t*)(ws + (which == 0 ? WS_W2T : WS_A2T)) + (size_t)z * D * 128;
        return ConvJob{src, dst, D, 96, D, kt * 64, nt * 128, 128, 3};
    }
    id -= 128;
    const int kt = id / 16, nt = id % 16;
    return ConvJob{p.in[21], (bf16_t*)(ws + WS_G2T), D, 256, D, kt * 64, nt * 128, 256, 0};
}
constexpr int N_CONV_JOBS = 1536 + 2560 + 128 + 64 + 128 + 64;

__device__ __forceinline__ void rms_row_bf16(const f32x4 (&x)[8], const float* __restrict__ g, bf16_t* __restrict__ dst, int lane) {
    float ss = 0.f;
#pragma unroll
    for (int j = 0; j < 8; ++j) ss += x[j][0] * x[j][0] + x[j][1] * x[j][1] + x[j][2] * x[j][2] + x[j][3] * x[j][3];
    ss = wave_sum(ss);
    const float inv = rsqrtf(ss * (1.f / D) + 1e-6f);
#pragma unroll
    for (int j = 0; j < 8; ++j) {
        const f32x4 gv = *(const f32x4*)(g + (j * 64 + lane) * 4);
        u32x2 o; o.x = pk2(x[j][0] * inv * gv[0], x[j][1] * inv * gv[1]); o.y = pk2(x[j][2] * inv * gv[2], x[j][3] * inv * gv[3]);
        *(u32x2*)(dst + (j * 64 + lane) * 4) = o;
    }
}

__device__ __forceinline__ void ph_prologue(CPar& p, LAS char* lds) {
    const int tid = otid();
    {
        int id = blockIdx.x, buf = 0;
        ConvJob cur{}; f32x4 w[4];
        if (id < N_CONV_JOBS) { cur = conv_decode(p, id); conv_load(tid, cur, w); }
        for (; id < N_CONV_JOBS; id += gridDim.x) {
            LAS char* lb = lds + buf * CONV_LDS;
            conv_stage(tid, lb, w);
            __syncthreads();
            ConvJob nxt = cur;
            if (id + (int)gridDim.x < N_CONV_JOBS) { nxt = conv_decode(p, id + gridDim.x); conv_load(tid, nxt, w); }
            conv_finish(tid, lb, cur);
            cur = nxt; buf ^= 1;
        }
    }
    {
        float* rgf = (float*)(p.ws + WS_RGF); float* ref = (float*)(p.ws + WS_REF);
        for (int i = blockIdx.x * NTHR + tid; i < 2 * 8 * 4 * 64; i += gridDim.x * NTHR) {
            const int ln = i & 63, c = (i >> 6) & 3, j = (i >> 8) & 7, layer = i >> 11, d = (j * 64 + ln) * 4 + c;
            *(f32x4*)(rgf + (size_t)i * 4) = *(const f32x4*)(p.in[27] + ((size_t)layer * D + d) * 4);
        }
        for (int i = blockIdx.x * NTHR + tid; i < 2 * 4 * 8 * 4 * 2 * 64; i += gridDim.x * NTHR) {
            const int ln = i & 63, hf = (i >> 6) & 1, c = (i >> 7) & 3, j = (i >> 9) & 7, gq = (i >> 12) & 3, layer = i >> 14, d = (j * 64 + ln) * 4 + c;
            *(f32x4*)(ref + (size_t)i * 4) = *(const f32x4*)(p.in[29] + (((size_t)layer * 4 + gq) * D + d) * 8 + hf * 4);
        }
    }
    const int lane = tid & 63, gw = blockIdx.x * 8 + (tid >> 6), nw = gridDim.x * 8;
    bf16_t* hn = (bf16_t*)(p.ws + WS_HN);
    f32x4 x[8], xn[8];
    if (gw < T) {
#pragma unroll
        for (int j = 0; j < 8; ++j) x[j] = *(const f32x4*)(p.in[0] + (size_t)gw * D + (j * 64 + lane) * 4);
    }
    for (int t = gw; t < T; t += nw) {
        const int tn = t + nw < T ? t + nw : t;
#pragma unroll
        for (int j = 0; j < 8; ++j) xn[j] = *(const f32x4*)(p.in[0] + (size_t)tn * D + (j * 64 + lane) * 4);
        rms_row_bf16(x, p.in[1], hn + (size_t)t * D, lane);
#pragma unroll
        for (int j = 0; j < 8; ++j) x[j] = xn[j];
    }
}

__device__ __forceinline__ void ph_qkv(CPar& p, LAS char* lds) {
    const int tid = otid();
    const bf16_t* hn = (const bf16_t*)(p.ws + WS_HN); const bf16_t* w = (const bf16_t*)(p.ws + WS_WQKV);
    {
        pg8::Gemm g{hn, w, T, 2 * D, D}; pg8::StaticOrder S; S.init(T, 2 * D, (int)gridDim.x, (int)blockIdx.x);
        pg8::PEpiQK E{(bf16_t*)(p.ws + WS_Q), (bf16_t*)(p.ws + WS_K), p.in[5]};
        pg8::gemm_phase<pg8::PEpiQK, pg8::StaticOrder, true, true>(tid, (LAS unsigned char*)lds, g, S, E);
    }
    {
        pg8::Gemm g{w + (size_t)2 * D * D, hn, D, T, D}; pg8::StaticOrder S; S.init(D, T, (int)gridDim.x, (int)blockIdx.x);
        pg8::PEpiVT E{(bf16_t*)(p.ws + WS_VT), p.in[5] + 2 * D};
        pg8::gemm_phase<pg8::PEpiVT, pg8::StaticOrder, true, true>(tid, (LAS unsigned char*)lds, g, S, E);
    }
}

template <int OFF>
__device__ __forceinline__ void attn_pair(const int lane, const bf16_t* __restrict__ Q, const bf16_t* __restrict__ Kp, const bf16_t* __restrict__ Vt, bf16_t* __restrict__ AO,
                                          const LAS float* rb, const int r0, const int h, const int cb, const int rs0) {
    constexpr int NR = 8 + OFF;
    const int qi = lane & 15, g = lane >> 4;
    int bs = cb * 16 - 8; bs = bs < 0 ? 0 : (bs > 32 ? 32 : bs);
    const int qc = cb * 16 + qi;
    int wsx = qc - 8; wsx = wsx < 0 ? 0 : (wsx > 48 ? 48 : wsx);
    const size_t tq = (size_t)r0 * GW + qc;
    bf16x8 qf[2][2];
#pragma unroll
    for (int q = 0; q < 2; ++q) {
        qf[q][0] = *(const bf16x8*)(Q + (tq + q * GW) * D + h * HD + 8 * g);
        qf[q][1] = *(const bf16x8*)(Q + (tq + q * GW) * D + h * HD + 32 + 8 * g);
    }
    f32x4 s[2][8][2];
#pragma unroll
    for (int i = 0; i < NR; ++i)
#pragma unroll
        for (int tt = 0; tt < 2; ++tt) {
            const bf16_t* kp = Kp + ((((((size_t)((rs0 + i) * 32 + h) * 8 + (bs >> 3) + (qi >> 2)) * 2 + tt) * 2) * 4 + (qi & 3)) * 4 + g) * 8;
            const bf16x8 kf0 = *(const bf16x8*)kp;
            const bf16x8 kf1 = *(const bf16x8*)(kp + 128);
            if (i < 8) {
                f32x4 a = {0.f, 0.f, 0.f, 0.f};
                a = __builtin_amdgcn_mfma_f32_16x16x32_bf16(kf0, qf[0][0], a, 0, 0, 0);
                a = __builtin_amdgcn_mfma_f32_16x16x32_bf16(kf1, qf[0][1], a, 0, 0, 0);
                s[0][i][tt] = a;
            }
            if (i >= OFF) {
                f32x4 a = {0.f, 0.f, 0.f, 0.f};
                a = __builtin_amdgcn_mfma_f32_16x16x32_bf16(kf0, qf[1][0], a, 0, 0, 0);
                a = __builtin_amdgcn_mfma_f32_16x16x32_bf16(kf1, qf[1][1], a, 0, 0, 0);
                s[1][i - OFF][tt] = a;
            }
        }
    int relx[2][4]; bool okc[2][4];
#pragma unroll
    for (int tt = 0; tt < 2; ++tt)
#pragma unroll
        for (int e = 0; e < 4; ++e) {
            const int kcol = bs + 8 * g + 4 * tt + e;
            int rel = kcol - qc; rel = rel < -15 ? -15 : (rel > 15 ? 15 : rel);
            relx[tt][e] = rel + 15; okc[tt][e] = (kcol >= wsx) && (kcol < wsx + 16);
        }
    float inv[2];
    u32x4 pw[2][8];
#pragma unroll
    for (int q = 0; q < 2; ++q) {
        float mx = -1e30f;
#pragma unroll
        for (int j = 0; j < 8; ++j) {
            const int ri = (rs0 + q * OFF + j) - (r0 + q) + 7;
#pragma unroll
            for (int tt = 0; tt < 2; ++tt)
#pragma unroll
                for (int e = 0; e < 4; ++e) {
                    const float bv = rb[ri * 31 + relx[tt][e]];
                    const float v = okc[tt][e] ? s[q][j][tt][e] + bv : -1e30f;
                    s[q][j][tt][e] = v; mx = fmaxf(mx, v);
                }
        }
        mx = fmaxf(mx, __shfl_xor(mx, 16)); mx = fmaxf(mx, __shfl_xor(mx, 32));
        float sum = 0.f;
#pragma unroll
        for (int j = 0; j < 8; ++j) {
            float pv[2][4];
#pragma unroll
            for (int tt = 0; tt < 2; ++tt)
#pragma unroll
                for (int e = 0; e < 4; ++e) { pv[tt][e] = __expf(s[q][j][tt][e] - mx); sum += pv[tt][e]; }
            pw[q][j].x = pk2(pv[0][0], pv[0][1]); pw[q][j].y = pk2(pv[0][2], pv[0][3]); pw[q][j].z = pk2(pv[1][0], pv[1][1]); pw[q][j].w = pk2(pv[1][2], pv[1][3]);
        }
        sum += __shfl_xor(sum, 16); sum += __shfl_xor(sum, 32);
        inv[q] = 1.f / sum;
    }
    f32x4 o[2][4];
#pragma unroll
    for (int q = 0; q < 2; ++q)
#pragma unroll
        for (int dt = 0; dt < 4; ++dt) o[q][dt] = (f32x4){0.f, 0.f, 0.f, 0.f};
#pragma unroll
    for (int i0 = 0; i0 < NR; i0 += 3) {
        u32x4 va[3][4];
#pragma unroll
        for (int ii = 0; ii < 3; ++ii)
            if (i0 + ii < NR) {
                const bf16_t* vp = Vt + (((size_t)((rs0 + i0 + ii) * 32 + h) * 8 + (bs >> 3) + g) * 64 + qi) * 8;
#pragma unroll
                for (int dt = 0; dt < 4; ++dt) va[ii][dt] = *(const u32x4*)(vp + dt * 128);
            }
#pragma unroll
        for (int ii = 0; ii < 3; ++ii)
            if (i0 + ii < NR) {
                const int i = i0 + ii;
                if (i < 8) {
                    const bf16x8 pf = __builtin_bit_cast(bf16x8, pw[0][i]);
#pragma unroll
                    for (int dt = 0; dt < 4; ++dt) o[0][dt] = __builtin_amdgcn_mfma_f32_16x16x32_bf16(__builtin_bit_cast(bf16x8, va[ii][dt]), pf, o[0][dt], 0, 0, 0);
                }
                if (i >= OFF) {
                    const bf16x8 pf = __builtin_bit_cast(bf16x8, pw[1][i - OFF]);
#pragma unroll
                    for (int dt = 0; dt < 4; ++dt) o[1][dt] = __builtin_amdgcn_mfma_f32_16x16x32_bf16(__builtin_bit_cast(bf16x8, va[ii][dt]), pf, o[1][dt], 0, 0, 0);
                }
            }
    }
#pragma unroll
    for (int q = 0; q < 2; ++q)
#pragma unroll
        for (int dt = 0; dt < 4; ++dt) {
            u32x2 ov; ov.x = pk2(o[q][dt][0] * inv[q], o[q][dt][1] * inv[q]); ov.y = pk2(o[q][dt][2] * inv[q], o[q][dt][3] * inv[q]);
            *(u32x2*)(AO + (tq + q * GW) * D + h * HD + dt * 16 + 4 * g) = ov;
        }
}
__device__ __forceinline__ void ph_attn(CPar& p, LAS char* lds) {
    const int tid = otid(), lane = tid & 63, gw = blockIdx.x * 8 + __builtin_amdgcn_readfirstlane(tid >> 6), nw = gridDim.x * 8;
    const bf16_t* Q = (const bf16_t*)(p.ws + WS_Q); const bf16_t* Kp = (const bf16_t*)(p.ws + WS_K); const bf16_t* Vt = (const bf16_t*)(p.ws + WS_VT);
    bf16_t* AO = (bf16_t*)(p.ws + WS_AO);
    LAS float* rpbs = (LAS float*)lds;
    for (int i = tid; i < NH * 15 * 31; i += NTHR) rpbs[i] = p.in[6][i];
    __syncthreads();
    for (int u = gw; u < (ROWS / 2) * NH * 4; u += nw) {
        const int cb = u & 3, h = (u >> 2) & 31, r0 = (u >> 7) * 2;
        int rs0 = r0 - 4; rs0 = rs0 < 0 ? 0 : (rs0 > ROWS - 8 ? ROWS - 8 : rs0);
        int rs1 = r0 - 3; rs1 = rs1 < 0 ? 0 : (rs1 > ROWS - 8 ? ROWS - 8 : rs1);
        const LAS float* rb = rpbs + h * 15 * 31;
        if (rs1 != rs0) attn_pair<1>(lane, Q, Kp, Vt, AO, rb, r0, h, cb, rs0);
        else attn_pair<0>(lane, Q, Kp, Vt, AO, rb, r0, h, cb, rs0);
    }
}

__device__ __forceinline__ void ph_oproj(CPar& p, LAS char* lds, const bf16_t* A, const bf16_t* W, const float* bias, const float* src, float* dst) {
    const int tid = otid();
    pg8::Gemm g{A, W, T, D, D}; pg8::StaticOrder S; S.init(T, D, (int)gridDim.x, (int)blockIdx.x);
    pg8::PEpiResid E{src, dst, bias};
    pg8::gemm_phase<pg8::PEpiResid, pg8::StaticOrder, true, true>(tid, (LAS unsigned char*)lds, g, S, E);
}

__device__ __forceinline__ void ph_router(CPar& p, const float* __restrict__ h, int layer) {
    const int tid = otid(), lane = tid & 63, gw = blockIdx.x * 8 + (tid >> 6), nw = gridDim.x * 8;
    bf16_t* hn = (bf16_t*)(p.ws + WS_HN);
    const float* g = p.in[2] + layer * D;
    const float* wrg = (const float*)(p.ws + WS_RGF) + (size_t)layer * 8 * 4 * 64 * 4; const float* brg = p.in[28] + layer * 4;
    const float* wre = (const float*)(p.ws + WS_REF) + (size_t)layer * 4 * 8 * 4 * 2 * 64 * 4; const float* bre = p.in[30] + layer * 32;
    unsigned* cnt = (unsigned*)(p.ws + WS_CTL) + (layer ? CW_CNT1 : CW_CNT0);
    int* list = (int*)(p.ws + WS_LIST) + (size_t)layer * NEXP * T;
    float* cw = (float*)(p.ws + WS_CW) + (size_t)layer * 2 * T;
    for (int t0 = gw; t0 < T; t0 += 2 * nw) {
        const float* hrow[2]; float inv[2];
#pragma unroll
        for (int k = 0; k < 2; ++k) hrow[k] = h + (size_t)(t0 + k * nw) * D;
        {
            float ss[2] = {0.f, 0.f};
#pragma unroll 2
            for (int j = 0; j < 8; ++j)
#pragma unroll
                for (int k = 0; k < 2; ++k) { const f32x4 xv = *(const f32x4*)(hrow[k] + (j * 64 + lane) * 4); ss[k] += xv[0] * xv[0] + xv[1] * xv[1] + xv[2] * xv[2] + xv[3] * xv[3]; }
#pragma unroll
            for (int k = 0; k < 2; ++k) inv[k] = rsqrtf(wave_sum(ss[k]) * (1.f / D) + 1e-6f);
        }
        float gl[2][4];
#pragma unroll
        for (int k = 0; k < 2; ++k)
#pragma unroll
            for (int e = 0; e < 4; ++e) gl[k][e] = 0.f;
#pragma unroll 1
        for (int j = 0; j < 8; ++j) {
            const int d0 = (j * 64 + lane) * 4;
            const f32x4 gv = *(const f32x4*)(g + d0);
            f32x4 wr4[4];
#pragma unroll
            for (int c = 0; c < 4; ++c) wr4[c] = *(const f32x4*)(wrg + ((size_t)(j * 4 + c) * 64 + lane) * 4);
#pragma unroll
            for (int k = 0; k < 2; ++k) {
                f32x4 xv = *(const f32x4*)(hrow[k] + d0);
                xv[0] *= inv[k] * gv[0]; xv[1] *= inv[k] * gv[1]; xv[2] *= inv[k] * gv[2]; xv[3] *= inv[k] * gv[3];
                u32x2 o; o.x = pk2(xv[0], xv[1]); o.y = pk2(xv[2], xv[3]);
                *(u32x2*)(hn + (size_t)(t0 + k * nw) * D + d0) = o;
#pragma unroll
                for (int c = 0; c < 4; ++c) { gl[k][0] += xv[c] * wr4[c][0]; gl[k][1] += xv[c] * wr4[c][1]; gl[k][2] += xv[c] * wr4[c][2]; gl[k][3] += xv[c] * wr4[c][3]; }
            }
        }
        int gi[2]; float gwt[2];
#pragma unroll
        for (int k = 0; k < 2; ++k) {
            const float l0 = wave_sum(gl[k][0]) + brg[0], l1 = wave_sum(gl[k][1]) + brg[1], l2 = wave_sum(gl[k][2]) + brg[2], l3 = wave_sum(gl[k][3]) + brg[3];
            int gq = 0; float gm = l0;
            if (l1 > gm) { gm = l1; gq = 1; }
            if (l2 > gm) { gm = l2; gq = 2; }
            if (l3 > gm) { gm = l3; gq = 3; }
            gwt[k] = 1.f / (__expf(l0 - gm) + __expf(l1 - gm) + __expf(l2 - gm) + __expf(l3 - gm));
            gi[k] = __builtin_amdgcn_readfirstlane(gq);
        }
        float el[2][8];
#pragma unroll
        for (int k = 0; k < 2; ++k)
#pragma unroll
            for (int e = 0; e < 8; ++e) el[k][e] = 0.f;
#pragma unroll 1
        for (int j = 0; j < 8; ++j) {
            const int d0 = (j * 64 + lane) * 4;
            const f32x4 gv = *(const f32x4*)(g + d0);
#pragma unroll
            for (int k = 0; k < 2; ++k) {
                const float* we = wre + (size_t)gi[k] * 8 * 4 * 2 * 64 * 4;
                f32x4 xv = *(const f32x4*)(hrow[k] + d0);
                xv[0] *= inv[k] * gv[0]; xv[1] *= inv[k] * gv[1]; xv[2] *= inv[k] * gv[2]; xv[3] *= inv[k] * gv[3];
#pragma unroll
                for (int c = 0; c < 4; ++c) {
                    const f32x4 w0 = *(const f32x4*)(we + ((size_t)((j * 4 + c) * 2) * 64 + lane) * 4), w1 = *(const f32x4*)(we + ((size_t)((j * 4 + c) * 2 + 1) * 64 + lane) * 4);
                    el[k][0] += xv[c] * w0[0]; el[k][1] += xv[c] * w0[1]; el[k][2] += xv[c] * w0[2]; el[k][3] += xv[c] * w0[3];
                    el[k][4] += xv[c] * w1[0]; el[k][5] += xv[c] * w1[1]; el[k][6] += xv[c] * w1[2]; el[k][7] += xv[c] * w1[3];
                }
            }
        }
#pragma unroll
        for (int k = 0; k < 2; ++k) {
            const int t = t0 + k * nw;
            int i1 = 0; float m1 = -1e30f;
#pragma unroll
            for (int e = 0; e < 8; ++e) { el[k][e] = wave_sum(el[k][e]) + bre[gi[k] * 8 + e]; if (el[k][e] > m1) { m1 = el[k][e]; i1 = e; } }
            int i2 = 0; float m2 = -1e30f;
#pragma unroll
            for (int e = 0; e < 8; ++e) { if (e != i1 && el[k][e] > m2) { m2 = el[k][e]; i2 = e; } }
            const float e21 = __expf(m2 - m1);
            const float w1 = 1.f / (1.f + e21), w2 = e21 / (1.f + e21);
            if (lane == 0) {
                const int ea = gi[k] * 8 + i1, eb = gi[k] * 8 + i2;
                const unsigned pa = atomicAdd(&cnt[ea], 1u); list[ea * T + pa] = 2 * t; cw[2 * t] = gwt[k] * w1;
                const unsigned pb = atomicAdd(&cnt[eb], 1u); list[eb * T + pb] = 2 * t + 1; cw[2 * t + 1] = gwt[k] * w2;
            }
        }
    }
}

__device__ __forceinline__ void moe_prefix(const int tid, CPar& p, LAS char* lds, int layer) {
    const unsigned* cnt = (const unsigned*)(p.ws + WS_CTL) + (layer ? CW_CNT1 : CW_CNT0);
    LAS int* pref = (LAS int*)(lds + LDS_PREF);
    __syncthreads();
    if (tid == 0) {
        LAS int* te = (LAS int*)(lds + LDS_TILE_E);
        int acc = 0;
        LAS int* tnv = (LAS int*)(lds + LDS_TILE_NV); LAS int* tlo = (LAS int*)(lds + LDS_TILE_LO);
        for (int e = 0; e < NEXP; ++e) {
            pref[e] = acc; const int c = (int)cnt[e], n = (c + 255) >> 8;
            for (int k = 0; k < n; ++k) { te[acc + k] = e; tnv[acc + k] = min(256, c - k * 256); tlo[acc + k] = e * T + k * 256; }
            acc += n;
        }
        pref[NEXP] = acc;
    }
    __syncthreads();
}
__device__ __forceinline__ void ph_moe_gu(CPar& p, LAS char* lds, int layer) {
    const int tid = otid();
    moe_prefix(tid, p, lds, layer);
    LAS int* pref = (LAS int*)(lds + LDS_PREF);
    const unsigned* cnt = (const unsigned*)(p.ws + WS_CTL) + (layer ? CW_CNT1 : CW_CNT0);
    const int* list = (const int*)(p.ws + WS_LIST) + (size_t)layer * NEXP * T;
    const float* cw = (const float*)(p.ws + WS_CW) + (size_t)layer * 2 * T;
    const bf16_t* hn = (const bf16_t*)(p.ws + WS_HN);
    const int ntile = pref[NEXP], xcd = blockIdx.x & 7, mlo = xcd * ntile / 8, mhi = (xcd + 1) * ntile / 8;
    for (int v = blockIdx.x >> 3; v < (mhi - mlo) * 8; v += gridDim.x >> 3) {
        const int mt = mlo + (v >> 3), j = v & 7;
        int e = 0;
        for (int q = 1; q < NEXP; ++q) if (pref[q] <= mt) e = q;
        const int lt = mt - pref[e];
        const int nvalid = min(256, (int)cnt[e] - lt * 256);
        const int* rows = list + e * T + lt * 256;
        const int rho0 = (tid & 31) * 4;
        const float* wsrc = ((rho0 >> 5) & 1 ? p.in[32] : p.in[31]) + (size_t)(layer * NEXP + e) * D * FF + j * 64 + (rho0 >> 6) * 32 + (rho0 & 31);
        EpiMoeGU2 ep{(bf16_t*)(p.ws + WS_ACT), cw, rows, nvalid, j * 64, lds, tid};
        gemm_tile_moe(tid, lds, hn, D, rows, nvalid, 1, wsrc, FF, D, ep);
    }
}
__device__ __forceinline__ void ph_moe_down(CPar& p, LAS char* lds, int layer) {
    const int tid = otid();
    moe_prefix(tid, p, lds, layer);
    LAS int* pref = (LAS int*)(lds + LDS_PREF);
    const unsigned* cnt = (const unsigned*)(p.ws + WS_CTL) + (layer ? CW_CNT1 : CW_CNT0);
    const int* list = (const int*)(p.ws + WS_LIST) + (size_t)layer * NEXP * T;
    const bf16_t* act = (const bf16_t*)(p.ws + WS_ACT);
    const int ntile = pref[NEXP], xcd = blockIdx.x & 7, mlo = xcd * ntile / 8, mhi = (xcd + 1) * ntile / 8;
    for (int v = blockIdx.x >> 3; v < (mhi - mlo) * 16; v += gridDim.x >> 3) {
        const int mt = mlo + (v >> 4), pn = v & 15;
        int e = 0;
        for (int q = 1; q < NEXP; ++q) if (pref[q] <= mt) e = q;
        const int lt = mt - pref[e];
        const int nvalid = min(256, (int)cnt[e] - lt * 256);
        const int* rows = list + e * T + lt * 256;
        const float* wsrc = p.in[33] + (size_t)(layer * NEXP + e) * FF * D + pn * 128 + (tid & 31) * 4;
        EpiMoeD2 ep{(bf16_t*)(p.ws + WS_Y), rows, nvalid, pn * 128, lds, tid};
        gemm_tile_moe(tid, lds, act, FF, rows, nvalid, 0, wsrc, D, FF, ep);
    }
}

struct MoeT { const bf16_t* A; const float* bp; const int* rows; unsigned offA[4]; int nvalid, mt, col, isgu, e; };
__device__ __forceinline__ void moe_setup_a(CPar& p, LAS char* lds, const int layer, const int u, const int ngu, const int tid, MoeT& U) {
    const int* list = (const int*)(p.ws + WS_LIST) + (size_t)layer * NEXP * T;
    const int isgu = u < ngu ? 1 : 0, d = u - ngu;
    const int mt = isgu ? u >> 3 : d >> 4, col = isgu ? u & 7 : d & 15;
    U.e = __builtin_amdgcn_readfirstlane(((LAS int*)(lds + LDS_TILE_E))[mt]);
    U.nvalid = __builtin_amdgcn_readfirstlane(((LAS int*)(lds + LDS_TILE_NV))[mt]);
    U.rows = list + __builtin_amdgcn_readfirstlane(((LAS int*)(lds + LDS_TILE_LO))[mt]);
    U.mt = mt; U.col = col; U.isgu = isgu;
    const int srow = tid >> 3;
#pragma unroll
    for (int i = 0; i < 4; ++i) {
        const int r = srow + i * 64;
        U.offA[i] = (unsigned)U.rows[r < U.nvalid ? r : 0];
    }
}
__device__ __forceinline__ void moe_setup_b(CPar& p, const int layer, const int tid, MoeT& U) {
    const int isgu = U.isgu, e = U.e, col = U.col;
    const int lda = isgu ? D : FF, ldn = isgu ? FF : D;
    U.A = isgu ? (const bf16_t*)(p.ws + WS_HN) : (const bf16_t*)(p.ws + (layer ? WS_ACT1 : WS_ACT));
    const int rho0 = (tid & 31) * 4;
    const float* wgu = ((rho0 >> 5) & 1 ? p.in[32] : p.in[31]) + (size_t)(layer * NEXP + e) * D * FF + col * 64 + (rho0 >> 6) * 32 + (rho0 & 31);
    const float* wdn = p.in[33] + (size_t)(layer * NEXP + e) * FF * D + col * 128 + rho0;
    U.bp = (isgu ? wgu : wdn) + (size_t)((tid >> 5) * 4) * ldn;
    const int sch = tid & 7;
#pragma unroll
    for (int i = 0; i < 4; ++i) U.offA[i] = (U.offA[i] >> isgu) * (unsigned)lda + sch * 8;
}
#define MOET_LOAD(U_, ra_, rb_, tt) do { _Pragma("unroll") for (int i = 0; i < 4; ++i) { ra_[i] = *(const u32x4*)(U_.A + U_.offA[i] + (tt) * 64); rb_[i] = *(const f32x4*)(U_.bp + (size_t)((tt) * 64 + i) * LDN); } } while (0)
template <int ISGU>
__device__ __forceinline__ void moe_issue_t(const MoeT& U, u32x4 (&xa)[4], f32x4 (&xb)[4], u32x4 (&ya)[4], f32x4 (&yb)[4]) {
    constexpr int LDN = ISGU ? FF : D;
    MOET_LOAD(U, ya, yb, 0);
    MOET_LOAD(U, xa, xb, 1);
}
__device__ __forceinline__ void moe_issue(const MoeT& U, u32x4 (&xa)[4], f32x4 (&xb)[4], u32x4 (&ya)[4], f32x4 (&yb)[4]) {
    if (U.isgu) moe_issue_t<1>(U, xa, xb, ya, yb); else moe_issue_t<0>(U, xa, xb, ya, yb);
}
template <int ISGU, class H>
__device__ __forceinline__ void moe_kloop(const int tid, LAS char* lds, const MoeT& U, u32x4 (&xa)[4], f32x4 (&xb)[4], u32x4 (&ya)[4], f32x4 (&yb)[4], f32x16 (&acc)[2][2], const H& after_first) {
    const int lane = tid & 63, wid = tid >> 6, wm = wid >> 1, wn = wid & 1;
    const int srow = tid >> 3, sch = tid & 7;
#define MOE_KEY(r_) ((((r_) >> 2) & 7) ^ ((((r_) >> 1) & 1) << 2))
    const unsigned ldsw = srow * 128 + ((sch ^ MOE_KEY(srow)) << 4);
    const int nq = tid & 31, kq = tid >> 5;
    unsigned ldsb[4];
#pragma unroll
    for (int c = 0; c < 4; ++c) { const int rho = nq * 4 + c; ldsb[c] = 32768u + rho * 128 + ((((kq >> 1)) ^ MOE_KEY(rho)) << 4) + (kq & 1) * 8; }
    const int l31 = lane & 31, lh = lane >> 5, key = MOE_KEY(l31);
    const unsigned ra = (wm * 64 + l31) * 128;
    const unsigned rb = 32768 + (wn * 64 + l31) * 128;
    unsigned kc[4];
#pragma unroll
    for (int ks = 0; ks < 4; ++ks) kc[ks] = ((ks * 2 + lh) ^ key) << 4;
#pragma unroll
    for (int mi = 0; mi < 2; ++mi)
#pragma unroll
        for (int nj = 0; nj < 2; ++nj)
#pragma unroll
            for (int e = 0; e < 16; ++e) acc[mi][nj][e] = 0.f;
    constexpr int nt = ISGU ? D / 64 : FF / 64, LDN = ISGU ? FF : D;
#define MOE_STORE(ra_, rb_, so_) do { _Pragma("unroll") for (int i = 0; i < 4; ++i) *(LAS u32x4*)(lds + (so_) + ldsw + i * 8192) = ra_[i]; \
        _Pragma("unroll") for (int c = 0; c < 4; ++c) { u32x2 o; o.x = pk2(rb_[0][c], rb_[1][c]); o.y = pk2(rb_[2][c], rb_[3][c]); *(LAS u32x2*)(lds + (so_) + ldsb[c]) = o; } } while (0)
#define MOE_FRAGS(so_, ks, AF, BQ) do { _Pragma("unroll") for (int mi = 0; mi < 2; ++mi) AF[mi] = *(const LAS bf16x8*)(lds + (so_) + ra + mi * 4096 + kc[ks]); \
        _Pragma("unroll") for (int nj = 0; nj < 2; ++nj) BQ[nj] = *(const LAS bf16x8*)(lds + (so_) + rb + nj * 4096 + kc[ks]); } while (0)
#define MOE_MMA(AF, BQ) do { _Pragma("unroll") for (int mi = 0; mi < 2; ++mi) _Pragma("unroll") for (int nj = 0; nj < 2; ++nj) \
        acc[mi][nj] = __builtin_amdgcn_mfma_f32_32x32x16_bf16(BQ[nj], AF[mi], acc[mi][nj], 0, 0, 0); } while (0)
#define MOE_SB __builtin_amdgcn_sched_barrier(0)
#define MOE_COMPUTE(so_) do { bf16x8 afA[2], bqA[2], afB[2], bqB[2]; \
        MOE_FRAGS(so_, 0, afA, bqA); MOE_FRAGS(so_, 1, afB, bqB); MOE_SB; MOE_MMA(afA, bqA); MOE_SB; \
        MOE_FRAGS(so_, 2, afA, bqA); MOE_SB; MOE_MMA(afB, bqB); MOE_SB; \
        MOE_FRAGS(so_, 3, afB, bqB); MOE_SB; MOE_MMA(afA, bqA); MOE_SB; MOE_MMA(afB, bqB); } while (0)
#define MOE_STEP(tt, SA_, SB_, LA_, LB_) do { \
        if ((tt) + 2 < nt) MOET_LOAD(U, LA_, LB_, (tt) + 2); \
        __builtin_amdgcn_sched_barrier(0); \
        MOE_COMPUTE(((tt) & 1) * 49152u); \
        __builtin_amdgcn_sched_barrier(0); \
        if ((tt) + 1 < nt) MOE_STORE(SA_, SB_, (((tt) + 1) & 1) * 49152u); \
        __syncthreads(); } while (0)
    MOE_STORE(ya, yb, 0u);
    __syncthreads();
    after_first();
    for (int t = 0; t < nt; t += 8) {
        MOE_STEP(t, xa, xb, ya, yb); MOE_STEP(t + 1, ya, yb, xa, xb); MOE_STEP(t + 2, xa, xb, ya, yb); MOE_STEP(t + 3, ya, yb, xa, xb);
        MOE_STEP(t + 4, xa, xb, ya, yb); MOE_STEP(t + 5, ya, yb, xa, xb); MOE_STEP(t + 6, xa, xb, ya, yb); MOE_STEP(t + 7, ya, yb, xa, xb);
    }
#undef MOE_STEP
#undef MOE_COMPUTE
#undef MOE_FRAGS
#undef MOE_MMA
#undef MOE_SB
#undef MOE_STORE
#undef MOE_KEY
}
__device__ __forceinline__ void moe_wait_tile(gu32* c, unsigned* tmo) {
    unsigned sp = 0u;
    while ((unsigned)__builtin_amdgcn_readfirstlane(__hip_atomic_load(c, __ATOMIC_RELAXED, __HIP_MEMORY_SCOPE_AGENT)) < 64u) {
        __builtin_amdgcn_s_sleep(1);
        if ((++sp & 255u) == 0u) { if (xb_ld(tmo)) break; if (sp > XB_SPIN_CAP) { atomicAdd(tmo, 1u); break; } }
    }
    __builtin_amdgcn_fence(__ATOMIC_ACQUIRE, "agent");
    asm volatile("s_waitcnt vmcnt(0)" ::: "memory");
}

template <int ISGU>
__device__ __forceinline__ void moe_run(CPar& p, LAS char* lds, const int layer, const int tid0, int& cur, int& nxt, const int lim, const int ngu) {
    if (cur >= lim) return;
    LAS int* curp = (LAS int*)(lds + LDS_MOEQ);
    gu32* qh = (gu32*)((unsigned*)(p.ws + WS_CTL) + CW_MOEQ + layer * 64);
    gu32* mtc0 = (gu32*)((unsigned*)(p.ws + WS_CTL) + CW_MOEMT + layer * 4096);
    unsigned* tmo = (unsigned*)(p.ws + WS_CTL) + CW_BAR + XB_TMO;
    const float* cw = (const float*)(p.ws + WS_CW) + (size_t)layer * 2 * T;
    bf16_t* act = (bf16_t*)(p.ws + (layer ? WS_ACT1 : WS_ACT));
    u32x4 xa[4], ya[4]; f32x4 xb[4], yb[4];
    MoeT U;
    {
        int tid = tid0; asm volatile("" : "+v"(tid));
        if (!ISGU) { if ((tid >> 6) == 0) moe_wait_tile(mtc0 + ((cur - ngu) >> 4) * 32, tmo); __syncthreads(); }
        moe_setup_a(p, lds, layer, cur, ngu, tid, U); moe_setup_b(p, layer, tid, U);
        moe_issue_t<ISGU>(U, xa, xb, ya, yb);
    }
    while (cur < lim) {
        int tid = tid0; asm volatile("" : "+v"(tid));
        MoeT Un = U;
        const int more = nxt < lim;
        unsigned n2 = 0u;
        f32x16 acc[2][2];
        moe_kloop<ISGU>(tid, lds, U, xa, xb, ya, yb, acc, [&]() {
            if (tid == 0) { int z = 0; asm volatile("" : "+v"(z)); n2 = __hip_atomic_fetch_add(qh + z, 1u, __ATOMIC_RELAXED, __HIP_MEMORY_SCOPE_AGENT); }
            if (more) moe_setup_a(p, lds, layer, nxt, ngu, tid, Un); });
        if ((tid >> 6) == 0) {
            if (!ISGU && more) moe_wait_tile(mtc0 + ((nxt - ngu) >> 4) * 32, tmo);
            if (tid == 0) curp[0] = (int)n2;
        }
        const int wm = (tid >> 6) >> 1, wn = (tid >> 6) & 1, l31 = tid & 31, lh = (tid >> 5) & 1;
        auto hook = [&]() -> int { if (more) { moe_setup_b(p, layer, tid, Un); moe_issue_t<ISGU>(Un, xa, xb, ya, yb); } return more; };
        if (ISGU) { EpiMoeGU3 ep{act, cw, U.rows, U.nvalid, U.col * 64, lds, tid, mtc0 + U.mt * 32}; ep(acc, wm, wn, l31, lh, hook); }
        else { EpiMoeD2 ep{(bf16_t*)(p.ws + WS_Y), U.rows, U.nvalid, U.col * 128, lds, tid}; ep(acc, wm, wn, l31, lh, hook); }
        cur = nxt; nxt = __builtin_amdgcn_readfirstlane(curp[0]); U = Un;
        __syncthreads();
    }
}
__device__ __forceinline__ void ph_moe(CPar& p, LAS char* lds, int layer) {
    const int tid0 = otid();
    moe_prefix(tid0, p, lds, layer);
    LAS int* pref = (LAS int*)(lds + LDS_PREF);
    LAS int* curp = (LAS int*)(lds + LDS_MOEQ);
    gu32* qh = (gu32*)((unsigned*)(p.ws + WS_CTL) + CW_MOEQ + layer * 64);
    const int ntile = pref[NEXP], ngu = ntile * 8, total = ntile * 24;
    if (tid0 == 0) {
        const unsigned a0 = __hip_atomic_fetch_add(qh, 1u, __ATOMIC_RELAXED, __HIP_MEMORY_SCOPE_AGENT), a1 = __hip_atomic_fetch_add(qh, 1u, __ATOMIC_RELAXED, __HIP_MEMORY_SCOPE_AGENT);
        curp[0] = (int)a0; curp[1] = (int)a1;
    }
    __syncthreads();
    int cur = __builtin_amdgcn_readfirstlane(curp[0]), nxt = __builtin_amdgcn_readfirstlane(curp[1]);
    __syncthreads();
    moe_run<1>(p, lds, layer, tid0, cur, nxt, ngu, ngu);
    moe_run<0>(p, lds, layer, tid0, cur, nxt, total, ngu);
}

__device__ __forceinline__ void ph_combine_mix(CPar& p) {
    const int tid = otid(), lane = tid & 63, gw = blockIdx.x * 8 + (tid >> 6), nw = gridDim.x * 8;
    const float* h1 = p.out; float* h2 = (float*)(p.ws + WS_HB);
    const bf16_t* y = (const bf16_t*)(p.ws + WS_Y); const float* g = p.in[1] + D; bf16_t* mixo = (bf16_t*)(p.ws + WS_MIX); const float* mix = p.in[9];
#define CM_ROW(dst, r, own) do { const int r_ = (r); \
        if (r_ < 0 || r_ >= T) { _Pragma("unroll") for (int j = 0; j < 8; ++j) dst[j] = (f32x4){0.f, 0.f, 0.f, 0.f}; } \
        else { float ss = 0.f; \
            _Pragma("unroll") for (int j = 0; j < 8; ++j) { const int d0 = (j * 64 + lane) * 4; \
                f32x4 x = *(const f32x4*)(h1 + (size_t)r_ * D + d0); \
                const u32x2 a = *(const u32x2*)(y + (size_t)(2 * r_) * D + d0), bq = *(const u32x2*)(y + (size_t)(2 * r_ + 1) * D + d0); \
                x[0] += bflo(a.x) + bflo(bq.x); x[1] += bfhi(a.x) + bfhi(bq.x); x[2] += bflo(a.y) + bflo(bq.y); x[3] += bfhi(a.y) + bfhi(bq.y); \
                if (own) *(f32x4*)(h2 + (size_t)r_ * D + d0) = x; \
                ss += x[0] * x[0] + x[1] * x[1] + x[2] * x[2] + x[3] * x[3]; dst[j] = x; } \
            const float inv = rsqrtf(wave_sum(ss) * (1.f / D) + 1e-6f); \
            _Pragma("unroll") for (int j = 0; j < 8; ++j) { const f32x4 gv = *(const f32x4*)(g + (j * 64 + lane) * 4); dst[j] = dst[j] * gv * inv; } } } while (0)
    for (int run = gw; run < T / 4; run += nw) {
        const int t0 = run * 4;
        f32x4 pv[8], cu[8], nx[8];
        CM_ROW(pv, t0 - 1, false);
        CM_ROW(cu, t0, true);
#pragma unroll 1
        for (int i = 0; i < 4; ++i) {
            const int t = t0 + i;
            CM_ROW(nx, t + 1, i < 3);
            const float* mx = mix; asm volatile("" : "+s"(mx));
#pragma unroll
            for (int j = 0; j < 8; ++j) {
                const int d0 = (j * 64 + lane) * 4;
                const f32x4 xx = (pv[j] + nx[j]) * 0.5f - cu[j];
#pragma unroll
                for (int m = 0; m < 6; ++m) {
                    const f32x4 mv = *(const f32x4*)(mx + m * D + d0);
                    const f32x4 o = cu[j] + xx * mv;
                    u32x2 ov; ov.x = pk2(o[0], o[1]); ov.y = pk2(o[2], o[3]);
                    const int slot = m == 1 ? 3 : (m == 2 ? 1 : (m == 3 ? 2 : m));
                    *(u32x2*)(mixo + ((size_t)slot * T + t) * D + d0) = ov;
                }
                pv[j] = cu[j]; cu[j] = nx[j];
            }
        }
    }
#undef CM_ROW
}
__device__ __forceinline__ void ph_rwkv_proj(CPar& p, LAS char* lds) {
    const int tid = otid();
    pg8::Gemm g{(const bf16_t*)(p.ws + WS_MIX), (const bf16_t*)(p.ws + WS_WR), 6 * T, 35 * 256, D};
    pg8::RwkvOrder S{(int)gridDim.x, (int)blockIdx.x};
    pg8::PEpiRwkv E{(bf16_t*)(p.ws + WS_R), (bf16_t*)(p.ws + WS_LW), (bf16_t*)(p.ws + WS_LA), (bf16_t*)(p.ws + WS_GL)};
    pg8::gemm_phase<pg8::PEpiRwkv, pg8::RwkvOrder, true, true>(tid, (LAS unsigned char*)lds, g, S, E);
}
__device__ __forceinline__ unsigned toff(int row, int col) { return (unsigned)(row * 128 + ((((col >> 3) ^ (row >> 1)) & 7) << 4) + (col & 7) * 2); }
constexpr unsigned T_AQ = 0, T_RQ = 8192, T_BK = 16384, T_KK = 24576, T_V = 32768, T_L = 40960, T_DL = 49152  ,
                   T_TII = 53248  , T_MAK = 55296, T_MRB = 63488, T_MRK = 71680, T_ZS = 79872,
                   T_W0A = T_AQ, T_W0B = T_MAK,
                   T_LIN = 40960, T_AS = 57344;
__device__ __forceinline__ f32x4 tile_mm(LAS char* lds, unsigned abase, unsigned bbase, int mblk, int nblk, int l15, int g, f32x4 acc, int nks) {
    for (int ks = 0; ks < nks; ++ks) {
        const bf16x8 a = *(const LAS bf16x8*)(lds + abase + toff(mblk * 16 + l15, ks * 32 + 8 * g));
        const bf16x8 b = *(const LAS bf16x8*)(lds + bbase + toff(nblk * 16 + l15, ks * 32 + 8 * g));
        acc = __builtin_amdgcn_mfma_f32_16x16x32_bf16(a, b, acc, 0, 0, 0);
    }
    return acc;
}
__device__ __forceinline__ void tile_st(LAS char* lds, unsigned base, int n, int m0, f32x4 v) {
    u32x2 o; o.x = pk2(v[0], v[1]); o.y = pk2(v[2], v[3]);
    *(LAS u32x2*)(lds + base + toff(n, m0)) = o;
}

typedef short v4i16_t __attribute__((ext_vector_type(4)));
__device__ __forceinline__ bf16x8 frag_row(LAS char* lds, unsigned base, int blk, int ks, int l15, int g) {
    return *(const LAS bf16x8*)(lds + base + toff(blk * 16 + l15, ks * 32 + 8 * g));
}
__device__ __forceinline__ bf16x8 frag_tr(LAS char* lds, unsigned base, int blk, int ks, int l15, int g) {
    const int q = l15 >> 2, pp = l15 & 3;
    const v4i16_t v0 = __builtin_amdgcn_ds_read_tr16_b64_v4i16((LAS v4i16_t*)(lds + base + toff(ks * 32 + 8 * g + q, blk * 16 + 4 * pp)));
    const v4i16_t v1 = __builtin_amdgcn_ds_read_tr16_b64_v4i16((LAS v4i16_t*)(lds + base + toff(ks * 32 + 8 * g + 4 + q, blk * 16 + 4 * pp)));
    return (bf16x8){v0[0], v0[1], v0[2], v0[3], v1[0], v1[1], v1[2], v1[3]};
}
template <bool ATR, bool BTR>
__device__ __forceinline__ f32x4 tile_mm2(LAS char* lds, unsigned abase, unsigned bbase, int mblk, int nblk, int l15, int g, f32x4 acc, int nks) {
    for (int ks = 0; ks < nks; ++ks) {
        const bf16x8 a = ATR ? frag_tr(lds, abase, mblk, ks, l15, g) : frag_row(lds, abase, mblk, ks, l15, g);
        const bf16x8 b = BTR ? frag_tr(lds, bbase, nblk, ks, l15, g) : frag_row(lds, bbase, nblk, ks, l15, g);
        acc = __builtin_amdgcn_mfma_f32_16x16x32_bf16(a, b, acc, 0, 0, 0);
    }
    return acc;
}

__device__ __forceinline__ void ph_gate(CPar& p, LAS char* lds) {
    const int tid = otid();
    pg8::Gemm g{(const bf16_t*)(p.ws + WS_GL), (const bf16_t*)(p.ws + WS_G2T), T, D, 256}; pg8::StaticOrder S; S.init(T, D, (int)gridDim.x, (int)blockIdx.x);
    pg8::PEpiPlain E{(bf16_t*)(p.ws + WS_G)};
    pg8::gemm_phase<pg8::PEpiPlain, pg8::StaticOrder, true, true>(tid, (LAS unsigned char*)lds, g, S, E);
    __syncthreads();
}
__device__ __forceinline__ void ph_scan_prep(CPar& p, LAS char* lds) {
    const int tid0 = otid(), wv = tid0 >> 6;
    const bf16_t* R = (const bf16_t*)(p.ws + WS_R); const bf16_t* K2 = (const bf16_t*)(p.ws + WS_K2); const bf16_t* V2 = (const bf16_t*)(p.ws + WS_V2);
    const float* k_k = p.in[22]; const float* k_a = p.in[23]; const float* r_k = p.in[24];
    for (int u = blockIdx.x; u < NH * 128; u += gridDim.x) {
        int tid = tid0; asm volatile("" : "+v"(tid));
        const int lane = tid & 63, l15 = lane & 15, g = lane >> 4;
        const int h = u & 31, m = u >> 5;
        {
            const int z = wv >> 2, nblk = wv & 3;
            LAS char* ldz = lds + z * T_ZS;
            LAS float* LIN = (LAS float*)(ldz + T_LIN); LAS float* AS = (LAS float*)(ldz + T_AS); LAS float* lendp = (LAS float*)(lds + LDS_SEG) + z * 64;
            bf16x8 afr[2][4][3], bfr[2][3];
            float bias[2];
#pragma unroll
            for (int isa = 0; isa < 2; ++isa) {
                const bf16_t* lsrc = (const bf16_t*)(p.ws + (isa ? WS_LA : WS_LW)) + (size_t)z * 512 * 4 * 64 * 8;
                const bf16_t* wsrc = (const bf16_t*)(p.ws + (isa ? WS_A2T : WS_W2T)) + (size_t)z * D * 128 + ((size_t)(h * 4 + nblk) * 4 * 64 + g * 16 + l15) * 8;
                bias[isa] = (isa ? p.in[17] : p.in[14])[z * D + h * HD + nblk * 16 + l15];
#pragma unroll
                for (int ks = 0; ks < 3; ++ks) bfr[isa][ks] = *(const bf16x8*)(wsrc + ks * 512);
#pragma unroll
                for (int mblk = 0; mblk < 4; ++mblk) {
                    const int tb = m * 4 + (z ? 3 - mblk : mblk), r15 = z ? 15 - l15 : l15;
#pragma unroll
                    for (int ks = 0; ks < 3; ++ks) afr[isa][mblk][ks] = *(const bf16x8*)(lsrc + (((size_t)tb * 4 + ks) * 64 + g * 16 + r15) * 8);
                }
            }
            float carry = 0.f;
#pragma unroll
            for (int mblk = 0; mblk < 4; ++mblk) {
                f32x4 accw = {0.f, 0.f, 0.f, 0.f}, acca = {0.f, 0.f, 0.f, 0.f};
#pragma unroll
                for (int ks = 0; ks < 3; ++ks) { accw = __builtin_amdgcn_mfma_f32_16x16x32_bf16(afr[0][mblk][ks], bfr[0][ks], accw, 0, 0, 0); acca = __builtin_amdgcn_mfma_f32_16x16x32_bf16(afr[1][mblk][ks], bfr[1][ks], acca, 0, 0, 0); }
                float o[4], oa[4];
#pragma unroll
                for (int e = 0; e < 4; ++e) {
                    oa[e] = sigmoidf_(acca[e] + bias[1]);
                    o[e] = -0.60653066f * sigmoidf_(accw[e] + bias[0]);
                }
                o[1] += o[0]; o[2] += o[1]; o[3] += o[2];
                const float tot = o[3];
                const float u1 = __shfl_up(tot, 16); const float s2 = tot + (g >= 1 ? u1 : 0.f);
                const float u2 = __shfl_up(s2, 32); const float incl = s2 + (g >= 2 ? u2 : 0.f);
                const float tt = __shfl(incl, 48 + l15);
                const float base = carry + incl - tot;
                carry += tt;
#pragma unroll
                for (int e = 0; e < 4; ++e) { LIN[(mblk * 16 + 4 * g + e) * 64 + nblk * 16 + l15] = o[e] + base; AS[(mblk * 16 + 4 * g + e) * 64 + nblk * 16 + l15] = oa[e]; }
            }
            if (g == 0) lendp[nblk * 16 + l15] = carry;
        }
        __syncthreads();
        {
            const int tau = tid >> 3, cg = tid & 7, c0 = h * HD + cg * 8;
            const int t = m * 64 + tau; const size_t o = (size_t)t * D + c0;
            const u32x4 kw = *(const u32x4*)(K2 + o), rw = *(const u32x4*)(R + o), vw = *(const u32x4*)(V2 + o);
            float kx[8], rx[8], kk[8], kac[8], rkc[8];
            float n2 = 0.f;
#pragma unroll
            for (int q4 = 0; q4 < 2; ++q4) {
                const f32x4 k4 = *(const f32x4*)(k_k + c0 + q4 * 4), ka4 = *(const f32x4*)(k_a + c0 + q4 * 4), rk4 = *(const f32x4*)(r_k + c0 + q4 * 4);
#pragma unroll
                for (int e = 0; e < 4; ++e) {
                    const int j = q4 * 4 + e; const unsigned kwj = kw[j >> 1], rwj = rw[j >> 1];
                    kx[j] = (j & 1) ? bfhi(kwj) : bflo(kwj); rx[j] = (j & 1) ? bfhi(rwj) : bflo(rwj);
                    kk[j] = kx[j] * k4[e]; n2 += kk[j] * kk[j]; kac[j] = ka4[e]; rkc[j] = rk4[e];
                }
            }
            n2 += __shfl_xor(n2, 1); n2 += __shfl_xor(n2, 2); n2 += __shfl_xor(n2, 4);
            const float rn = __builtin_amdgcn_rcpf(fmaxf(sqrtf(n2), 1e-12f));
#pragma unroll
            for (int j = 0; j < 8; ++j) kk[j] *= rn;
#pragma unroll
            for (int z = 0; z < 2; ++z) {
                LAS char* ldz = lds + z * T_ZS;
                LAS float* LIN = (LAS float*)(ldz + T_LIN); LAS float* AS = (LAS float*)(ldz + T_AS); LAS float* lendp = (LAS float*)(lds + LDS_SEG) + z * 64;
                LAS float* elend = (LAS float*)(lds + LDS_ELEND) + z * 64;
                float* sbon = (float*)(p.ws + WS_SBON) + (size_t)z * T * NH;
                const int sidx = z ? 63 - tau : tau;
                float lin[8], lex[8], av[8];
#pragma unroll
                for (int q4 = 0; q4 < 2; ++q4) {
                    const f32x4 a4 = *(const LAS f32x4*)(AS + sidx * 64 + cg * 8 + q4 * 4), l4 = *(const LAS f32x4*)(LIN + sidx * 64 + cg * 8 + q4 * 4);
                    f32x4 p4 = {0.f, 0.f, 0.f, 0.f};
                    if (sidx > 0) p4 = *(const LAS f32x4*)(LIN + (sidx - 1) * 64 + cg * 8 + q4 * 4);
#pragma unroll
                    for (int e = 0; e < 4; ++e) { av[q4 * 4 + e] = a4[e]; lin[q4 * 4 + e] = l4[e]; lex[q4 * 4 + e] = p4[e]; }
                }
                float kd[8], sb = 0.f;
#pragma unroll
                for (int j = 0; j < 8; ++j) { kd[j] = kx[j] * (1.f + (av[j] - 1.f) * kac[j]); sb += rx[j] * kd[j] * rkc[j]; }
                sb += __shfl_xor(sb, 1); sb += __shfl_xor(sb, 2); sb += __shfl_xor(sb, 4);
                if (cg == 0) sbon[(size_t)t * NH + h] = sb;
                float aq[8], rq[8], bk[8], kq[8];
#pragma unroll
                for (int j = 0; j < 8; ++j) {
                    const float b = kk[j] * av[j];
                    const float elin = __expf(lin[j]), elex = __expf(lex[j]), enl = __expf(-lin[j]);
                    aq[j] = -kk[j] * elex; bk[j] = b * enl; kq[j] = kd[j] * enl; rq[j] = rx[j] * elin;
                }
                const unsigned wo = toff(sidx, cg * 8);
                *(LAS u32x4*)(ldz + T_AQ + wo) = (u32x4){pk2(aq[0], aq[1]), pk2(aq[2], aq[3]), pk2(aq[4], aq[5]), pk2(aq[6], aq[7])};
                *(LAS u32x4*)(ldz + T_RQ + wo) = (u32x4){pk2(rq[0], rq[1]), pk2(rq[2], rq[3]), pk2(rq[4], rq[5]), pk2(rq[6], rq[7])};
                *(LAS u32x4*)(ldz + T_BK + wo) = (u32x4){pk2(bk[0], bk[1]), pk2(bk[2], bk[3]), pk2(bk[4], bk[5]), pk2(bk[6], bk[7])};
                *(LAS u32x4*)(ldz + T_KK + wo) = (u32x4){pk2(kq[0], kq[1]), pk2(kq[2], kq[3]), pk2(kq[4], kq[5]), pk2(kq[6], kq[7])};
                *(LAS u32x4*)(ldz + T_V + wo) = vw;
                if (tau == 0) {
#pragma unroll
                    for (int q4 = 0; q4 < 2; ++q4) { const f32x4 e4 = *(const LAS f32x4*)(lendp + cg * 8 + q4 * 4);
#pragma unroll
                        for (int e = 0; e < 4; ++e) elend[cg * 8 + q4 * 4 + e] = __expf(e4[e]); }
                }
            }
        }
        __syncthreads();
#pragma unroll
        for (int z = 0; z < 2; ++z) {
            LAS char* ldz = lds + z * T_ZS;
            const int nblk = wv & 3;
#pragma unroll
            for (int pid = 0; pid < 4; ++pid) {
                const unsigned ab = (pid & 1) ? T_KK : T_BK, bb = pid < 2 ? T_AQ : T_RQ;
                const unsigned db = pid == 0 ? T_L : (pid == 1 ? T_MAK : (pid == 2 ? T_MRB : T_MRK));
#pragma unroll
                for (int i = 0; i < 2; ++i) {
                    const int mblk = (wv >> 2) * 2 + i;
                    f32x4 acc = {0.f, 0.f, 0.f, 0.f};
                    if (mblk <= nblk) {
                        acc = tile_mm(ldz, ab, bb, mblk, nblk, l15, g, acc, 2);
                        const int n = nblk * 16 + l15, m0 = mblk * 16 + 4 * g;
#pragma unroll
                        for (int e = 0; e < 4; ++e) { const bool keep = pid < 2 ? (m0 + e < n) : (m0 + e <= n); acc[e] = keep ? acc[e] : 0.f; }
                        if (pid == 0 && mblk == nblk) *(LAS f32x4*)(ldz + T_DL + ((nblk * 16 + l15) * 16 + 4 * g) * 4) = acc;
                    }
                    tile_st(ldz, db, nblk * 16 + l15, mblk * 16 + 4 * g, acc);
                }
            }
        }
        __syncthreads();
        f32x4 xacc[2][4];
        const int wcol = (wv & 3) * 16 + l15;
#pragma unroll
        for (int z = 0; z < 2; ++z) {
            LAS char* ldz = lds + z * T_ZS;
            if (wv >= 4) {
#pragma unroll
                for (int sb = 0; sb < 4; ++sb) {
                    f32x4 acc = {0.f, 0.f, 0.f, 0.f};
                    xacc[z][sb] = tile_mm2<false, true>(ldz, T_MAK, T_V, sb, wv - 4, l15, g, acc, sb < 2 ? 1 : 2);
                }
            } else {
#pragma unroll
                for (int sb = 0; sb < 4; ++sb) {
                    const v4i16_t w = __builtin_amdgcn_ds_read_tr16_b64_v4i16((LAS v4i16_t*)(ldz + T_AQ + toff(sb * 16 + 4 * g + (l15 >> 2), (wv & 3) * 16 + 4 * (l15 & 3))));
                    xacc[z][sb] = (f32x4){bf2f((bf16_t)w[0]), bf2f((bf16_t)w[1]), bf2f((bf16_t)w[2]), bf2f((bf16_t)w[3])};
                }
            }
        }
        if (wv < 2) {
            LAS char* ldz = lds + wv * T_ZS;
            float tc[16];
#pragma unroll
            for (int r = 0; r < 16; ++r) {
                float v = (r == l15) ? 1.f : 0.f;
#pragma unroll
                for (int q4 = 0; q4 < (r + 3) / 4; ++q4) {
                    const f32x4 lr = *(const LAS f32x4*)(ldz + T_DL + ((g * 16 + r) * 16 + q4 * 4) * 4);
#pragma unroll
                    for (int e = 0; e < 4; ++e) if (q4 * 4 + e < r) v += lr[e] * tc[q4 * 4 + e];
                }
                tc[r] = v;
                *(LAS bf16_t*)(ldz + T_TII + ((g * 16 + r) * 16 + l15) * 2) = (bf16_t)f2bf(v);
            }
        }
        __syncthreads();
#pragma unroll
        for (int z = 0; z < 2; ++z) {
            LAS char* ldz = lds + z * T_ZS;
            const unsigned wbase = (wv < 4 ? T_W0A : T_W0B);
            unsigned wp[4][2];
#pragma unroll
            for (int i = 0; i < 4; ++i) {
                f32x4 r = xacc[z][i];
                if (i >= 1) {
                    const u32x2 l0 = *(const LAS u32x2*)(ldz + T_L + toff(i * 16 + l15, 4 * g));
                    u32x2 l1 = {0u, 0u};
                    if (i >= 2) l1 = *(const LAS u32x2*)(ldz + T_L + toff(i * 16 + l15, 16 + 4 * g));
                    const u32x4 aw = {l0.x, l0.y, l1.x, l1.y};
                    const u32x4 bw = {wp[0][0], wp[0][1], i >= 2 ? wp[1][0] : 0u, i >= 2 ? wp[1][1] : 0u};
                    r = __builtin_amdgcn_mfma_f32_16x16x32_bf16(__builtin_bit_cast(bf16x8, aw), __builtin_bit_cast(bf16x8, bw), r, 0, 0, 0);
                }
                if (i == 3) {
                    const u32x2 l2 = *(const LAS u32x2*)(ldz + T_L + toff(48 + l15, 32 + 4 * g));
                    const u32x4 aw = {l2.x, l2.y, 0u, 0u};
                    const u32x4 bw = {wp[2][0], wp[2][1], 0u, 0u};
                    r = __builtin_amdgcn_mfma_f32_16x16x32_bf16(__builtin_bit_cast(bf16x8, aw), __builtin_bit_cast(bf16x8, bw), r, 0, 0, 0);
                }
                const u32x2 tw = *(const LAS u32x2*)(ldz + T_TII + ((i * 16 + l15) * 16 + 4 * g) * 2);
                const u32x4 aw = {tw.x, tw.y, 0u, 0u};
                const u32x4 bw = {pk2(r[0], r[1]), pk2(r[2], r[3]), 0u, 0u};
                f32x4 w = {0.f, 0.f, 0.f, 0.f};
                w = __builtin_amdgcn_mfma_f32_16x16x32_bf16(__builtin_bit_cast(bf16x8, aw), __builtin_bit_cast(bf16x8, bw), w, 0, 0, 0);
                wp[i][0] = pk2(w[0], w[1]); wp[i][1] = pk2(w[2], w[3]);
                *(LAS u32x2*)(ldz + wbase + toff(wcol, i * 16 + 4 * g)) = (u32x2){wp[i][0], wp[i][1]};
            }
        }
        __syncthreads();
#pragma unroll
        for (int z = 0; z < 2; ++z) {
            LAS char* ldz = lds + z * T_ZS;
            LAS float* elend = (LAS float*)(lds + LDS_ELEND) + z * 64;
            const int cc = z ? 127 - m : m;
            const size_t uc = ((size_t)(z * NH + h) * 128 + cc) * 4096, um = ((size_t)(z * NH + h) * 128 + m) * 4096;
            bf16_t* GB = (bf16_t*)(p.ws + WS_GB) + uc; bf16_t* FB = (bf16_t*)(p.ws + WS_FB) + uc;
            bf16_t* GYB = (bf16_t*)(p.ws + WS_GYB) + um; bf16_t* FYB = (bf16_t*)(p.ws + WS_FYB) + um;
#pragma unroll
            for (int i = 0; i < 2; ++i) {
                const int tile = wv * 2 + i, mblk = tile >> 2, nblk = tile & 3;
                const int n = nblk * 16 + l15, m0 = mblk * 16 + 4 * g;
                {
                    f32x4 acc = {0.f, 0.f, 0.f, 0.f};
                    acc = tile_mm2<false, true>(ldz, T_W0A, T_BK, mblk, nblk, l15, g, acc, 2);
                    const float el = elend[n];
#pragma unroll
                    for (int e = 0; e < 4; ++e) acc[e] = (acc[e] + (m0 + e == n ? 1.f : 0.f)) * el;
                    u32x2 o; o.x = pk2(acc[0], acc[1]); o.y = pk2(acc[2], acc[3]);
                    *(u32x2*)(GB + ((nblk * 4 + mblk) * 64 + lane) * 4) = o;
                }
                {
                    f32x4 acc = {0.f, 0.f, 0.f, 0.f};
                    acc = tile_mm2<true, false>(ldz, T_BK, T_W0B, mblk, nblk, l15, g, acc, 2);
                    acc = tile_mm2<true, true>(ldz, T_KK, T_V, mblk, nblk, l15, g, acc, 2);
                    const f32x4 el4 = *(const LAS f32x4*)(elend + m0);
                    u32x2 o; o.x = pk2(acc[0] * el4[0], acc[1] * el4[1]); o.y = pk2(acc[2] * el4[2], acc[3] * el4[3]);
                    *(u32x2*)(FB + ((nblk * 4 + mblk) * 64 + lane) * 4) = o;
                }
                {
                    f32x4 acc = {0.f, 0.f, 0.f, 0.f};
                    acc = tile_mm(ldz, T_W0A, T_MRB, mblk, nblk, l15, g, acc, 2);
                    const u32x2 rq = *(const LAS u32x2*)(ldz + T_RQ + toff(n, m0));
                    acc[0] += bflo(rq.x); acc[1] += bfhi(rq.x); acc[2] += bflo(rq.y); acc[3] += bfhi(rq.y);
                    u32x2 o; o.x = pk2(acc[0], acc[1]); o.y = pk2(acc[2], acc[3]);
                    *(u32x2*)(GYB + (z ? (((3 - nblk) * 4 + mblk) * 64 + g * 16 + 15 - l15) : ((nblk * 4 + mblk) * 64 + lane)) * 4) = o;
                }
                {
                    f32x4 acc = {0.f, 0.f, 0.f, 0.f};
                    acc = tile_mm(ldz, T_MRB, T_W0B, mblk, nblk, l15, g, acc, 2);
                    acc = tile_mm2<false, true>(ldz, T_MRK, T_V, mblk, nblk, l15, g, acc, 2);
                    u32x2 o;
                    if (z) { o.x = pk2(acc[3], acc[2]); o.y = pk2(acc[1], acc[0]); *(u32x2*)(FYB + ((nblk * 4 + (3 - mblk)) * 64 + (3 - g) * 16 + l15) * 4) = o; }
                    else { o.x = pk2(acc[0], acc[1]); o.y = pk2(acc[2], acc[3]); *(u32x2*)(FYB + ((nblk * 4 + mblk) * 64 + lane) * 4) = o; }
                }
            }
        }
        lds_barrier();
    }
}

__device__ __forceinline__ void ph_scan_state(CPar& p) {
    const int tid = otid(), lane = tid & 63, wv = tid >> 6, l15 = lane & 15, g = lane >> 4;
    if (wv != 0) return;
    for (int u = blockIdx.x; u < 256; u += gridDim.x) {
        const int zh = u >> 2, vq = u & 3;
        const bf16_t* GB = (const bf16_t*)(p.ws + WS_GB) + (size_t)zh * 128 * 4096;
        const bf16_t* FB = (const bf16_t*)(p.ws + WS_FB) + (size_t)zh * 128 * 4096;
        bf16_t* HS = (bf16_t*)(p.ws + WS_HS) + (size_t)zh * 128 * 4096;
        f32x4 acc[4];
#pragma unroll
        for (int mt = 0; mt < 4; ++mt) acc[mt] = (f32x4){0.f, 0.f, 0.f, 0.f};
        u32x2 gq[4][2][2], fq[4], gq2[4][2][2], fq2[4], gq3[4][2][2], fq3[4], gq4[4][2][2], fq4[4];
#define SCAN_LOAD(G_, F_, cidx) do { const bf16_t* gp = GB + (size_t)(cidx) * 4096; const bf16_t* fp = FB + (size_t)(cidx) * 4096; \
            _Pragma("unroll") for (int mt = 0; mt < 4; ++mt) { \
                _Pragma("unroll") for (int ks = 0; ks < 2; ++ks) { G_[mt][ks][0] = *(const u32x2*)(gp + ((mt * 4 + 2 * ks) * 64 + lane) * 4); G_[mt][ks][1] = *(const u32x2*)(gp + ((mt * 4 + 2 * ks + 1) * 64 + lane) * 4); } \
                F_[mt] = *(const u32x2*)(fp + ((vq * 4 + mt) * 64 + lane) * 4); } } while (0)
#define SCAN_STEP(G_, F_, cidx) do { \
            bf16_t* hp = HS + (size_t)(cidx) * 4096 + (vq * 4 * 64 + lane) * 4; \
            u32x2 hb[4]; \
            _Pragma("unroll") for (int mt = 0; mt < 4; ++mt) { hb[mt].x = pk2(acc[mt][0], acc[mt][1]); hb[mt].y = pk2(acc[mt][2], acc[mt][3]); *(u32x2*)(hp + mt * 256) = hb[mt]; } \
            bf16x8 bfr[2]; \
            _Pragma("unroll") for (int ks = 0; ks < 2; ++ks) { u32x4 w = {hb[2 * ks].x, hb[2 * ks].y, hb[2 * ks + 1].x, hb[2 * ks + 1].y}; bfr[ks] = __builtin_bit_cast(bf16x8, w); } \
            _Pragma("unroll") for (int mt = 0; mt < 4; ++mt) { \
                f32x4 a = {bflo(F_[mt].x), bfhi(F_[mt].x), bflo(F_[mt].y), bfhi(F_[mt].y)}; \
                _Pragma("unroll") for (int ks = 0; ks < 2; ++ks) { \
                    u32x4 w = {G_[mt][ks][0].x, G_[mt][ks][0].y, G_[mt][ks][1].x, G_[mt][ks][1].y}; \
                    a = __builtin_amdgcn_mfma_f32_16x16x32_bf16(__builtin_bit_cast(bf16x8, w), bfr[ks], a, 0, 0, 0); } \
                acc[mt] = a; } } while (0)
        SCAN_LOAD(gq, fq, 0); SCAN_LOAD(gq2, fq2, 1); SCAN_LOAD(gq3, fq3, 2); SCAN_LOAD(gq4, fq4, 3);
#pragma unroll 4
        for (int c = 0; c < 128; c += 4) {
            SCAN_STEP(gq, fq, c);
            if (c + 4 < 128) SCAN_LOAD(gq, fq, c + 4);
            SCAN_STEP(gq2, fq2, c + 1);
            if (c + 4 < 128) SCAN_LOAD(gq2, fq2, c + 5);
            SCAN_STEP(gq3, fq3, c + 2);
            if (c + 4 < 128) SCAN_LOAD(gq3, fq3, c + 6);
            SCAN_STEP(gq4, fq4, c + 3);
            if (c + 4 < 128) SCAN_LOAD(gq4, fq4, c + 7);
        }
#undef SCAN_STEP
#undef SCAN_LOAD
    }
}

__device__ __forceinline__ void ph_scan_out(CPar& p, LAS char* lds) {
    const int tid = otid(), lane = tid & 63, wv = tid >> 6, l15 = lane & 15, g = lane >> 4;
    const bf16_t* V2 = (const bf16_t*)(p.ws + WS_V2); const bf16_t* G = (const bf16_t*)(p.ws + WS_G); bf16_t* Z = (bf16_t*)(p.ws + WS_Z);
    const float* sbon = (const float*)(p.ws + WS_SBON); const float* lw = p.in[25]; const float* lb = p.in[26];
    const int vb = wv & 3, tk = tid >> 3, cg = tid & 7;
    const int NU = NH * 128, GS = gridDim.x;
    u32x2 Af[2][2], Aa[2][2][2][2], Ab[2][2][2][2];
    struct BSet { u32x4 vw, gw; f32x4 w0, w1, b0, b1; float s0, s1; };
    BSet B0, B1;
#define OUT_LOADA(u_) do { const int h_ = (u_) & 31, m_ = (u_) >> 5; \
        _Pragma("unroll") for (int i = 0; i < 2; ++i) { const int sb = (wv >> 2) * 2 + i; \
            _Pragma("unroll") for (int z = 0; z < 2; ++z) { const int cc = z ? 127 - m_ : m_; \
                const bf16_t* gy = (const bf16_t*)(p.ws + WS_GYB) + ((size_t)(z * NH + h_) * 128 + m_) * 4096; \
                const bf16_t* fy = (const bf16_t*)(p.ws + WS_FYB) + ((size_t)(z * NH + h_) * 128 + m_) * 4096; \
                const bf16_t* hs = (const bf16_t*)(p.ws + WS_HS) + ((size_t)(z * NH + h_) * 128 + cc) * 4096; \
                Af[i][z] = *(const u32x2*)(fy + ((vb * 4 + sb) * 64 + lane) * 4); \
                _Pragma("unroll") for (int ks = 0; ks < 2; ++ks) { \
                    const bf16_t* gyp = gy + ((sb * 4 + 2 * ks + (g >> 1)) * 64 + (2 * (g & 1)) * 16 + l15) * 4;        \
                    Aa[i][z][ks][0] = *(const u32x2*)gyp; Aa[i][z][ks][1] = *(const u32x2*)(gyp + 64); \
                    const bf16_t* hsp = hs + ((vb * 4 + 2 * ks + (g >> 1)) * 64 + (2 * (g & 1)) * 16 + l15) * 4; \
                    Ab[i][z][ks][0] = *(const u32x2*)hsp; Ab[i][z][ks][1] = *(const u32x2*)(hsp + 64); } } } } while (0)
#define OUT_LOADB(S_, u_) do { const int h_ = (u_) & 31, m_ = (u_) >> 5, t_ = m_ * 64 + tk, c0_ = h_ * HD + cg * 8; const size_t o_ = (size_t)t_ * D + c0_; \
        S_.vw = *(const u32x4*)(V2 + o_); S_.gw = *(const u32x4*)(G + o_); \
        S_.s0 = sbon[(size_t)t_ * NH + h_]; S_.s1 = sbon[(size_t)T * NH + (size_t)t_ * NH + h_]; \
        S_.w0 = *(const f32x4*)(lw + c0_); S_.w1 = *(const f32x4*)(lw + c0_ + 4); S_.b0 = *(const f32x4*)(lb + c0_); S_.b1 = *(const f32x4*)(lb + c0_ + 4); } while (0)
#define OUT_MMA(yt_) do { \
        _Pragma("unroll") for (int i = 0; i < 2; ++i) { const int sb = (wv >> 2) * 2 + i; \
            f32x4 acc = {0.f, 0.f, 0.f, 0.f}; \
            _Pragma("unroll") for (int z = 0; z < 2; ++z) { \
                const u32x2 f = Af[i][z]; \
                acc[0] += bflo(f.x); acc[1] += bfhi(f.x); acc[2] += bflo(f.y); acc[3] += bfhi(f.y); \
                _Pragma("unroll") for (int ks = 0; ks < 2; ++ks) { \
                    const bf16x8 a = __builtin_bit_cast(bf16x8, (u32x4){Aa[i][z][ks][0].x, Aa[i][z][ks][0].y, Aa[i][z][ks][1].x, Aa[i][z][ks][1].y}); \
                    const bf16x8 bq = __builtin_bit_cast(bf16x8, (u32x4){Ab[i][z][ks][0].x, Ab[i][z][ks][0].y, Ab[i][z][ks][1].x, Ab[i][z][ks][1].y}); \
                    acc = __builtin_amdgcn_mfma_f32_16x16x32_bf16(a, bq, acc, 0, 0, 0); } } \
            _Pragma("unroll") for (int e = 0; e < 4; ++e) yt_[(sb * 16 + 4 * g + e) * 64 + vb * 16 + l15] = acc[e]; } } while (0)
#define OUT_NORM(S_, u_, yt_) do { const int h_ = (u_) & 31, m_ = (u_) >> 5, t_ = m_ * 64 + tk, c0_ = h_ * HD + cg * 8; const size_t o_ = (size_t)t_ * D + c0_; \
        const float sbv = S_.s0 + S_.s1; \
        const f32x4 y0 = *(const LAS f32x4*)(yt_ + tk * 64 + cg * 8), y1 = *(const LAS f32x4*)(yt_ + tk * 64 + cg * 8 + 4); \
        float sum = y0[0] + y0[1] + y0[2] + y0[3] + y1[0] + y1[1] + y1[2] + y1[3]; \
        sum += __shfl_xor(sum, 1); sum += __shfl_xor(sum, 2); sum += __shfl_xor(sum, 4); \
        const float mu = sum * (1.f / 64.f); \
        float yv[8], wv8[8], bv8[8], gv[8], vv[8]; \
        _Pragma("unroll") for (int e = 0; e < 4; ++e) { yv[e] = y0[e] - mu; yv[4 + e] = y1[e] - mu; wv8[e] = S_.w0[e]; wv8[4 + e] = S_.w1[e]; bv8[e] = S_.b0[e]; bv8[4 + e] = S_.b1[e]; } \
        _Pragma("unroll") for (int j = 0; j < 8; ++j) gv[j] = (j & 1) ? bfhi(S_.gw[j >> 1]) : bflo(S_.gw[j >> 1]); \
        _Pragma("unroll") for (int j = 0; j < 8; ++j) vv[j] = (j & 1) ? bfhi(S_.vw[j >> 1]) : bflo(S_.vw[j >> 1]); \
        float sq = 0.f; \
        _Pragma("unroll") for (int j = 0; j < 8; ++j) sq += yv[j] * yv[j]; \
        sq += __shfl_xor(sq, 1); sq += __shfl_xor(sq, 2); sq += __shfl_xor(sq, 4); \
        const float rs = rsqrtf(sq * (1.f / 64.f) + 64e-5f); \
        float ov[8]; \
        _Pragma("unroll") for (int j = 0; j < 8; ++j) ov[j] = (yv[j] * rs * wv8[j] + bv8[j] + sbv * vv[j]) * gv[j]; \
        u32x4 pw; pw.x = pk2(ov[0], ov[1]); pw.y = pk2(ov[2], ov[3]); pw.z = pk2(ov[4], ov[5]); pw.w = pk2(ov[6], ov[7]); \
        *(u32x4*)(Z + o_) = pw; } while (0)
    LAS float* yt0 = (LAS float*)lds; LAS float* yt1 = yt0 + 4096;
    int u = blockIdx.x;
    if (u < NU) { OUT_LOADA(u); OUT_LOADB(B0, u); }
    for (; u < NU; u += 2 * GS) {
        OUT_MMA(yt0);
        const int u1 = u + GS;
        if (u1 < NU) { OUT_LOADA(u1); OUT_LOADB(B1, u1); }
        lds_barrier();
        OUT_NORM(B0, u, yt0);
        if (u1 >= NU) break;
        OUT_MMA(yt1);
        const int u2 = u1 + GS;
        if (u2 < NU) { OUT_LOADA(u2); OUT_LOADB(B0, u2); }
        lds_barrier();
        OUT_NORM(B1, u1, yt1);
    }
#undef OUT_LOADA
#undef OUT_LOADB
#undef OUT_MMA
#undef OUT_NORM
}

__device__ __forceinline__ void ph_final(CPar& p) {
    const int tid = otid(), lane = tid & 63, gw = blockIdx.x * 8 + (tid >> 6), nw = gridDim.x * 8;
    float* h3 = p.out; const bf16_t* y = (const bf16_t*)(p.ws + WS_Y); const float* g = p.in[3];
    for (int t = gw; t < T; t += nw) {
        f32x4 x[8]; float ss = 0.f;
#pragma unroll
        for (int j = 0; j < 8; ++j) {
            const int d0 = (j * 64 + lane) * 4;
            x[j] = *(const f32x4*)(h3 + (size_t)t * D + d0);
            const u32x2 a = *(const u32x2*)(y + (size_t)(2 * t) * D + d0), b = *(const u32x2*)(y + (size_t)(2 * t + 1) * D + d0);
            x[j][0] += bflo(a.x) + bflo(b.x); x[j][1] += bfhi(a.x) + bfhi(b.x); x[j][2] += bflo(a.y) + bflo(b.y); x[j][3] += bfhi(a.y) + bfhi(b.y);
            ss += x[j][0] * x[j][0] + x[j][1] * x[j][1] + x[j][2] * x[j][2] + x[j][3] * x[j][3];
        }
        ss = wave_sum(ss);
        const float inv = rsqrtf(ss * (1.f / D) + 1e-6f);
#pragma unroll
        for (int j = 0; j < 8; ++j) {
            const int d0 = (j * 64 + lane) * 4;
            const f32x4 gv = *(const f32x4*)(g + d0);
            f32x4 o = {x[j][0] * inv * gv[0], x[j][1] * inv * gv[1], x[j][2] * inv * gv[2], x[j][3] * inv * gv[3]};
            *(f32x4*)(h3 + (size_t)t * D + d0) = o;
        }
    }
}

constexpr int NPH = 19;
extern __shared__ __attribute__((aligned(16))) char smem[];
__global__ void __launch_bounds__(NTHR, 2) fwd(Params p_unused, int lo, int hi) {
    LAS char* lds = (LAS char*)smem;
    CPar* pp = (CPar*)__builtin_amdgcn_kernarg_segment_ptr();
    if (threadIdx.x == 0) *(LAS u32x4*)(lds + LDS_XB) = (u32x4){0u, 0u, 0u, 0u};
    __syncthreads();
    XcdBarrier bar;
    const bool multi = (hi - lo) > 1;
    if (multi) bar = xcd_barrier_post((unsigned*)(pp->ws + WS_CTL) + CW_BAR, (volatile LAS unsigned*)(lds + LDS_XB));
#define IN(k) (lo <= (k) && (k) < hi)
#define SEAM(k) do { if (IN(k) && IN((k) + 1)) xcd_barrier(bar); } while (0)
#define PHASE(k, call) do { if (IN(k)) { asm volatile("" : "+s"(pp)); CPar& p = *pp; call; } } while (0)
    PHASE(0, ph_prologue(p, lds));
    SEAM(0);
    PHASE(1, ph_qkv(p, lds));
    SEAM(1);
    PHASE(2, ph_attn(p, lds));
    SEAM(2);
    PHASE(3, ph_oproj(p, lds, (const bf16_t*)(p.ws + WS_AO), (const bf16_t*)(p.ws + WS_WONA), p.in[8], p.in[0], p.out));
    SEAM(3);
    PHASE(4, ph_router(p, p.out, 0));
    SEAM(4);
    PHASE(6, ph_moe(p, lds, 0));
    SEAM(6);
    PHASE(7, ph_combine_mix(p));
    SEAM(7);
    PHASE(9, ph_rwkv_proj(p, lds));
    SEAM(9);
    PHASE(11, ph_gate(p, lds));
    PHASE(11, ph_scan_prep(p, lds));
    SEAM(11);
    PHASE(12, ph_scan_state(p));
    SEAM(12);
    PHASE(13, ph_scan_out(p, lds));
    SEAM(13);
    PHASE(14, ph_oproj(p, lds, (const bf16_t*)(p.ws + WS_Z), (const bf16_t*)(p.ws + WS_WORW), nullptr, (const float*)(p.ws + WS_HB), p.out));
    SEAM(14);
    PHASE(15, ph_router(p, p.out, 1));
    SEAM(15);
    PHASE(17, ph_moe(p, lds, 1));
    SEAM(17);
    PHASE(18, ph_final(p));
}

extern "C" void kernel_launch(void* const* d_in, const int* in_sizes, int n_in, void* d_out, int out_size, void* d_ws, size_t ws_size, hipStream_t stream) {
    static int grid = 0;
    if (grid == 0) {
        if (n_in != 34 || out_size != T * D || ws_size < WS_END) { fprintf(stderr, "kernel_launch: unexpected shapes (n_in %d out %d ws %zu)\n", n_in, out_size, ws_size); grid = -1; return; }
        int dev = 0, cus = 0, per_cu = 0;
        if (hipGetDevice(&dev) != hipSuccess || hipDeviceGetAttribute(&cus, hipDeviceAttributeMultiprocessorCount, dev) != hipSuccess) { grid = -1; return; }
        if (hipFuncSetAttribute((const void*)fwd, hipFuncAttributeMaxDynamicSharedMemorySize, LDS_BYTES) != hipSuccess) { fprintf(stderr, "kernel_launch: hipFuncSetAttribute failed\n"); grid = -1; return; }
        if (hipOccupancyMaxActiveBlocksPerMultiprocessor(&per_cu, (const void*)fwd, NTHR, LDS_BYTES) != hipSuccess || per_cu < 1) { fprintf(stderr, "kernel_launch: occupancy query failed (%d)\n", per_cu); grid = -1; return; }
        if (cus < 256) { fprintf(stderr, "kernel_launch: built for a 256-CU device (got %d)\n", cus); grid = -1; return; }
        grid = 256;
    }
    if (grid < 0) return;
    (void)hipMemsetAsync((char*)d_ws + WS_CTL, 0, 1 * MiB, stream);
    Params p{};
    for (int i = 0; i < 34; ++i) p.in[i] = (const float*)d_in[i];
    p.out = (float*)d_out; p.ws = (unsigned char*)d_ws;
#if MK_FUSED
    hipLaunchKernelGGL(fwd, dim3(grid), dim3(NTHR), LDS_BYTES, stream, p, 0, NPH);
#else
    for (int k = 0; k < NPH; ++k) hipLaunchKernelGGL(fwd, dim3(grid), dim3(NTHR), LDS_BYTES, stream, p, k, k + 1);
#endif
}
```

```cpp
#include <hip/hip_runtime.h>
#include <cstdint>
#include <cstdio>

#define LAS __attribute__((address_space(3)))
typedef unsigned short bf16_t;
typedef short bf16x8 __attribute__((ext_vector_type(8)));
typedef float f32x4 __attribute__((ext_vector_type(4)));
typedef float f32x16 __attribute__((ext_vector_type(16)));
typedef unsigned u32x4 __attribute__((ext_vector_type(4)));
typedef unsigned u32x2 __attribute__((ext_vector_type(2)));

constexpr int T = 8192, D = 2048, NH = 32, HD = 64, GW = 64, ROWS = 128;
constexpr int NEXP = 32, FF = 512;
constexpr int NTHR = 512;
#ifndef MK_FUSED
#define MK_FUSED 1
#endif

constexpr size_t MiB = 1u << 20;
constexpr size_t WS_CTL = 0;
constexpr size_t WS_LIST = 1 * MiB;
constexpr size_t WS_CW = 3 * MiB;
constexpr size_t WS_RGF = 3 * MiB + 256 * 1024;
constexpr size_t WS_REF = 3 * MiB + 384 * 1024;
constexpr size_t WS_WQKV = 4 * MiB;
constexpr size_t WS_WONA = 28 * MiB;
constexpr size_t WS_WR = 36 * MiB, WS_WK = 44 * MiB, WS_WV = 52 * MiB, WS_WORW = 60 * MiB;
constexpr size_t WS_W1T = 68 * MiB, WS_A1T = 69 * MiB, WS_G1T = 70 * MiB;
constexpr size_t WS_W2T = 71 * MiB, WS_A2T = 72 * MiB;
constexpr size_t WS_G2T = 73 * MiB;
constexpr size_t WS_GB = 74 * MiB;
constexpr size_t WS_FB = 138 * MiB;
constexpr size_t WS_GYB = 330 * MiB;
constexpr size_t WS_HS = 394 * MiB;
constexpr size_t WS_HB = 458 * MiB;
constexpr size_t WS_HN = 522 * MiB;
constexpr size_t WS_SBON = 522 * MiB;
constexpr size_t WS_ACT = 554 * MiB;
constexpr size_t WS_ACT1 = 666 * MiB;
constexpr size_t WS_Y = 570 * MiB;
constexpr size_t WS_Z = 570 * MiB;
constexpr size_t WS_FYB = 602 * MiB;
constexpr size_t WS_Q = 634 * MiB, WS_K = 666 * MiB, WS_VT = 698 * MiB, WS_AO = 730 * MiB;
constexpr size_t WS_MIX = 698 * MiB;
constexpr size_t WS_G = 698 * MiB;
constexpr size_t WS_R = 890 * MiB, WS_K2 = 922 * MiB, WS_V2 = 954 * MiB;
constexpr size_t WS_LW = 986 * MiB, WS_LA = 990 * MiB, WS_GL = 994 * MiB;
constexpr size_t WS_END = 998 * MiB;

constexpr int CW_BAR = 4096;
constexpr int CW_CNT0 = 16384, CW_CNT1 = 16384 + 64;
constexpr int CW_MOEQ = 20480;
constexpr int CW_MOEMT = 24576;

constexpr int LDS_MISC = 159744;
constexpr int LDS_PREF = LDS_MISC;
constexpr int LDS_XB = LDS_MISC + 256;
constexpr int LDS_SEG = LDS_MISC + 512;
constexpr int LDS_ELEND = LDS_MISC + 1024;
constexpr int LDS_TILE_E = LDS_MISC + 2048;
constexpr int LDS_MOEQ = LDS_MISC + 3072;
constexpr int LDS_BYTES = 163840;

struct Params {
    const float* in[34];
    float* out;
    unsigned char* ws;
};
typedef const __attribute__((address_space(4))) Params CPar;

typedef float f32x2_t __attribute__((ext_vector_type(2)));
typedef __bf16 bf16x2_t __attribute__((ext_vector_type(2)));
__device__ __forceinline__ unsigned pk2(float lo, float hi) { const f32x2_t v = {lo, hi}; return __builtin_bit_cast(unsigned, __builtin_convertvector(v, bf16x2_t)); }
__device__ __forceinline__ unsigned f2bf(float f) { return pk2(f, 0.f) & 0xffffu; }
__device__ __forceinline__ float bflo(unsigned u) { return __builtin_bit_cast(float, u << 16); }
__device__ __forceinline__ float bfhi(unsigned u) { return __builtin_bit_cast(float, u & 0xffff0000u); }
__device__ __forceinline__ float bf2f(bf16_t b) { return __builtin_bit_cast(float, (unsigned)b << 16); }
__device__ __forceinline__ void lds_barrier() { asm volatile("s_waitcnt lgkmcnt(0)" ::: "memory"); __builtin_amdgcn_s_barrier(); asm volatile("" ::: "memory"); }
__device__ __forceinline__ float wave_sum(float v) {
#pragma unroll
    for (int o = 32; o; o >>= 1) v += __shfl_xor(v, o);
    return v;
}
__device__ __forceinline__ int otid() { int t = threadIdx.x; asm volatile("" : "+v"(t)); return t; }
__device__ __forceinline__ float tanhf_(float x) { return 1.f - 2.f * __builtin_amdgcn_rcpf(1.f + __expf(2.f * x)); }
__device__ __forceinline__ float sigmoidf_(float x) { return __builtin_amdgcn_rcpf(1.f + __expf(-x)); }

#define XB_TMO      128
#define XB_XCNT(j)  (256  + 64 * (j))
#define XB_XSUB(j)  (1280 + 64 * (j))
#define XB_XGEN(j)  (2304 + 64 * (j))
#define XB_TOP      3328
#define XB_TOPGEN   3392
#define XCD_BAR_WORDS 3456
#define XB_SPIN_CAP (1u << 18)
__device__ __forceinline__ unsigned xb_ld(unsigned* p)              { return __hip_atomic_load(p, __ATOMIC_RELAXED, __HIP_MEMORY_SCOPE_AGENT); }
__device__ __forceinline__ unsigned xb_add(unsigned* p, unsigned v) { return __hip_atomic_fetch_add(p, v, __ATOMIC_RELAXED, __HIP_MEMORY_SCOPE_AGENT); }
__device__ __forceinline__ unsigned xb_xcc_id() { return (unsigned)__builtin_amdgcn_s_getreg((3 << 11) | 20) & 0xFu; }
#define XB_SPIN(cond, bar) do { unsigned _sp = 0; while (cond) { __builtin_amdgcn_s_sleep(1); \
    if ((++_sp & 255u) == 0u) { if (xb_ld(&(bar)[XB_TMO])) break; if (_sp > XB_SPIN_CAP) { atomicAdd(&(bar)[XB_TMO], 1u); break; } } } } while (0)
struct XcdBarrier { unsigned* bar; unsigned x; volatile LAS unsigned* st; };
__device__ __forceinline__ XcdBarrier xcd_barrier_post(unsigned* bar, volatile LAS unsigned* st) {
    XcdBarrier b; b.bar = bar; b.x = xb_xcc_id(); b.st = st;
    if (threadIdx.x == 0) (void)xb_add(&bar[XB_XCNT(b.x)], 1u);
    return b;
}
__device__ __forceinline__ void xcd_barrier_complete(unsigned* bar, unsigned x, unsigned& nloc, unsigned& nx) {
    const unsigned G = gridDim.x * gridDim.y * gridDim.z;
    unsigned sum, cnt, mine, sp = 0u;
    for (;;) {
        sum = 0u; cnt = 0u; mine = 0u;
#pragma unroll
        for (unsigned j = 0; j < 16; ++j) { const unsigned c = xb_ld(&bar[XB_XCNT(j)]); sum += c; cnt += (c > 0u) ? 1u : 0u; mine = (j == x) ? c : mine; }
        if (sum == G) break;
        __builtin_amdgcn_s_sleep(1);
        if ((++sp & 255u) == 0u) { if (xb_ld(&bar[XB_TMO])) break; if (sp > XB_SPIN_CAP) { atomicAdd(&bar[XB_TMO], 1u); break; } }
    }
    nloc = mine > 0u ? mine : 1u; nx = cnt > 0u ? cnt : 1u;
}
__device__ __forceinline__ void xcd_barrier(const XcdBarrier& b) {
    asm volatile("s_waitcnt vmcnt(0)" ::: "memory");
    __syncthreads();
    if (threadIdx.x == 0) {
        unsigned* bar = b.bar;
        __builtin_amdgcn_s_waitcnt(0);
        unsigned nloc = b.st[0], nx = b.st[1];
        if (nloc == 0u) { xcd_barrier_complete(bar, b.x, nloc, nx); b.st[0] = nloc; b.st[1] = nx; }
        const unsigned old = xb_add(&bar[XB_XSUB(b.x)], 1u);
        const unsigned gen = old / nloc;
        if (old + 1u == (gen + 1u) * nloc) {
            __builtin_amdgcn_fence(__ATOMIC_RELEASE, "agent");
            asm volatile("s_waitcnt vmcnt(0)" ::: "memory");
            const unsigned og = xb_add(&bar[XB_TOP], 1u);
            const unsigned tg = og / nx;
            if (og + 1u == (tg + 1u) * nx) xb_add(&bar[XB_TOPGEN], 1u);
            else XB_SPIN(xb_ld(&bar[XB_TOPGEN]) == tg, bar);
            __builtin_amdgcn_fence(__ATOMIC_ACQUIRE, "agent");
            xb_add(&bar[XB_XGEN(b.x)], 1u);
            asm volatile("s_waitcnt vmcnt(0)" ::: "memory");
        } else {
            XB_SPIN(xb_ld(&bar[XB_XGEN(b.x)]) == gen, bar);
            __builtin_amdgcn_fence(__ATOMIC_ACQUIRE, "agent");
            asm volatile("s_waitcnt vmcnt(0)" ::: "memory");
        }
    }
    __syncthreads();
}

template <class Epi>
__device__ __forceinline__ void gemm_tile_moe(const int tid, LAS char* lds, const bf16_t* __restrict__ A, int lda, const int* __restrict__ rows, int nvalid, int rshift,
                                              const float* __restrict__ bsrc, int ldn, int K, const Epi& epi) {
    const int lane = tid & 63, wid = tid >> 6, wm = wid >> 1, wn = wid & 1;
    const int srow = tid >> 3, sch = tid & 7;
    unsigned offA[4];
#pragma unroll
    for (int i = 0; i < 4; ++i) {
        const int r = srow + i * 64;
        const int rr = r < nvalid ? r : 0;
        offA[i] = (unsigned)(rows[rr] >> rshift) * (unsigned)lda + sch * 8;
    }
#define MOE_KEY(r_) ((((r_) >> 2) & 7) ^ ((((r_) >> 1) & 1) << 2))
    const unsigned ldsw = srow * 128 + ((sch ^ MOE_KEY(srow)) << 4);
    const int nq = tid & 31, kq = tid >> 5;
    unsigned ldsb[4];
#pragma unroll
    for (int c = 0; c < 4; ++c) { const int rho = nq * 4 + c; ldsb[c] = 32768u + rho * 128 + ((((kq >> 1)) ^ MOE_KEY(rho)) << 4) + (kq & 1) * 8; }
    const float* bp = bsrc + (size_t)(kq * 4) * ldn;
    const int l31 = lane & 31, lh = lane >> 5, key = MOE_KEY(l31);
    const unsigned ra = (wm * 64 + l31) * 128;
    const unsigned rb = 32768 + (wn * 64 + l31) * 128;
    unsigned kc[4];
#pragma unroll
    for (int ks = 0; ks < 4; ++ks) kc[ks] = ((ks * 2 + lh) ^ key) << 4;
    f32x16 acc[2][2];
#pragma unroll
    for (int mi = 0; mi < 2; ++mi)
#pragma unroll
        for (int nj = 0; nj < 2; ++nj)
#pragma unroll
            for (int e = 0; e < 16; ++e) acc[mi][nj][e] = 0.f;
    u32x4 xa[4], ya[4]; f32x4 xb[4], yb[4];
    const int nt = K >> 6;
#define MOE_LOAD(ra_, rb_, tt) do { _Pragma("unroll") for (int i = 0; i < 4; ++i) { ra_[i] = *(const u32x4*)(A + offA[i] + (tt) * 64); rb_[i] = *(const f32x4*)(bp + (size_t)((tt) * 64 + i) * ldn); } } while (0)
#define MOE_STORE(ra_, rb_, so_) do { _Pragma("unroll") for (int i = 0; i < 4; ++i) *(LAS u32x4*)(lds + (so_) + ldsw + i * 8192) = ra_[i]; \
        _Pragma("unroll") for (int c = 0; c < 4; ++c) { u32x2 o; o.x = pk2(rb_[0][c], rb_[1][c]); o.y = pk2(rb_[2][c], rb_[3][c]); *(LAS u32x2*)(lds + (so_) + ldsb[c]) = o; } } while (0)
#define MOE_FRAGS(so_, ks, AF, BQ) do { _Pragma("unroll") for (int mi = 0; mi < 2; ++mi) AF[mi] = *(const LAS bf16x8*)(lds + (so_) + ra + mi * 4096 + kc[ks]); \
        _Pragma("unroll") for (int nj = 0; nj < 2; ++nj) BQ[nj] = *(const LAS bf16x8*)(lds + (so_) + rb + nj * 4096 + kc[ks]); } while (0)
#define MOE_MMA(AF, BQ) do { _Pragma("unroll") for (int mi = 0; mi < 2; ++mi) _Pragma("unroll") for (int nj = 0; nj < 2; ++nj) \
        acc[mi][nj] = __builtin_amdgcn_mfma_f32_32x32x16_bf16(BQ[nj], AF[mi], acc[mi][nj], 0, 0, 0); } while (0)
#define MOE_SB __builtin_amdgcn_sched_barrier(0)
#define MOE_COMPUTE(so_) do { bf16x8 afA[2], bqA[2], afB[2], bqB[2]; \
        MOE_FRAGS(so_, 0, afA, bqA); MOE_FRAGS(so_, 1, afB, bqB); MOE_SB; MOE_MMA(afA, bqA); MOE_SB; \
        MOE_FRAGS(so_, 2, afA, bqA); MOE_SB; MOE_MMA(afB, bqB); MOE_SB; \
        MOE_FRAGS(so_, 3, afB, bqB); MOE_SB; MOE_MMA(afA, bqA); MOE_SB; MOE_MMA(afB, bqB); } while (0)
#define MOE_STEP(tt, SA_, SB_, LA_, LB_) do { \
        if ((tt) + 2 < nt) MOE_LOAD(LA_, LB_, (tt) + 2); \
        __builtin_amdgcn_sched_barrier(0); \
        MOE_COMPUTE(((tt) & 1) * 49152u); \
        __builtin_amdgcn_sched_barrier(0); \
        if ((tt) + 1 < nt) MOE_STORE(SA_, SB_, (((tt) + 1) & 1) * 49152u); \
        __syncthreads(); } while (0)
    MOE_LOAD(xa, xb, 0);
    MOE_STORE(xa, xb, 0u);
    if (nt > 1) MOE_LOAD(xa, xb, 1);
    __syncthreads();
    for (int t = 0; t < nt; t += 8) {
        MOE_STEP(t, xa, xb, ya, yb); MOE_STEP(t + 1, ya, yb, xa, xb); MOE_STEP(t + 2, xa, xb, ya, yb); MOE_STEP(t + 3, ya, yb, xa, xb);
        MOE_STEP(t + 4, xa, xb, ya, yb); MOE_STEP(t + 5, ya, yb, xa, xb); MOE_STEP(t + 6, xa, xb, ya, yb); MOE_STEP(t + 7, ya, yb, xa, xb);
    }
#undef MOE_STEP
#undef MOE_COMPUTE
#undef MOE_FRAGS
#undef MOE_MMA
#undef MOE_SB
#undef MOE_LOAD
#undef MOE_STORE
#undef MOE_KEY
    epi(acc, wm, wn, l31, lh);
}

typedef __attribute__((address_space(1))) unsigned gu32;
struct EpiMoeGU3 {
    bf16_t* act; const float* cw; const int* rows; int nvalid; int f0; LAS char* lds; int tid; gu32* mtc;
    __device__ __forceinline__ void operator()(const f32x16 (&acc)[2][2], int wm, int wn, int l31, int lh) const {
#pragma unroll
        for (int mi = 0; mi < 2; ++mi) {
            const int ml = wm * 64 + mi * 32 + l31;
            const float w = ml < nvalid ? cw[rows[ml]] : 0.f;
#pragma unroll
            for (int rg = 0; rg < 4; ++rg) {
                float o[4];
#pragma unroll
                for (int e = 0; e < 4; ++e) { const float g = acc[mi][0][4 * rg + e], u = acc[mi][1][4 * rg + e]; o[e] = g * sigmoidf_(g) * u * w; }
                u32x2 ov; ov.x = pk2(o[0], o[1]); ov.y = pk2(o[2], o[3]);
                *(LAS u32x2*)(lds + ml * 144 + (wn * 32 + 8 * rg + 4 * lh) * 2) = ov;
            }
        }
        __syncthreads();
        const __amdgpu_buffer_rsrc_t rs = __builtin_amdgcn_make_buffer_rsrc((void*)act, 0, 2 * T * FF * 2, 0x00020000);
#pragma unroll
        for (int i = 0; i < 4; ++i) {
            const int row = (tid >> 3) + 64 * i, pc = tid & 7;
            if (row < nvalid) {
                const u32x4 v = *(const LAS u32x4*)(lds + row * 144 + pc * 16);
                __builtin_amdgcn_raw_buffer_store_b128(v, rs, (rows[row] * FF + f0 + pc * 8) * 2, 0,   16);
            }
        }
        asm volatile("s_waitcnt vmcnt(0)" ::: "memory");
        if ((tid & 63) == 0) (void)__hip_atomic_fetch_add(mtc, 1u, __ATOMIC_RELAXED, __HIP_MEMORY_SCOPE_AGENT);
        __syncthreads();
    }
};
struct EpiMoeD2 {
    bf16_t* y; const int* rows; int nvalid; int n0; LAS char* lds; int tid;
    __device__ __forceinline__ void operator()(const f32x16 (&acc)[2][2], int wm, int wn, int l31, int lh) const {
#pragma unroll
        for (int mi = 0; mi < 2; ++mi) {
            const int ml = wm * 64 + mi * 32 + l31;
#pragma unroll
            for (int nj = 0; nj < 2; ++nj)
#pragma unroll
                for (int rg = 0; rg < 4; ++rg) {
                    u32x2 o; o.x = pk2(acc[mi][nj][4 * rg], acc[mi][nj][4 * rg + 1]); o.y = pk2(acc[mi][nj][4 * rg + 2], acc[mi][nj][4 * rg + 3]);
                    *(LAS u32x2*)(lds + ml * 272 + (wn * 64 + nj * 32 + 8 * rg + 4 * lh) * 2) = o;
                }
        }
        __syncthreads();
#pragma unroll
        for (int i = 0; i < 8; ++i) {
            const int row = (tid >> 4) + 32 * i, pc = tid & 15;
            if (row < nvalid) {
                const u32x4 v = *(const LAS u32x4*)(lds + row * 272 + pc * 16);
                *(u32x4*)(y + (size_t)rows[row] * D + n0 + pc * 8) = v;
            }
        }
        __syncthreads();
    }
};
namespace pg8 {
#define PG8_LAS __attribute__((address_space(3)))
typedef unsigned short bf16_t;
typedef short bf16x8 __attribute__((ext_vector_type(8)));
typedef float f32x4 __attribute__((ext_vector_type(4)));
typedef unsigned u32x4 __attribute__((ext_vector_type(4)));
constexpr int BM = 256, BK = 64, HALF = 128, HTB = HALF * BK * 2  , STAGE_BYTES = 8 * HTB, NXCD = 8, WGM = 8;

__host__ __device__ __forceinline__ int lds_byte(int r, int c) { const int st = (r >> 4) * 2 + (c >> 5), rr = r & 15, cc = c & 31, ob = rr * 64 + cc * 2; return st * 1024 + (ob ^ (((ob >> 9) & 1) << 5)); }
__host__ __device__ __forceinline__ void stage_rc(int b, int& R, int& C) { const int st = b / 1024, sb = b % 1024, swz = sb ^ (((sb >> 9) & 1) << 5); R = (st >> 1) * 16 + swz / 64; C = (st & 1) * 32 + (swz % 64) / 2; }
__host__ __device__ __forceinline__ int perm32(int rho) { const int n = rho >> 4, i = rho & 15; return 8 * (i >> 2) + 4 * n + (i & 3); }

struct Unit { int pm, pn; };
struct Gemm { const bf16_t* A; const bf16_t* Bt; int M, N, K; };

struct StaticOrder {
    int nM, nN, nwg, G, c;
    __host__ __device__ void init(int M, int N, int G_, int c_) { nM = M / BM; nN = N / BM; nwg = nM * nN; G = G_; c = c_; }
    __host__ __device__ bool next(int i, Unit& u) const {
        const long L = (long)i * G + c; if (L >= nwg) return false;
        int wgid = (int)L; { const int q = nwg / NXCD, r = nwg % NXCD, xcd = wgid % NXCD, off = wgid / NXCD; wgid = (xcd < r ? xcd * (q + 1) : r * (q + 1) + (xcd - r) * q) + off; }
        const int nig = WGM * nN, gid = wgid / nig, fm = gid * WGM, gsz = (nM - fm) < WGM ? (nM - fm) : WGM;
        u.pm = fm + ((wgid % nig) % gsz); u.pn = (wgid % nig) / gsz; return true;
    }
    __device__ __forceinline__ void a_ready(const Unit&) const {}
    __device__ __forceinline__ void done(const Unit&) const {}
};

__device__ __forceinline__ unsigned cvt_pk_bf16(float lo, float hi) { unsigned r; asm volatile("v_cvt_pk_bf16_f32 %0, %1, %2" : "=v"(r) : "v"(lo), "v"(hi)); return r; }

template <class Epi, class Sched, bool ALIGN_EPI = false, bool SP2 = false>
__device__ __forceinline__ void gemm_phase(const int tid, PG8_LAS unsigned char* lds, const Gemm g, const Sched& S, const Epi& E) {
    const int wid = __builtin_amdgcn_readfirstlane(tid >> 6), lane = tid & 63, wr = wid >> 2, wc = wid & 3, fr = lane & 15, fq = lane >> 4;
    const int K = g.K, nt = K / BK;
    unsigned voffA[2], voffB[2];
#pragma unroll
    for (int i = 0; i < 2; ++i) { int R, C; stage_rc(tid * 16 + i * 8192, R, C); const int Rb = Epi::PERM ? ((R & ~31) + perm32(R & 31)) : R;
        voffA[i] = (unsigned)(R * K + C) * 2u; voffB[i] = (unsigned)(Rb * K + C) * 2u; }
    const size_t kstep = (size_t)(BK * 2);
    const size_t hstep = (size_t)HALF * K * 2;
    const size_t tstep = 2 * hstep;
    const unsigned ldsw = (unsigned)wid * 1024u;
    const int aoff = lds_byte(wr * 64 + fr, fq * 8), boff = lds_byte(wc * 32 + fr, fq * 8);
#define PG8_SA(b, h) (((b) * 2 + (h)) * HTB)
#define PG8_SB(b, h) ((4 + (b) * 2 + (h)) * HTB)
#define PG8_STAGE(bufoff, gbase, voff) do { _Pragma("unroll") for (int _i = 0; _i < 2; ++_i) \
        __builtin_amdgcn_global_load_lds((const unsigned*)((const char*)(gbase) + (voff)[_i]), (PG8_LAS unsigned*)(lds + (bufoff) + ldsw + _i * 8192), 16, 0, 0); } while (0)
#define PG8_LDA(dst, b, h) do { _Pragma("unroll") for (int m = 0; m < 4; ++m) _Pragma("unroll") for (int k = 0; k < 2; ++k) dst[m][k] = *(const PG8_LAS bf16x8*)(lds + PG8_SA(b, h) + aoff + m * 2048 + k * 1024); } while (0)
#define PG8_LDB(dst, b, h) do { _Pragma("unroll") for (int n = 0; n < 2; ++n) _Pragma("unroll") for (int k = 0; k < 2; ++k) dst[n][k] = *(const PG8_LAS bf16x8*)(lds + PG8_SB(b, h) + boff + n * 2048 + k * 1024); } while (0)
#define PG8_MMA(ai, bj, At, Bt) do { __builtin_amdgcn_s_setprio(1); _Pragma("unroll") for (int m = 0; m < 4; ++m) _Pragma("unroll") for (int n = 0; n < 2; ++n) _Pragma("unroll") for (int k = 0; k < 2; ++k) \
        acc[ai][bj][m][n] = __builtin_amdgcn_mfma_f32_16x16x32_bf16(Bt[n][k], At[m][k], acc[ai][bj][m][n], 0, 0, 0); __builtin_amdgcn_s_setprio(0); } while (0)
#define PG8_WAIT_V(n) asm volatile("s_waitcnt vmcnt(" #n ")" ::: "memory")
#define PG8_WAIT_L(n) asm volatile("s_waitcnt lgkmcnt(" #n ")" ::: "memory")
#define PG8_BAR __builtin_amdgcn_s_barrier()
#define PG8_SCHED __builtin_amdgcn_sched_barrier(0)
    Unit cur, nxt; int ui = 0;
    if (!S.next(0, cur)) return;
    f32x4 acc[2][2][4][2];
#pragma unroll
    for (int a = 0; a < 2; ++a)
#pragma unroll
        for (int b = 0; b < 2; ++b)
#pragma unroll
            for (int m = 0; m < 4; ++m)
#pragma unroll
                for (int n = 0; n < 2; ++n) acc[a][b][m][n] = (f32x4){0.f, 0.f, 0.f, 0.f};
    bf16x8 At[4][2], B0[2][2], B1[2][2];
    const char* cA = (const char*)g.A + (size_t)cur.pm * tstep; const char* cB = (const char*)g.Bt + (size_t)cur.pn * tstep;
    S.a_ready(cur);
    if constexpr (SP2) {
        PG8_STAGE(PG8_SB(0, 0), cB, voffB); PG8_STAGE(PG8_SB(0, 1), cB + hstep, voffB); PG8_STAGE(PG8_SA(0, 0), cA, voffA); PG8_STAGE(PG8_SA(0, 1), cA + hstep, voffA);
        if (wr == 1) PG8_BAR;
        PG8_WAIT_V(2); PG8_BAR;
        PG8_STAGE(PG8_SB(1, 0), cB + kstep, voffB); PG8_STAGE(PG8_SA(1, 0), cA + kstep, voffA); PG8_STAGE(PG8_SB(1, 1), cB + hstep + kstep, voffB);
        PG8_WAIT_V(6); PG8_BAR;
    } else {
        PG8_STAGE(PG8_SB(0, 0), cB, voffB); PG8_STAGE(PG8_SA(0, 0), cA, voffA); PG8_STAGE(PG8_SB(0, 1), cB + hstep, voffB); PG8_STAGE(PG8_SA(0, 1), cA + hstep, voffA);
        if (wr == 1) PG8_BAR;
        PG8_WAIT_V(4); PG8_BAR;
        PG8_STAGE(PG8_SB(1, 0), cB + kstep, voffB); PG8_STAGE(PG8_SA(1, 0), cA + kstep, voffA); PG8_STAGE(PG8_SB(1, 1), cB + hstep + kstep, voffB);
        PG8_WAIT_V(6); PG8_BAR;
    }
    for (;;) {
        const bool has_next = S.next(ui + 1, nxt);
        const char* nA = has_next ? (const char*)g.A + (size_t)nxt.pm * tstep : cA; const char* nB = has_next ? (const char*)g.Bt + (size_t)nxt.pn * tstep : cB;
        for (int t = 0; t < nt; t += 2) {
            const bool last = (t == nt - 2);
            const char* a1 = cA + (size_t)(t + 1) * kstep;
            const char* a2 = last ? nA : cA + (size_t)(t + 2) * kstep; const char* b2 = last ? nB : cB + (size_t)(t + 2) * kstep;
            const char* a3 = a2 + kstep; const char* b3 = b2 + kstep;
            if (last && has_next) S.a_ready(nxt);
            if constexpr (SP2) {
            PG8_LDB(B0, 0, 0); PG8_LDB(B1, 0, 1); PG8_SCHED; PG8_LDA(At, 0, 0); PG8_STAGE(PG8_SA(1, 1), a1 + hstep, voffA);
            PG8_WAIT_V(8); PG8_WAIT_L(0); PG8_BAR; PG8_MMA(0, 0, At, B0); PG8_MMA(0, 1, At, B1); PG8_BAR; PG8_SCHED;
            PG8_LDA(At, 0, 1); PG8_STAGE(PG8_SB(0, 0), b2, voffB); PG8_STAGE(PG8_SB(0, 1), b2 + hstep, voffB); PG8_STAGE(PG8_SA(0, 0), a2, voffA);
            PG8_WAIT_V(8); PG8_WAIT_L(0); PG8_BAR; PG8_MMA(1, 0, At, B0); PG8_MMA(1, 1, At, B1); PG8_BAR; PG8_SCHED;
            PG8_LDB(B0, 1, 0); PG8_LDB(B1, 1, 1); PG8_SCHED; PG8_LDA(At, 1, 0); PG8_STAGE(PG8_SA(0, 1), a2 + hstep, voffA);
            PG8_WAIT_V(8); PG8_WAIT_L(0); PG8_BAR; PG8_MMA(0, 0, At, B0); PG8_MMA(0, 1, At, B1); PG8_BAR; PG8_SCHED;
            PG8_LDA(At, 1, 1); PG8_STAGE(PG8_SB(1, 0), b3, voffB); PG8_STAGE(PG8_SB(1, 1), b3 + hstep, voffB); PG8_STAGE(PG8_SA(1, 0), a3, voffA);
            PG8_WAIT_V(8); PG8_WAIT_L(0); PG8_BAR; PG8_MMA(1, 0, At, B0); PG8_MMA(1, 1, At, B1); PG8_BAR; PG8_SCHED;
            } else {
            PG8_LDB(B0, 0, 0); PG8_SCHED; PG8_LDA(At, 0, 0); PG8_STAGE(PG8_SA(1, 1), a1 + hstep, voffA);
            PG8_WAIT_L(8); PG8_BAR; PG8_WAIT_L(0); PG8_MMA(0, 0, At, B0); PG8_BAR; PG8_SCHED;
            PG8_LDB(B1, 0, 1); PG8_STAGE(PG8_SB(0, 0), b2, voffB);
            PG8_BAR; PG8_WAIT_L(0); PG8_MMA(0, 1, At, B1); PG8_BAR;
            PG8_LDA(At, 0, 1); PG8_STAGE(PG8_SA(0, 0), a2, voffA);
            PG8_BAR; PG8_WAIT_L(0); PG8_MMA(1, 0, At, B0); PG8_BAR; PG8_SCHED;
            PG8_STAGE(PG8_SB(0, 1), b2 + hstep, voffB);
            PG8_WAIT_V(6); PG8_BAR; PG8_MMA(1, 1, At, B1); PG8_BAR;
            PG8_LDB(B0, 1, 0); PG8_SCHED; PG8_LDA(At, 1, 0); PG8_STAGE(PG8_SA(0, 1), a2 + hstep, voffA);
            PG8_WAIT_L(8); PG8_BAR; PG8_WAIT_L(0); PG8_MMA(0, 0, At, B0); PG8_BAR; PG8_SCHED;
            PG8_LDB(B1, 1, 1); PG8_STAGE(PG8_SB(1, 0), b3, voffB);
            PG8_BAR; PG8_WAIT_L(0); PG8_MMA(0, 1, At, B1); PG8_BAR;
            PG8_LDA(At, 1, 1); PG8_STAGE(PG8_SA(1, 0), a3, voffA);
            PG8_BAR; PG8_WAIT_L(0); PG8_MMA(1, 0, At, B0); PG8_BAR; PG8_SCHED;
            PG8_STAGE(PG8_SB(1, 1), b3 + hstep, voffB);
            PG8_WAIT_V(6); PG8_BAR; PG8_MMA(1, 1, At, B1); PG8_BAR;
            }
        }
        if constexpr (ALIGN_EPI) { if (wr == 0) PG8_BAR; }
        if constexpr (!Epi::AFTER_DRAIN) { E(acc, cur, wr, wc, fr, fq); S.done(cur); }
        if (!has_next) break;
#pragma unroll
        for (int a = 0; a < 2; ++a)
#pragma unroll
            for (int b = 0; b < 2; ++b)
#pragma unroll
                for (int m = 0; m < 4; ++m)
#pragma unroll
                    for (int n = 0; n < 2; ++n) acc[a][b][m][n] = (f32x4){0.f, 0.f, 0.f, 0.f};
        cur = nxt; cA = nA; cB = nB; ++ui;
        if constexpr (ALIGN_EPI) { if (wr == 1) PG8_BAR; }
    }
    PG8_WAIT_V(0);
    if constexpr (!ALIGN_EPI) { if (wr == 0) PG8_BAR; }
    PG8_BAR;
    if constexpr (Epi::AFTER_DRAIN) { E.fused(acc, cur, wr, wc, fr, fq, lds, wid, lane); S.done(cur); }
#undef PG8_SA
#undef PG8_SB
#undef PG8_STAGE
#undef PG8_LDA
#undef PG8_LDB
#undef PG8_MMA
#undef PG8_WAIT_V
#undef PG8_WAIT_L
#undef PG8_BAR
#undef PG8_SCHED
}

struct PEpiQK {
    static constexpr bool PERM = true, AFTER_DRAIN = false;
    bf16_t* q; bf16_t* k; const float* bias;
    __device__ __forceinline__ void operator()(const f32x4 (&acc)[2][2][4][2], const Unit& u, int wr, int wc, int fr, int fq) const {
        const int row0 = u.pm * BM + wr * 64 + fr, colt = u.pn * BM;
        const bool isq = colt < 2048; const float sc = isq ? 0.125f : 1.f;
        const int cbase = (isq ? colt : colt - 2048) + wc * 32 + 8 * fq, bcol = colt + wc * 32 + 8 * fq;
#pragma unroll
        for (int bj = 0; bj < 2; ++bj) {
            const f32x4 b0 = *(const f32x4*)(bias + bcol + bj * HALF), b1 = *(const f32x4*)(bias + bcol + bj * HALF + 4);
            const int kc = cbase + bj * HALF, hh = kc >> 6, d0 = kc & 63;
#pragma unroll
            for (int ai = 0; ai < 2; ++ai)
#pragma unroll
                for (int m = 0; m < 4; ++m) {
                    const f32x4 v0 = (acc[ai][bj][m][0] + b0) * sc, v1 = (acc[ai][bj][m][1] + b1) * sc;
                    u32x4 w; w.x = cvt_pk_bf16(v0[0], v0[1]); w.y = cvt_pk_bf16(v0[2], v0[3]); w.z = cvt_pk_bf16(v1[0], v1[1]); w.w = cvt_pk_bf16(v1[2], v1[3]);
                    const int tok = row0 + ai * HALF + m * 16;
                    if (isq) *(u32x4*)(q + (size_t)tok * 2048 + kc) = w;
                    else { const int R = tok >> 6, c = tok & 63;
                        *(u32x4*)(k + ((((((size_t)(R * 32 + hh) * 8 + (c >> 3)) * 2 + ((c >> 2) & 1)) * 2 + (d0 >> 5)) * 4 + (c & 3)) * 4 + ((d0 >> 3) & 3)) * 8) = w; }
                }
        }
    }
};
struct PEpiVT {
    static constexpr bool PERM = true, AFTER_DRAIN = false;
    bf16_t* vt; const float* bias;
    __device__ __forceinline__ void operator()(const f32x4 (&acc)[2][2][4][2], const Unit& u, int wr, int wc, int fr, int fq) const {
        const int row0 = u.pm * BM + wr * 64 + fr, col0 = u.pn * BM + wc * 32 + 8 * fq;
#pragma unroll
        for (int ai = 0; ai < 2; ++ai)
#pragma unroll
            for (int m = 0; m < 4; ++m) {
                const int c = row0 + ai * HALF + m * 16; const float b = bias[c];
#pragma unroll
                for (int bj = 0; bj < 2; ++bj) {
                    const f32x4 v0 = acc[ai][bj][m][0] + b, v1 = acc[ai][bj][m][1] + b;
                    u32x4 w; w.x = cvt_pk_bf16(v0[0], v0[1]); w.y = cvt_pk_bf16(v0[2], v0[3]); w.z = cvt_pk_bf16(v1[0], v1[1]); w.w = cvt_pk_bf16(v1[2], v1[3]);
                    { const int tok = col0 + bj * HALF, R = tok >> 6, cgp = (tok & 63) >> 3;
                      *(u32x4*)(vt + ((((size_t)(R * 32 + (c >> 6)) * 8 + cgp) * 64 + (c & 63)) * 8)) = w; }
                }
            }
    }
};
struct PEpiResid {
    static constexpr bool PERM = false, AFTER_DRAIN = false;
    const float* src; float* dst; const float* bias;
    __device__ __forceinline__ void operator()(const f32x4 (&acc)[2][2][4][2], const Unit& u, int wr, int wc, int fr, int fq) const {
        const int row0 = u.pm * BM + wr * 64 + fr, col0 = u.pn * BM + wc * 32 + 4 * fq;
        f32x4 bv[2][2];
#pragma unroll
        for (int bj = 0; bj < 2; ++bj)
#pragma unroll
            for (int n = 0; n < 2; ++n) bv[bj][n] = bias ? *(const f32x4*)(bias + col0 + bj * HALF + n * 16) : (f32x4){0.f, 0.f, 0.f, 0.f};
#pragma unroll
        for (int ai = 0; ai < 2; ++ai)
#pragma unroll
            for (int mh = 0; mh < 2; ++mh) {
                f32x4 sv[2][2][2];
#pragma unroll
                for (int ml = 0; ml < 2; ++ml)
#pragma unroll
                    for (int bj = 0; bj < 2; ++bj)
#pragma unroll
                        for (int n = 0; n < 2; ++n) sv[ml][bj][n] = *(const f32x4*)(src + (size_t)(row0 + ai * HALF + (mh * 2 + ml) * 16) * 2048 + col0 + bj * HALF + n * 16);
                asm volatile("" ::: "memory");
#pragma unroll
                for (int ml = 0; ml < 2; ++ml)
#pragma unroll
                    for (int bj = 0; bj < 2; ++bj)
#pragma unroll
                        for (int n = 0; n < 2; ++n) *(f32x4*)(dst + (size_t)(row0 + ai * HALF + (mh * 2 + ml) * 16) * 2048 + col0 + bj * HALF + n * 16) = sv[ml][bj][n] + acc[ai][bj][mh * 2 + ml][n] + bv[bj][n];
                asm volatile("" ::: "memory");
            }
    }
};
struct PEpiRwkv {
    static constexpr bool PERM = true, AFTER_DRAIN = false;
    bf16_t* rkv;
    bf16_t* lw; bf16_t* la; bf16_t* gl;
    __device__ __forceinline__ void operator()(const f32x4 (&acc)[2][2][4][2], const Unit& u, int wr, int wc, int fr, int fq) const {
        const int which = u.pm >> 5, row0 = (u.pm & 31) * BM + wr * 64 + fr;
#pragma unroll
        for (int bj = 0; bj < 2; ++bj)
#pragma unroll
            for (int ai = 0; ai < 2; ++ai)
#pragma unroll
                for (int m = 0; m < 4; ++m) {
                    f32x4 v0 = acc[ai][bj][m][0], v1 = acc[ai][bj][m][1];
                    const int t = row0 + ai * HALF + m * 16;
                    bf16_t* dp;
                    if (which < 3) dp = rkv + (size_t)which * 8192 * 2048 + (size_t)t * 2048 + (u.pn - which * 8) * BM + bj * HALF + wc * 32 + 8 * fq;
                    else {
                        const int j = bj * HALF + wc * 32 + 8 * fq;
#pragma unroll
                        for (int e = 0; e < 4; ++e) {
                            if (which == 3) { v0[e] = tanhf_(v0[e]); v1[e] = tanhf_(v1[e]); }
                            else if (which == 5) { v0[e] = __builtin_amdgcn_rcpf(1.f + __expf(-v0[e])); v1[e] = __builtin_amdgcn_rcpf(1.f + __expf(-v1[e])); }
                        }
                        dp = which == 5 ? gl + (size_t)t * 256 + j : (which == 3 ? lw : la) + ((((size_t)(j >> 7) * 512 + (t >> 4)) * 4 + ((j & 127) >> 5)) * 64 + ((j >> 3) & 3) * 16 + (t & 15)) * 8;
                    }
                    u32x4 w; w.x = cvt_pk_bf16(v0[0], v0[1]); w.y = cvt_pk_bf16(v0[2], v0[3]); w.z = cvt_pk_bf16(v1[0], v1[1]); w.w = cvt_pk_bf16(v1[2], v1[3]);
                    *(u32x4*)dp = w;
                }
    }
};
struct PEpiPlain {
    static constexpr bool PERM = true, AFTER_DRAIN = false;
    bf16_t* dst;
    __device__ __forceinline__ void operator()(const f32x4 (&acc)[2][2][4][2], const Unit& u, int wr, int wc, int fr, int fq) const {
        const int row0 = u.pm * BM + wr * 64 + fr, col0 = u.pn * BM + wc * 32 + 8 * fq;
#pragma unroll
        for (int ai = 0; ai < 2; ++ai)
#pragma unroll
            for (int m = 0; m < 4; ++m)
#pragma unroll
                for (int bj = 0; bj < 2; ++bj) {
                    const f32x4 v0 = acc[ai][bj][m][0], v1 = acc[ai][bj][m][1];
                    u32x4 w; w.x = cvt_pk_bf16(v0[0], v0[1]); w.y = cvt_pk_bf16(v0[2], v0[3]); w.z = cvt_pk_bf16(v1[0], v1[1]); w.w = cvt_pk_bf16(v1[2], v1[3]);
                    *(u32x4*)(dst + (size_t)(row0 + ai * HALF + m * 16) * 2048 + col0 + bj * HALF) = w;
                }
    }
};
struct RwkvOrder {
    int G, c;
    __device__ bool next(int i, Unit& u) const {
        const int L = i * G + ((c & 7) * (G >> 3) + (c >> 3));
        if (L >= 864) return false;
        if (L < 768) { const int which = L >> 8, r = L & 255; u.pm = which * 32 + (r >> 3); u.pn = which * 8 + (r & 7); }
        else { const int r = L - 768, which = 3 + (r >> 5); u.pm = which * 32 + (r & 31); u.pn = 32 + (which - 3); }
        return true;
    }
    __device__ __forceinline__ void a_ready(const Unit&) const {}
    __device__ __forceinline__ void done(const Unit&) const {}
};
}

struct ConvJob { const float* src; bf16_t* dst; int ldn, Kreal, Nreal, k0, n0, ldk, mode; };
constexpr int CONV_LDS = 64 * 132 * 4;
__device__ __forceinline__ void conv_load(const int tid, const ConvJob& j, f32x4 (&w)[4]) {
    const int kq = tid >> 5, nc = (tid & 31) * 4;
#pragma unroll
    for (int i = 0; i < 4; ++i) {
        const int k = j.k0 + kq * 4 + i;
        w[i] = (f32x4){0.f, 0.f, 0.f, 0.f};
        if (k < j.Kreal && j.n0 + nc < j.Nreal) w[i] = *(const f32x4*)(j.src + (size_t)k * j.ldn + j.n0 + nc);
    }
}
__device__ __forceinline__ void conv_stage(const int tid, LAS char* lb, const f32x4 (&w)[4]) {
    const int kq = tid >> 5, nc = (tid & 31) * 4;
#pragma unroll
    for (int i = 0; i < 4; ++i) *(LAS f32x4*)(lb + ((kq * 4 + i) * 132 + nc) * 4) = w[i];
}
__device__ __forceinline__ void conv_finish(const int tid, const LAS char* lb, const ConvJob& j) {
    const int n = tid >> 2, part = tid & 3;
    float w[16];
#pragma unroll
    for (int i = 0; i < 16; ++i) w[i] = *(const LAS float*)(lb + ((part * 16 + i) * 132 + n) * 4);
    u32x4 o0, o1;
    o0.x = pk2(w[0], w[1]); o0.y = pk2(w[2], w[3]); o0.z = pk2(w[4], w[5]); o0.w = pk2(w[6], w[7]);
    o1.x = pk2(w[8], w[9]); o1.y = pk2(w[10], w[11]); o1.z = pk2(w[12], w[13]); o1.w = pk2(w[14], w[15]);
    if (j.mode == 3) {
        const int nn = j.n0 + n, kk = j.k0 + part * 16;
        bf16_t* dp = j.dst + ((((size_t)(nn >> 4) * 4 + (kk >> 5)) * 64 + ((kk >> 3) & 3) * 16 + (nn & 15)) * 8);
        *(u32x4*)dp = o0; *(u32x4*)(dp + 128) = o1;
    } else {
        bf16_t* dp = j.dst + (size_t)(j.n0 + n) * j.ldk + j.k0 + part * 16;
        *(u32x4*)dp = o0; *(u32x4*)(dp + 8) = o1;
    }
}
__device__ __forceinline__ ConvJob conv_decode(CPar& p, int id) {
    unsigned char* ws = p.ws;
    if (id < 1536) { const int kt = id / 48, nt = id % 48; return ConvJob{p.in[4], (bf16_t*)(ws + WS_WQKV), 3 * D, D, 3 * D, kt * 64, nt * 128, D, 0}; }
    id -= 1536;
    if (id < 2560) {
        const int w = id / 512, r = id % 512, kt = r / 16, nt = r % 16;
        const float* src = w == 0 ? p.in[7] : w == 1 ? p.in[10] : w == 2 ? p.in[11] : w == 3 ? p.in[12] : p.in[13];
        const size_t off = w == 0 ? WS_WONA : w == 1 ? WS_WR : w == 2 ? WS_WK : w == 3 ? WS_WV : WS_WORW;
        return ConvJob{src, (bf16_t*)(ws + off), D, D, D, kt * 64, nt * 128, D, 0};
    }
    id -= 2560;
    if (id < 128) {
        const int which = id / 64, r = id % 64, z = r / 32, kt = r % 32;
        const float* src = (which == 0 ? p.in[15] : p.in[18]) + (size_t)z * D * 96;
        bf16_t* dst = (bf16_t*)(ws + (which == 0 ? WS_W1T : WS_A1T)) + (size_t)z * 128 * D;
        return ConvJob{src, dst, 96, D, 96, kt * 64, 0, D, 0};
    }
    id -= 128;
    if (id < 64) { const int kt = id / 2, nt = id % 2; return ConvJob{p.in[20], (bf16_t*)(ws + WS_G1T), 256, D, 256, kt * 64, nt * 128, D, 0}; }
    id -= 64;
    if (id < 128) {
        const int which = id / 64, r = id % 64, z = r / 32, r2 = r % 32, kt = r2 / 16, nt = r2 % 16;
        const float* src = (which == 0 ? p.in[16] : p.in[19]) + (size_t)z * 96 * D;
        bf16_t* dst = (bf16_t*)(ws + (which == 0 ? WS_W2T : WS_A2T)) + (size_t)z * D * 128;
        return ConvJob{src, dst, D, 96, D, kt * 64, nt * 128, 128, 3};
    }
    id -= 128;
    const int kt = id / 16, nt = id % 16;
    return ConvJob{p.in[21], (bf16_t*)(ws + WS_G2T), D, 256, D, kt * 64, nt * 128, 256, 0};
}
constexpr int N_CONV_JOBS = 1536 + 2560 + 128 + 64 + 128 + 64;

__device__ __forceinline__ void rms_row_bf16(const f32x4 (&x)[8], const float* __restrict__ g, bf16_t* __restrict__ dst, int lane) {
    float ss = 0.f;
#pragma unroll
    for (int j = 0; j < 8; ++j) ss += x[j][0] * x[j][0] + x[j][1] * x[j][1] + x[j][2] * x[j][2] + x[j][3] * x[j][3];
    ss = wave_sum(ss);
    const float inv = rsqrtf(ss * (1.f / D) + 1e-6f);
#pragma unroll
    for (int j = 0; j < 8; ++j) {
        const f32x4 gv = *(const f32x4*)(g + (j * 64 + lane) * 4);
        u32x2 o; o.x = pk2(x[j][0] * inv * gv[0], x[j][1] * inv * gv[1]); o.y = pk2(x[j][2] * inv * gv[2], x[j][3] * inv * gv[3]);
        *(u32x2*)(dst + (j * 64 + lane) * 4) = o;
    }
}

__device__ __forceinline__ void ph_prologue(CPar& p, LAS char* lds) {
    const int tid = otid();
    {
        int id = blockIdx.x, buf = 0;
        ConvJob cur{}; f32x4 w[4];
        if (id < N_CONV_JOBS) { cur = conv_decode(p, id); conv_load(tid, cur, w); }
        for (; id < N_CONV_JOBS; id += gridDim.x) {
            LAS char* lb = lds + buf * CONV_LDS;
            conv_stage(tid, lb, w);
            __syncthreads();
            ConvJob nxt = cur;
            if (id + (int)gridDim.x < N_CONV_JOBS) { nxt = conv_decode(p, id + gridDim.x); conv_load(tid, nxt, w); }
            conv_finish(tid, lb, cur);
            cur = nxt; buf ^= 1;
        }
    }
    {
        float* rgf = (float*)(p.ws + WS_RGF); float* ref = (float*)(p.ws + WS_REF);
        for (int i = blockIdx.x * NTHR + tid; i < 2 * 8 * 4 * 64; i += gridDim.x * NTHR) {
            const int ln = i & 63, c = (i >> 6) & 3, j = (i >> 8) & 7, layer = i >> 11, d = (j * 64 + ln) * 4 + c;
            *(f32x4*)(rgf + (size_t)i * 4) = *(const f32x4*)(p.in[27] + ((size_t)layer * D + d) * 4);
        }
        for (int i = blockIdx.x * NTHR + tid; i < 2 * 4 * 8 * 4 * 2 * 64; i += gridDim.x * NTHR) {
            const int ln = i & 63, hf = (i >> 6) & 1, c = (i >> 7) & 3, j = (i >> 9) & 7, gq = (i >> 12) & 3, layer = i >> 14, d = (j * 64 + ln) * 4 + c;
            *(f32x4*)(ref + (size_t)i * 4) = *(const f32x4*)(p.in[29] + (((size_t)layer * 4 + gq) * D + d) * 8 + hf * 4);
        }
    }
    const int lane = tid & 63, gw = blockIdx.x * 8 + (tid >> 6), nw = gridDim.x * 8;
    bf16_t* hn = (bf16_t*)(p.ws + WS_HN);
    f32x4 x[8], xn[8];
    if (gw < T) {
#pragma unroll
        for (int j = 0; j < 8; ++j) x[j] = *(const f32x4*)(p.in[0] + (size_t)gw * D + (j * 64 + lane) * 4);
    }
    for (int t = gw; t < T; t += nw) {
        const int tn = t + nw < T ? t + nw : t;
#pragma unroll
        for (int j = 0; j < 8; ++j) xn[j] = *(const f32x4*)(p.in[0] + (size_t)tn * D + (j * 64 + lane) * 4);
        rms_row_bf16(x, p.in[1], hn + (size_t)t * D, lane);
#pragma unroll
        for (int j = 0; j < 8; ++j) x[j] = xn[j];
    }
}

__device__ __forceinline__ void ph_qkv(CPar& p, LAS char* lds) {
    const int tid = otid();
    const bf16_t* hn = (const bf16_t*)(p.ws + WS_HN); const bf16_t* w = (const bf16_t*)(p.ws + WS_WQKV);
    {
        pg8::Gemm g{hn, w, T, 2 * D, D}; pg8::StaticOrder S; S.init(T, 2 * D, (int)gridDim.x, (int)blockIdx.x);
        pg8::PEpiQK E{(bf16_t*)(p.ws + WS_Q), (bf16_t*)(p.ws + WS_K), p.in[5]};
        pg8::gemm_phase<pg8::PEpiQK, pg8::StaticOrder, true, true>(tid, (LAS unsigned char*)lds, g, S, E);
    }
    {
        pg8::Gemm g{w + (size_t)2 * D * D, hn, D, T, D}; pg8::StaticOrder S; S.init(D, T, (int)gridDim.x, (int)blockIdx.x);
        pg8::PEpiVT E{(bf16_t*)(p.ws + WS_VT), p.in[5] + 2 * D};
        pg8::gemm_phase<pg8::PEpiVT, pg8::StaticOrder, true, true>(tid, (LAS unsigned char*)lds, g, S, E);
    }
}

template <int OFF>
__device__ __forceinline__ void attn_pair(const int lane, const bf16_t* __restrict__ Q, const bf16_t* __restrict__ Kp, const bf16_t* __restrict__ Vt, bf16_t* __restrict__ AO,
                                          const LAS float* rb, const int r0, const int h, const int cb, const int rs0) {
    constexpr int NR = 8 + OFF;
    const int qi = lane & 15, g = lane >> 4;
    int bs = cb * 16 - 8; bs = bs < 0 ? 0 : (bs > 32 ? 32 : bs);
    const int qc = cb * 16 + qi;
    int wsx = qc - 8; wsx = wsx < 0 ? 0 : (wsx > 48 ? 48 : wsx);
    const size_t tq = (size_t)r0 * GW + qc;
    bf16x8 qf[2][2];
#pragma unroll
    for (int q = 0; q < 2; ++q) {
        qf[q][0] = *(const bf16x8*)(Q + (tq + q * GW) * D + h * HD + 8 * g);
        qf[q][1] = *(const bf16x8*)(Q + (tq + q * GW) * D + h * HD + 32 + 8 * g);
    }
    f32x4 s[2][8][2];
#pragma unroll
    for (int i = 0; i < NR; ++i)
#pragma unroll
        for (int tt = 0; tt < 2; ++tt) {
            const bf16_t* kp = Kp + ((((((size_t)((rs0 + i) * 32 + h) * 8 + (bs >> 3) + (qi >> 2)) * 2 + tt) * 2) * 4 + (qi & 3)) * 4 + g) * 8;
            const bf16x8 kf0 = *(const bf16x8*)kp;
            const bf16x8 kf1 = *(const bf16x8*)(kp + 128);
            if (i < 8) {
                f32x4 a = {0.f, 0.f, 0.f, 0.f};
                a = __builtin_amdgcn_mfma_f32_16x16x32_bf16(kf0, qf[0][0], a, 0, 0, 0);
                a = __builtin_amdgcn_mfma_f32_16x16x32_bf16(kf1, qf[0][1], a, 0, 0, 0);
                s[0][i][tt] = a;
            }
            if (i >= OFF) {
                f32x4 a = {0.f, 0.f, 0.f, 0.f};
                a = __builtin_amdgcn_mfma_f32_16x16x32_bf16(kf0, qf[1][0], a, 0, 0, 0);
                a = __builtin_amdgcn_mfma_f32_16x16x32_bf16(kf1, qf[1][1], a, 0, 0, 0);
                s[1][i - OFF][tt] = a;
            }
        }
    int relx[2][4]; bool okc[2][4];
#pragma unroll
    for (int tt = 0; tt < 2; ++tt)
#pragma unroll
        for (int e = 0; e < 4; ++e) {
            const int kcol = bs + 8 * g + 4 * tt + e;
            int rel = kcol - qc; rel = rel < -15 ? -15 : (rel > 15 ? 15 : rel);
            relx[tt][e] = rel + 15; okc[tt][e] = (kcol >= wsx) && (kcol < wsx + 16);
        }
    float inv[2];
    u32x4 pw[2][8];
#pragma unroll
    for (int q = 0; q < 2; ++q) {
        float mx = -1e30f;
#pragma unroll
        for (int j = 0; j < 8; ++j) {
            const int ri = (rs0 + q * OFF + j) - (r0 + q) + 7;
#pragma unroll
            for (int tt = 0; tt < 2; ++tt)
#pragma unroll
                for (int e = 0; e < 4; ++e) {
                    const float bv = rb[ri * 31 + relx[tt][e]];
                    const float v = okc[tt][e] ? s[q][j][tt][e] + bv : -1e30f;
                    s[q][j][tt][e] = v; mx = fmaxf(mx, v);
                }
        }
        mx = fmaxf(mx, __shfl_xor(mx, 16)); mx = fmaxf(mx, __shfl_xor(mx, 32));
        float sum = 0.f;
#pragma unroll
        for (int j = 0; j < 8; ++j) {
            float pv[2][4];
#pragma unroll
            for (int tt = 0; tt < 2; ++tt)
#pragma unroll
                for (int e = 0; e < 4; ++e) { pv[tt][e] = __expf(s[q][j][tt][e] - mx); sum += pv[tt][e]; }
            pw[q][j].x = pk2(pv[0][0], pv[0][1]); pw[q][j].y = pk2(pv[0][2], pv[0][3]); pw[q][j].z = pk2(pv[1][0], pv[1][1]); pw[q][j].w = pk2(pv[1][2], pv[1][3]);
        }
        sum += __shfl_xor(sum, 16); sum += __shfl_xor(sum, 32);
        inv[q] = 1.f / sum;
    }
    f32x4 o[2][4];
#pragma unroll
    for (int q = 0; q < 2; ++q)
#pragma unroll
        for (int dt = 0; dt < 4; ++dt) o[q][dt] = (f32x4){0.f, 0.f, 0.f, 0.f};
#pragma unroll
    for (int i0 = 0; i0 < NR; i0 += 3) {
        u32x4 va[3][4];
#pragma unroll
        for (int ii = 0; ii < 3; ++ii)
            if (i0 + ii < NR) {
                const bf16_t* vp = Vt + (((size_t)((rs0 + i0 + ii) * 32 + h) * 8 + (bs >> 3) + g) * 64 + qi) * 8;
#pragma unroll
                for (int dt = 0; dt < 4; ++dt) va[ii][dt] = *(const u32x4*)(vp + dt * 128);
            }
#pragma unroll
        for (int ii = 0; ii < 3; ++ii)
            if (i0 + ii < NR) {
                const int i = i0 + ii;
                if (i < 8) {
                    const bf16x8 pf = __builtin_bit_cast(bf16x8, pw[0][i]);
#pragma unroll
                    for (int dt = 0; dt < 4; ++dt) o[0][dt] = __builtin_amdgcn_mfma_f32_16x16x32_bf16(__builtin_bit_cast(bf16x8, va[ii][dt]), pf, o[0][dt], 0, 0, 0);
                }
                if (i >= OFF) {
                    const bf16x8 pf = __builtin_bit_cast(bf16x8, pw[1][i - OFF]);
#pragma unroll
                    for (int dt = 0; dt < 4; ++dt) o[1][dt] = __builtin_amdgcn_mfma_f32_16x16x32_bf16(__builtin_bit_cast(bf16x8, va[ii][dt]), pf, o[1][dt], 0, 0, 0);
                }
            }
    }
#pragma unroll
    for (int q = 0; q < 2; ++q)
#pragma unroll
        for (int dt = 0; dt < 4; ++dt) {
            u32x2 ov; ov.x = pk2(o[q][dt][0] * inv[q], o[q][dt][1] * inv[q]); ov.y = pk2(o[q][dt][2] * inv[q], o[q][dt][3] * inv[q]);
            *(u32x2*)(AO + (tq + q * GW) * D + h * HD + dt * 16 + 4 * g) = ov;
        }
}
__device__ __forceinline__ void ph_attn(CPar& p, LAS char* lds) {
    const int tid = otid(), lane = tid & 63, gw = blockIdx.x * 8 + __builtin_amdgcn_readfirstlane(tid >> 6), nw = gridDim.x * 8;
    const bf16_t* Q = (const bf16_t*)(p.ws + WS_Q); const bf16_t* Kp = (const bf16_t*)(p.ws + WS_K); const bf16_t* Vt = (const bf16_t*)(p.ws + WS_VT);
    bf16_t* AO = (bf16_t*)(p.ws + WS_AO);
    LAS float* rpbs = (LAS float*)lds;
    for (int i = tid; i < NH * 15 * 31; i += NTHR) rpbs[i] = p.in[6][i];
    __syncthreads();
    for (int u = gw; u < (ROWS / 2) * NH * 4; u += nw) {
        const int cb = u & 3, h = (u >> 2) & 31, r0 = (u >> 7) * 2;
        int rs0 = r0 - 4; rs0 = rs0 < 0 ? 0 : (rs0 > ROWS - 8 ? ROWS - 8 : rs0);
        int rs1 = r0 - 3; rs1 = rs1 < 0 ? 0 : (rs1 > ROWS - 8 ? ROWS - 8 : rs1);
        const LAS float* rb = rpbs + h * 15 * 31;
        if (rs1 != rs0) attn_pair<1>(lane, Q, Kp, Vt, AO, rb, r0, h, cb, rs0);
        else attn_pair<0>(lane, Q, Kp, Vt, AO, rb, r0, h, cb, rs0);
    }
}

__device__ __forceinline__ void ph_oproj(CPar& p, LAS char* lds, const bf16_t* A, const bf16_t* W, const float* bias, const float* src, float* dst) {
    const int tid = otid();
    pg8::Gemm g{A, W, T, D, D}; pg8::StaticOrder S; S.init(T, D, (int)gridDim.x, (int)blockIdx.x);
    pg8::PEpiResid E{src, dst, bias};
    pg8::gemm_phase<pg8::PEpiResid, pg8::StaticOrder, true, true>(tid, (LAS unsigned char*)lds, g, S, E);
}

__device__ __forceinline__ void ph_router(CPar& p, const float* __restrict__ h, int layer) {
    const int tid = otid(), lane = tid & 63, gw = blockIdx.x * 8 + (tid >> 6), nw = gridDim.x * 8;
    bf16_t* hn = (bf16_t*)(p.ws + WS_HN);
    const float* g = p.in[2] + layer * D;
    const float* wrg = (const float*)(p.ws + WS_RGF) + (size_t)layer * 8 * 4 * 64 * 4; const float* brg = p.in[28] + layer * 4;
    const float* wre = (const float*)(p.ws + WS_REF) + (size_t)layer * 4 * 8 * 4 * 2 * 64 * 4; const float* bre = p.in[30] + layer * 32;
    unsigned* cnt = (unsigned*)(p.ws + WS_CTL) + (layer ? CW_CNT1 : CW_CNT0);
    int* list = (int*)(p.ws + WS_LIST) + (size_t)layer * NEXP * T;
    float* cw = (float*)(p.ws + WS_CW) + (size_t)layer * 2 * T;
    for (int t0 = gw; t0 < T; t0 += 2 * nw) {
        const float* hrow[2]; float inv[2];
#pragma unroll
        for (int k = 0; k < 2; ++k) hrow[k] = h + (size_t)(t0 + k * nw) * D;
        {
            float ss[2] = {0.f, 0.f};
#pragma unroll 2
            for (int j = 0; j < 8; ++j)
#pragma unroll
                for (int k = 0; k < 2; ++k) { const f32x4 xv = *(const f32x4*)(hrow[k] + (j * 64 + lane) * 4); ss[k] += xv[0] * xv[0] + xv[1] * xv[1] + xv[2] * xv[2] + xv[3] * xv[3]; }
#pragma unroll
            for (int k = 0; k < 2; ++k) inv[k] = rsqrtf(wave_sum(ss[k]) * (1.f / D) + 1e-6f);
        }
        float gl[2][4];
#pragma unroll
        for (int k = 0; k < 2; ++k)
#pragma unroll
            for (int e = 0; e < 4; ++e) gl[k][e] = 0.f;
#pragma unroll 1
        for (int j = 0; j < 8; ++j) {
            const int d0 = (j * 64 + lane) * 4;
            const f32x4 gv = *(const f32x4*)(g + d0);
            f32x4 wr4[4];
#pragma unroll
            for (int c = 0; c < 4; ++c) wr4[c] = *(const f32x4*)(wrg + ((size_t)(j * 4 + c) * 64 + lane) * 4);
#pragma unroll
            for (int k = 0; k < 2; ++k) {
                f32x4 xv = *(const f32x4*)(hrow[k] + d0);
                xv[0] *= inv[k] * gv[0]; xv[1] *= inv[k] * gv[1]; xv[2] *= inv[k] * gv[2]; xv[3] *= inv[k] * gv[3];
                u32x2 o; o.x = pk2(xv[0], xv[1]); o.y = pk2(xv[2], xv[3]);
                *(u32x2*)(hn + (size_t)(t0 + k * nw) * D + d0) = o;
#pragma unroll
                for (int c = 0; c < 4; ++c) { gl[k][0] += xv[c] * wr4[c][0]; gl[k][1] += xv[c] * wr4[c][1]; gl[k][2] += xv[c] * wr4[c][2]; gl[k][3] += xv[c] * wr4[c][3]; }
            }
        }
        int gi[2]; float gwt[2];
#pragma unroll
        for (int k = 0; k < 2; ++k) {
            const float l0 = wave_sum(gl[k][0]) + brg[0], l1 = wave_sum(gl[k][1]) + brg[1], l2 = wave_sum(gl[k][2]) + brg[2], l3 = wave_sum(gl[k][3]) + brg[3];
            int gq = 0; float gm = l0;
            if (l1 > gm) { gm = l1; gq = 1; }
            if (l2 > gm) { gm = l2; gq = 2; }
            if (l3 > gm) { gm = l3; gq = 3; }
            gwt[k] = 1.f / (__expf(l0 - gm) + __expf(l1 - gm) + __expf(l2 - gm) + __expf(l3 - gm));
            gi[k] = __builtin_amdgcn_readfirstlane(gq);
        }
        float el[2][8];
#pragma unroll
        for (int k = 0; k < 2; ++k)
#pragma unroll
            for (int e = 0; e < 8; ++e) el[k][e] = 0.f;
#pragma unroll 1
        for (int j = 0; j < 8; ++j) {
            const int d0 = (j * 64 + lane) * 4;
            const f32x4 gv = *(const f32x4*)(g + d0);
#pragma unroll
            for (int k = 0; k < 2; ++k) {
                const float* we = wre + (size_t)gi[k] * 8 * 4 * 2 * 64 * 4;
                f32x4 xv = *(const f32x4*)(hrow[k] + d0);
                xv[0] *= inv[k] * gv[0]; xv[1] *= inv[k] * gv[1]; xv[2] *= inv[k] * gv[2]; xv[3] *= inv[k] * gv[3];
#pragma unroll
                for (int c = 0; c < 4; ++c) {
                    const f32x4 w0 = *(const f32x4*)(we + ((size_t)((j * 4 + c) * 2) * 64 + lane) * 4), w1 = *(const f32x4*)(we + ((size_t)((j * 4 + c) * 2 + 1) * 64 + lane) * 4);
                    el[k][0] += xv[c] * w0[0]; el[k][1] += xv[c] * w0[1]; el[k][2] += xv[c] * w0[2]; el[k][3] += xv[c] * w0[3];
                    el[k][4] += xv[c] * w1[0]; el[k][5] += xv[c] * w1[1]; el[k][6] += xv[c] * w1[2]; el[k][7] += xv[c] * w1[3];
                }
            }
        }
#pragma unroll
        for (int k = 0; k < 2; ++k) {
            const int t = t0 + k * nw;
            int i1 = 0; float m1 = -1e30f;
#pragma unroll
            for (int e = 0; e < 8; ++e) { el[k][e] = wave_sum(el[k][e]) + bre[gi[k] * 8 + e]; if (el[k][e] > m1) { m1 = el[k][e]; i1 = e; } }
            int i2 = 0; float m2 = -1e30f;
#pragma unroll
            for (int e = 0; e < 8; ++e) { if (e != i1 && el[k][e] > m2) { m2 = el[k][e]; i2 = e; } }
            const float e21 = __expf(m2 - m1);
            const float w1 = 1.f / (1.f + e21), w2 = e21 / (1.f + e21);
            if (lane == 0) {
                const int ea = gi[k] * 8 + i1, eb = gi[k] * 8 + i2;
                const unsigned pa = atomicAdd(&cnt[ea], 1u); list[ea * T + pa] = 2 * t; cw[2 * t] = gwt[k] * w1;
                const unsigned pb = atomicAdd(&cnt[eb], 1u); list[eb * T + pb] = 2 * t + 1; cw[2 * t + 1] = gwt[k] * w2;
            }
        }
    }
}

__device__ __forceinline__ void moe_prefix(const int tid, CPar& p, LAS char* lds, int layer) {
    const unsigned* cnt = (const unsigned*)(p.ws + WS_CTL) + (layer ? CW_CNT1 : CW_CNT0);
    LAS int* pref = (LAS int*)(lds + LDS_PREF);
    __syncthreads();
    if (tid == 0) {
        LAS int* te = (LAS int*)(lds + LDS_TILE_E);
        int acc = 0;
        for (int e = 0; e < NEXP; ++e) { pref[e] = acc; const int n = (int)((cnt[e] + 255u) >> 8); for (int k = 0; k < n; ++k) te[acc + k] = e; acc += n; }
        pref[NEXP] = acc;
    }
    __syncthreads();
}
__device__ __forceinline__ void ph_moe(CPar& p, LAS char* lds, int layer) {
    const int tid0 = otid();
    moe_prefix(tid0, p, lds, layer);
    LAS int* pref = (LAS int*)(lds + LDS_PREF);
    LAS int* curp = (LAS int*)(lds + LDS_MOEQ);
    const unsigned* cnt = (const unsigned*)(p.ws + WS_CTL) + (layer ? CW_CNT1 : CW_CNT0);
    gu32* qh = (gu32*)((unsigned*)(p.ws + WS_CTL) + CW_MOEQ + layer * 64);
    gu32* mtc0 = (gu32*)((unsigned*)(p.ws + WS_CTL) + CW_MOEMT + layer * 4096);
    unsigned* tmo = (unsigned*)(p.ws + WS_CTL) + CW_BAR + XB_TMO;
    const int* list = (const int*)(p.ws + WS_LIST) + (size_t)layer * NEXP * T;
    const float* cw = (const float*)(p.ws + WS_CW) + (size_t)layer * 2 * T;
    const bf16_t* hn = (const bf16_t*)(p.ws + WS_HN);
    bf16_t* act = (bf16_t*)(p.ws + (layer ? WS_ACT1 : WS_ACT));
    const int ntile = pref[NEXP], ngu = ntile * 8, total = ntile * 24;
    if (tid0 == 0) curp[0] = (int)__hip_atomic_fetch_add(qh, 1u, __ATOMIC_RELAXED, __HIP_MEMORY_SCOPE_AGENT);
    __syncthreads();
    int cur = __builtin_amdgcn_readfirstlane(curp[0]);
    while (cur < total) {
        int tid = tid0; asm volatile("" : "+v"(tid));
        unsigned nxt = 0u;
        if (tid == 0) nxt = __hip_atomic_fetch_add(qh, 1u, __ATOMIC_RELAXED, __HIP_MEMORY_SCOPE_AGENT);
        if (cur < ngu) {
            const int mt = cur >> 3, j = cur & 7;
            const int e = ((LAS int*)(lds + LDS_TILE_E))[mt];
            const int lt = mt - pref[e];
            const int nvalid = min(256, (int)cnt[e] - lt * 256);
            const int* rows = list + e * T + lt * 256;
            const int rho0 = (tid & 31) * 4;
            const float* wsrc = ((rho0 >> 5) & 1 ? p.in[32] : p.in[31]) + (size_t)(layer * NEXP + e) * D * FF + j * 64 + (rho0 >> 6) * 32 + (rho0 & 31);
            EpiMoeGU3 ep{act, cw, rows, nvalid, j * 64, lds, tid, mtc0 + mt * 32};
            gemm_tile_moe(tid, lds, hn, D, rows, nvalid, 1, wsrc, FF, D, ep);
        } else {
            const int d = cur - ngu, mt = d >> 4, pn = d & 15;
            if ((tid >> 6) == 0) {
                gu32* c = mtc0 + mt * 32;
                unsigned sp = 0u;
                while ((unsigned)__builtin_amdgcn_readfirstlane(__hip_atomic_load(c, __ATOMIC_RELAXED, __HIP_MEMORY_SCOPE_AGENT)) < 64u) {
                    __builtin_amdgcn_s_sleep(1);
                    if ((++sp & 255u) == 0u) { if (xb_ld(tmo)) break; if (sp > XB_SPIN_CAP) { atomicAdd(tmo, 1u); break; } }
                }
                __builtin_amdgcn_fence(__ATOMIC_ACQUIRE, "agent");
                asm volatile("s_waitcnt vmcnt(0)" ::: "memory");
            }
            __syncthreads();
            const int e = ((LAS int*)(lds + LDS_TILE_E))[mt];
            const int lt = mt - pref[e];
            const int nvalid = min(256, (int)cnt[e] - lt * 256);
            const int* rows = list + e * T + lt * 256;
            const float* wsrc = p.in[33] + (size_t)(layer * NEXP + e) * FF * D + pn * 128 + (tid & 31) * 4;
            EpiMoeD2 ep{(bf16_t*)(p.ws + WS_Y), rows, nvalid, pn * 128, lds, tid};
            gemm_tile_moe(tid, lds, act, FF, rows, nvalid, 0, wsrc, D, FF, ep);
        }
        if (tid == 0) curp[0] = (int)nxt;
        __syncthreads();
        cur = __builtin_amdgcn_readfirstlane(curp[0]);
    }
}

__device__ __forceinline__ void ph_combine_mix(CPar& p) {
    const int tid = otid(), lane = tid & 63, gw = blockIdx.x * 8 + (tid >> 6), nw = gridDim.x * 8;
    const float* h1 = p.out; float* h2 = (float*)(p.ws + WS_HB);
    const bf16_t* y = (const bf16_t*)(p.ws + WS_Y); const float* g = p.in[1] + D; bf16_t* mixo = (bf16_t*)(p.ws + WS_MIX); const float* mix = p.in[9];
#define CM_ROW(dst, r, own) do { const int r_ = (r); \
        if (r_ < 0 || r_ >= T) { _Pragma("unroll") for (int j = 0; j < 8; ++j) dst[j] = (f32x4){0.f, 0.f, 0.f, 0.f}; } \
        else { float ss = 0.f; \
            _Pragma("unroll") for (int j = 0; j < 8; ++j) { const int d0 = (j * 64 + lane) * 4; \
                f32x4 x = *(const f32x4*)(h1 + (size_t)r_ * D + d0); \
                const u32x2 a = *(const u32x2*)(y + (size_t)(2 * r_) * D + d0), bq = *(const u32x2*)(y + (size_t)(2 * r_ + 1) * D + d0); \
                x[0] += bflo(a.x) + bflo(bq.x); x[1] += bfhi(a.x) + bfhi(bq.x); x[2] += bflo(a.y) + bflo(bq.y); x[3] += bfhi(a.y) + bfhi(bq.y); \
                if (own) *(f32x4*)(h2 + (size_t)r_ * D + d0) = x; \
                ss += x[0] * x[0] + x[1] * x[1] + x[2] * x[2] + x[3] * x[3]; dst[j] = x; } \
            const float inv = rsqrtf(wave_sum(ss) * (1.f / D) + 1e-6f); \
            _Pragma("unroll") for (int j = 0; j < 8; ++j) { const f32x4 gv = *(const f32x4*)(g + (j * 64 + lane) * 4); dst[j] = dst[j] * gv * inv; } } } while (0)
    for (int run = gw; run < T / 4; run += nw) {
        const int t0 = run * 4;
        f32x4 pv[8], cu[8], nx[8];
        CM_ROW(pv, t0 - 1, false);
        CM_ROW(cu, t0, true);
#pragma unroll 1
        for (int i = 0; i < 4; ++i) {
            const int t = t0 + i;
            CM_ROW(nx, t + 1, i < 3);
            const float* mx = mix; asm volatile("" : "+s"(mx));
#pragma unroll
            for (int j = 0; j < 8; ++j) {
                const int d0 = (j * 64 + lane) * 4;
                const f32x4 xx = (pv[j] + nx[j]) * 0.5f - cu[j];
#pragma unroll
                for (int m = 0; m < 6; ++m) {
                    const f32x4 mv = *(const f32x4*)(mx + m * D + d0);
                    const f32x4 o = cu[j] + xx * mv;
                    u32x2 ov; ov.x = pk2(o[0], o[1]); ov.y = pk2(o[2], o[3]);
                    const int slot = m == 1 ? 3 : (m == 2 ? 1 : (m == 3 ? 2 : m));
                    *(u32x2*)(mixo + ((size_t)slot * T + t) * D + d0) = ov;
                }
                pv[j] = cu[j]; cu[j] = nx[j];
            }
        }
    }
#undef CM_ROW
}
__device__ __forceinline__ void ph_rwkv_proj(CPar& p, LAS char* lds) {
    const int tid = otid();
    pg8::Gemm g{(const bf16_t*)(p.ws + WS_MIX), (const bf16_t*)(p.ws + WS_WR), 6 * T, 35 * 256, D};
    pg8::RwkvOrder S{(int)gridDim.x, (int)blockIdx.x};
    pg8::PEpiRwkv E{(bf16_t*)(p.ws + WS_R), (bf16_t*)(p.ws + WS_LW), (bf16_t*)(p.ws + WS_LA), (bf16_t*)(p.ws + WS_GL)};
    pg8::gemm_phase<pg8::PEpiRwkv, pg8::RwkvOrder, true, true>(tid, (LAS unsigned char*)lds, g, S, E);
}
__device__ __forceinline__ unsigned toff(int row, int col) { return (unsigned)(row * 128 + ((((col >> 3) ^ (row >> 1)) & 7) << 4) + (col & 7) * 2); }
constexpr unsigned T_AQ = 0, T_RQ = 8192, T_BK = 16384, T_KK = 24576, T_V = 32768, T_L = 40960, T_DL = 49152  ,
                   T_TII = 53248  , T_MAK = 55296, T_MRB = 63488, T_MRK = 71680, T_ZS = 79872,
                   T_W0A = T_AQ, T_W0B = T_MAK,
                   T_LIN = 40960, T_AS = 57344;
__device__ __forceinline__ f32x4 tile_mm(LAS char* lds, unsigned abase, unsigned bbase, int mblk, int nblk, int l15, int g, f32x4 acc, int nks) {
    for (int ks = 0; ks < nks; ++ks) {
        const bf16x8 a = *(const LAS bf16x8*)(lds + abase + toff(mblk * 16 + l15, ks * 32 + 8 * g));
        const bf16x8 b = *(const LAS bf16x8*)(lds + bbase + toff(nblk * 16 + l15, ks * 32 + 8 * g));
        acc = __builtin_amdgcn_mfma_f32_16x16x32_bf16(a, b, acc, 0, 0, 0);
    }
    return acc;
}
__device__ __forceinline__ void tile_st(LAS char* lds, unsigned base, int n, int m0, f32x4 v) {
    u32x2 o; o.x = pk2(v[0], v[1]); o.y = pk2(v[2], v[3]);
    *(LAS u32x2*)(lds + base + toff(n, m0)) = o;
}

typedef short v4i16_t __attribute__((ext_vector_type(4)));
__device__ __forceinline__ bf16x8 frag_row(LAS char* lds, unsigned base, int blk, int ks, int l15, int g) {
    return *(const LAS bf16x8*)(lds + base + toff(blk * 16 + l15, ks * 32 + 8 * g));
}
__device__ __forceinline__ bf16x8 frag_tr(LAS char* lds, unsigned base, int blk, int ks, int l15, int g) {
    const int q = l15 >> 2, pp = l15 & 3;
    const v4i16_t v0 = __builtin_amdgcn_ds_read_tr16_b64_v4i16((LAS v4i16_t*)(lds + base + toff(ks * 32 + 8 * g + q, blk * 16 + 4 * pp)));
    const v4i16_t v1 = __builtin_amdgcn_ds_read_tr16_b64_v4i16((LAS v4i16_t*)(lds + base + toff(ks * 32 + 8 * g + 4 + q, blk * 16 + 4 * pp)));
    return (bf16x8){v0[0], v0[1], v0[2], v0[3], v1[0], v1[1], v1[2], v1[3]};
}
template <bool ATR, bool BTR>
__device__ __forceinline__ f32x4 tile_mm2(LAS char* lds, unsigned abase, unsigned bbase, int mblk, int nblk, int l15, int g, f32x4 acc, int nks) {
    for (int ks = 0; ks < nks; ++ks) {
        const bf16x8 a = ATR ? frag_tr(lds, abase, mblk, ks, l15, g) : frag_row(lds, abase, mblk, ks, l15, g);
        const bf16x8 b = BTR ? frag_tr(lds, bbase, nblk, ks, l15, g) : frag_row(lds, bbase, nblk, ks, l15, g);
        acc = __builtin_amdgcn_mfma_f32_16x16x32_bf16(a, b, acc, 0, 0, 0);
    }
    return acc;
}

__device__ __forceinline__ void ph_gate(CPar& p, LAS char* lds) {
    const int tid = otid();
    pg8::Gemm g{(const bf16_t*)(p.ws + WS_GL), (const bf16_t*)(p.ws + WS_G2T), T, D, 256}; pg8::StaticOrder S; S.init(T, D, (int)gridDim.x, (int)blockIdx.x);
    pg8::PEpiPlain E{(bf16_t*)(p.ws + WS_G)};
    pg8::gemm_phase<pg8::PEpiPlain, pg8::StaticOrder, true, true>(tid, (LAS unsigned char*)lds, g, S, E);
    __syncthreads();
}
__device__ __forceinline__ void ph_scan_prep(CPar& p, LAS char* lds) {
    const int tid0 = otid(), wv = tid0 >> 6;
    const bf16_t* R = (const bf16_t*)(p.ws + WS_R); const bf16_t* K2 = (const bf16_t*)(p.ws + WS_K2); const bf16_t* V2 = (const bf16_t*)(p.ws + WS_V2);
    const float* k_k = p.in[22]; const float* k_a = p.in[23]; const float* r_k = p.in[24];
    for (int u = blockIdx.x; u < NH * 128; u += gridDim.x) {
        int tid = tid0; asm volatile("" : "+v"(tid));
        const int lane = tid & 63, l15 = lane & 15, g = lane >> 4;
        const int h = u & 31, m = u >> 5;
        {
            const int z = wv >> 2, nblk = wv & 3;
            LAS char* ldz = lds + z * T_ZS;
            LAS float* LIN = (LAS float*)(ldz + T_LIN); LAS float* AS = (LAS float*)(ldz + T_AS); LAS float* lendp = (LAS float*)(lds + LDS_SEG) + z * 64;
            bf16x8 afr[2][4][3], bfr[2][3];
            float bias[2];
#pragma unroll
            for (int isa = 0; isa < 2; ++isa) {
                const bf16_t* lsrc = (const bf16_t*)(p.ws + (isa ? WS_LA : WS_LW)) + (size_t)z * 512 * 4 * 64 * 8;
                const bf16_t* wsrc = (const bf16_t*)(p.ws + (isa ? WS_A2T : WS_W2T)) + (size_t)z * D * 128 + ((size_t)(h * 4 + nblk) * 4 * 64 + g * 16 + l15) * 8;
                bias[isa] = (isa ? p.in[17] : p.in[14])[z * D + h * HD + nblk * 16 + l15];
#pragma unroll
                for (int ks = 0; ks < 3; ++ks) bfr[isa][ks] = *(const bf16x8*)(wsrc + ks * 512);
#pragma unroll
                for (int mblk = 0; mblk < 4; ++mblk) {
                    const int tb = m * 4 + (z ? 3 - mblk : mblk), r15 = z ? 15 - l15 : l15;
#pragma unroll
                    for (int ks = 0; ks < 3; ++ks) afr[isa][mblk][ks] = *(const bf16x8*)(lsrc + (((size_t)tb * 4 + ks) * 64 + g * 16 + r15) * 8);
                }
            }
            float carry = 0.f;
#pragma unroll
            for (int mblk = 0; mblk < 4; ++mblk) {
                f32x4 accw = {0.f, 0.f, 0.f, 0.f}, acca = {0.f, 0.f, 0.f, 0.f};
#pragma unroll
                for (int ks = 0; ks < 3; ++ks) { accw = __builtin_amdgcn_mfma_f32_16x16x32_bf16(afr[0][mblk][ks], bfr[0][ks], accw, 0, 0, 0); acca = __builtin_amdgcn_mfma_f32_16x16x32_bf16(afr[1][mblk][ks], bfr[1][ks], acca, 0, 0, 0); }
                float o[4], oa[4];
#pragma unroll
                for (int e = 0; e < 4; ++e) {
                    oa[e] = sigmoidf_(acca[e] + bias[1]);
                    o[e] = -0.60653066f * sigmoidf_(accw[e] + bias[0]);
                }
                o[1] += o[0]; o[2] += o[1]; o[3] += o[2];
                const float tot = o[3];
                const float u1 = __shfl_up(tot, 16); const float s2 = tot + (g >= 1 ? u1 : 0.f);
                const float u2 = __shfl_up(s2, 32); const float incl = s2 + (g >= 2 ? u2 : 0.f);
                const float tt = __shfl(incl, 48 + l15);
                const float base = carry + incl - tot;
                carry += tt;
#pragma unroll
                for (int e = 0; e < 4; ++e) { LIN[(mblk * 16 + 4 * g + e) * 64 + nblk * 16 + l15] = o[e] + base; AS[(mblk * 16 + 4 * g + e) * 64 + nblk * 16 + l15] = oa[e]; }
            }
            if (g == 0) lendp[nblk * 16 + l15] = carry;
        }
        __syncthreads();
        {
            const int tau = tid >> 3, cg = tid & 7, c0 = h * HD + cg * 8;
            const int t = m * 64 + tau; const size_t o = (size_t)t * D + c0;
            const u32x4 kw = *(const u32x4*)(K2 + o), rw = *(const u32x4*)(R + o), vw = *(const u32x4*)(V2 + o);
            float kx[8], rx[8], kk[8], kac[8], rkc[8];
            float n2 = 0.f;
#pragma unroll
            for (int q4 = 0; q4 < 2; ++q4) {
                const f32x4 k4 = *(const f32x4*)(k_k + c0 + q4 * 4), ka4 = *(const f32x4*)(k_a + c0 + q4 * 4), rk4 = *(const f32x4*)(r_k + c0 + q4 * 4);
#pragma unroll
                for (int e = 0; e < 4; ++e) {
                    const int j = q4 * 4 + e; const unsigned kwj = kw[j >> 1], rwj = rw[j >> 1];
                    kx[j] = (j & 1) ? bfhi(kwj) : bflo(kwj); rx[j] = (j & 1) ? bfhi(rwj) : bflo(rwj);
                    kk[j] = kx[j] * k4[e]; n2 += kk[j] * kk[j]; kac[j] = ka4[e]; rkc[j] = rk4[e];
                }
            }
            n2 += __shfl_xor(n2, 1); n2 += __shfl_xor(n2, 2); n2 += __shfl_xor(n2, 4);
            const float rn = __builtin_amdgcn_rcpf(fmaxf(sqrtf(n2), 1e-12f));
#pragma unroll
            for (int j = 0; j < 8; ++j) kk[j] *= rn;
#pragma unroll
            for (int z = 0; z < 2; ++z) {
                LAS char* ldz = lds + z * T_ZS;
                LAS float* LIN = (LAS float*)(ldz + T_LIN); LAS float* AS = (LAS float*)(ldz + T_AS); LAS float* lendp = (LAS float*)(lds + LDS_SEG) + z * 64;
                LAS float* elend = (LAS float*)(lds + LDS_ELEND) + z * 64;
                float* sbon = (float*)(p.ws + WS_SBON) + (size_t)z * T * NH;
                const int sidx = z ? 63 - tau : tau;
                float lin[8], lex[8], av[8];
#pragma unroll
                for (int q4 = 0; q4 < 2; ++q4) {
                    const f32x4 a4 = *(const LAS f32x4*)(AS + sidx * 64 + cg * 8 + q4 * 4), l4 = *(const LAS f32x4*)(LIN + sidx * 64 + cg * 8 + q4 * 4);
                    f32x4 p4 = {0.f, 0.f, 0.f, 0.f};
                    if (sidx > 0) p4 = *(const LAS f32x4*)(LIN + (sidx - 1) * 64 + cg * 8 + q4 * 4);
#pragma unroll
                    for (int e = 0; e < 4; ++e) { av[q4 * 4 + e] = a4[e]; lin[q4 * 4 + e] = l4[e]; lex[q4 * 4 + e] = p4[e]; }
                }
                float kd[8], sb = 0.f;
#pragma unroll
                for (int j = 0; j < 8; ++j) { kd[j] = kx[j] * (1.f + (av[j] - 1.f) * kac[j]); sb += rx[j] * kd[j] * rkc[j]; }
                sb += __shfl_xor(sb, 1); sb += __shfl_xor(sb, 2); sb += __shfl_xor(sb, 4);
                if (cg == 0) sbon[(size_t)t * NH + h] = sb;
                float aq[8], rq[8], bk[8], kq[8];
#pragma unroll
                for (int j = 0; j < 8; ++j) {
                    const float b = kk[j] * av[j];
                    const float elin = __expf(lin[j]), elex = __expf(lex[j]), enl = __expf(-lin[j]);
                    aq[j] = -kk[j] * elex; bk[j] = b * enl; kq[j] = kd[j] * enl; rq[j] = rx[j] * elin;
                }
                const unsigned wo = toff(sidx, cg * 8);
                *(LAS u32x4*)(ldz + T_AQ + wo) = (u32x4){pk2(aq[0], aq[1]), pk2(aq[2], aq[3]), pk2(aq[4], aq[5]), pk2(aq[6], aq[7])};
                *(LAS u32x4*)(ldz + T_RQ + wo) = (u32x4){pk2(rq[0], rq[1]), pk2(rq[2], rq[3]), pk2(rq[4], rq[5]), pk2(rq[6], rq[7])};
                *(LAS u32x4*)(ldz + T_BK + wo) = (u32x4){pk2(bk[0], bk[1]), pk2(bk[2], bk[3]), pk2(bk[4], bk[5]), pk2(bk[6], bk[7])};
                *(LAS u32x4*)(ldz + T_KK + wo) = (u32x4){pk2(kq[0], kq[1]), pk2(kq[2], kq[3]), pk2(kq[4], kq[5]), pk2(kq[6], kq[7])};
                *(LAS u32x4*)(ldz + T_V + wo) = vw;
                if (tau == 0) {
#pragma unroll
                    for (int q4 = 0; q4 < 2; ++q4) { const f32x4 e4 = *(const LAS f32x4*)(lendp + cg * 8 + q4 * 4);
#pragma unroll
                        for (int e = 0; e < 4; ++e) elend[cg * 8 + q4 * 4 + e] = __expf(e4[e]); }
                }
            }
        }
        __syncthreads();
#pragma unroll
        for (int z = 0; z < 2; ++z) {
            LAS char* ldz = lds + z * T_ZS;
            const int nblk = wv & 3;
#pragma unroll
            for (int pid = 0; pid < 4; ++pid) {
                const unsigned ab = (pid & 1) ? T_KK : T_BK, bb = pid < 2 ? T_AQ : T_RQ;
                const unsigned db = pid == 0 ? T_L : (pid == 1 ? T_MAK : (pid == 2 ? T_MRB : T_MRK));
#pragma unroll
                for (int i = 0; i < 2; ++i) {
                    const int mblk = (wv >> 2) * 2 + i;
                    f32x4 acc = {0.f, 0.f, 0.f, 0.f};
                    if (mblk <= nblk) {
                        acc = tile_mm(ldz, ab, bb, mblk, nblk, l15, g, acc, 2);
                        const int n = nblk * 16 + l15, m0 = mblk * 16 + 4 * g;
#pragma unroll
                        for (int e = 0; e < 4; ++e) { const bool keep = pid < 2 ? (m0 + e < n) : (m0 + e <= n); acc[e] = keep ? acc[e] : 0.f; }
                        if (pid == 0 && mblk == nblk) *(LAS f32x4*)(ldz + T_DL + ((nblk * 16 + l15) * 16 + 4 * g) * 4) = acc;
                    }
                    tile_st(ldz, db, nblk * 16 + l15, mblk * 16 + 4 * g, acc);
                }
            }
        }
        __syncthreads();
        f32x4 xacc[2][4];
        const int wcol = (wv & 3) * 16 + l15;
#pragma unroll
        for (int z = 0; z < 2; ++z) {
            LAS char* ldz = lds + z * T_ZS;
            if (wv >= 4) {
#pragma unroll
                for (int sb = 0; sb < 4; ++sb) {
                    f32x4 acc = {0.f, 0.f, 0.f, 0.f};
                    xacc[z][sb] = tile_mm2<false, true>(ldz, T_MAK, T_V, sb, wv - 4, l15, g, acc, sb < 2 ? 1 : 2);
                }
            } else {
#pragma unroll
                for (int sb = 0; sb < 4; ++sb) {
                    const v4i16_t w = __builtin_amdgcn_ds_read_tr16_b64_v4i16((LAS v4i16_t*)(ldz + T_AQ + toff(sb * 16 + 4 * g + (l15 >> 2), (wv & 3) * 16 + 4 * (l15 & 3))));
                    xacc[z][sb] = (f32x4){bf2f((bf16_t)w[0]), bf2f((bf16_t)w[1]), bf2f((bf16_t)w[2]), bf2f((bf16_t)w[3])};
                }
            }
        }
        if (wv < 2) {
            LAS char* ldz = lds + wv * T_ZS;
            float tc[16];
#pragma unroll
            for (int r = 0; r < 16; ++r) {
                float v = (r == l15) ? 1.f : 0.f;
#pragma unroll
                for (int q4 = 0; q4 < (r + 3) / 4; ++q4) {
                    const f32x4 lr = *(const LAS f32x4*)(ldz + T_DL + ((g * 16 + r) * 16 + q4 * 4) * 4);
#pragma unroll
                    for (int e = 0; e < 4; ++e) if (q4 * 4 + e < r) v += lr[e] * tc[q4 * 4 + e];
                }
                tc[r] = v;
                *(LAS bf16_t*)(ldz + T_TII + ((g * 16 + r) * 16 + l15) * 2) = (bf16_t)f2bf(v);
            }
        }
        __syncthreads();
#pragma unroll
        for (int z = 0; z < 2; ++z) {
            LAS char* ldz = lds + z * T_ZS;
            const unsigned wbase = (wv < 4 ? T_W0A : T_W0B);
            unsigned wp[4][2];
#pragma unroll
            for (int i = 0; i < 4; ++i) {
                f32x4 r = xacc[z][i];
                if (i >= 1) {
                    const u32x2 l0 = *(const LAS u32x2*)(ldz + T_L + toff(i * 16 + l15, 4 * g));
                    u32x2 l1 = {0u, 0u};
                    if (i >= 2) l1 = *(const LAS u32x2*)(ldz + T_L + toff(i * 16 + l15, 16 + 4 * g));
                    const u32x4 aw = {l0.x, l0.y, l1.x, l1.y};
                    const u32x4 bw = {wp[0][0], wp[0][1], i >= 2 ? wp[1][0] : 0u, i >= 2 ? wp[1][1] : 0u};
                    r = __builtin_amdgcn_mfma_f32_16x16x32_bf16(__builtin_bit_cast(bf16x8, aw), __builtin_bit_cast(bf16x8, bw), r, 0, 0, 0);
                }
                if (i == 3) {
                    const u32x2 l2 = *(const LAS u32x2*)(ldz + T_L + toff(48 + l15, 32 + 4 * g));
                    const u32x4 aw = {l2.x, l2.y, 0u, 0u};
                    const u32x4 bw = {wp[2][0], wp[2][1], 0u, 0u};
                    r = __builtin_amdgcn_mfma_f32_16x16x32_bf16(__builtin_bit_cast(bf16x8, aw), __builtin_bit_cast(bf16x8, bw), r, 0, 0, 0);
                }
                const u32x2 tw = *(const LAS u32x2*)(ldz + T_TII + ((i * 16 + l15) * 16 + 4 * g) * 2);
                const u32x4 aw = {tw.x, tw.y, 0u, 0u};
                const u32x4 bw = {pk2(r[0], r[1]), pk2(r[2], r[3]), 0u, 0u};
                f32x4 w = {0.f, 0.f, 0.f, 0.f};
                w = __builtin_amdgcn_mfma_f32_16x16x32_bf16(__builtin_bit_cast(bf16x8, aw), __builtin_bit_cast(bf16x8, bw), w, 0, 0, 0);
                wp[i][0] = pk2(w[0], w[1]); wp[i][1] = pk2(w[2], w[3]);
                *(LAS u32x2*)(ldz + wbase + toff(wcol, i * 16 + 4 * g)) = (u32x2){wp[i][0], wp[i][1]};
            }
        }
        __syncthreads();
#pragma unroll
        for (int z = 0; z < 2; ++z) {
            LAS char* ldz = lds + z * T_ZS;
            LAS float* elend = (LAS float*)(lds + LDS_ELEND) + z * 64;
            const int cc = z ? 127 - m : m;
            const size_t uc = ((size_t)(z * NH + h) * 128 + cc) * 4096, um = ((size_t)(z * NH + h) * 128 + m) * 4096;
            bf16_t* GB = (bf16_t*)(p.ws + WS_GB) + uc; bf16_t* FB = (bf16_t*)(p.ws + WS_FB) + uc;
            bf16_t* GYB = (bf16_t*)(p.ws + WS_GYB) + um; bf16_t* FYB = (bf16_t*)(p.ws + WS_FYB) + um;
#pragma unroll
            for (int i = 0; i < 2; ++i) {
                const int tile = wv * 2 + i, mblk = tile >> 2, nblk = tile & 3;
                const int n = nblk * 16 + l15, m0 = mblk * 16 + 4 * g;
                {
                    f32x4 acc = {0.f, 0.f, 0.f, 0.f};
                    acc = tile_mm2<false, true>(ldz, T_W0A, T_BK, mblk, nblk, l15, g, acc, 2);
                    const float el = elend[n];
#pragma unroll
                    for (int e = 0; e < 4; ++e) acc[e] = (acc[e] + (m0 + e == n ? 1.f : 0.f)) * el;
                    u32x2 o; o.x = pk2(acc[0], acc[1]); o.y = pk2(acc[2], acc[3]);
                    *(u32x2*)(GB + ((nblk * 4 + mblk) * 64 + lane) * 4) = o;
                }
                {
                    f32x4 acc = {0.f, 0.f, 0.f, 0.f};
                    acc = tile_mm2<true, false>(ldz, T_BK, T_W0B, mblk, nblk, l15, g, acc, 2);
                    acc = tile_mm2<true, true>(ldz, T_KK, T_V, mblk, nblk, l15, g, acc, 2);
                    const f32x4 el4 = *(const LAS f32x4*)(elend + m0);
                    u32x2 o; o.x = pk2(acc[0] * el4[0], acc[1] * el4[1]); o.y = pk2(acc[2] * el4[2], acc[3] * el4[3]);
                    *(u32x2*)(FB + ((nblk * 4 + mblk) * 64 + lane) * 4) = o;
                }
                {
                    f32x4 acc = {0.f, 0.f, 0.f, 0.f};
                    acc = tile_mm(ldz, T_W0A, T_MRB, mblk, nblk, l15, g, acc, 2);
                    const u32x2 rq = *(const LAS u32x2*)(ldz + T_RQ + toff(n, m0));
                    acc[0] += bflo(rq.x); acc[1] += bfhi(rq.x); acc[2] += bflo(rq.y); acc[3] += bfhi(rq.y);
                    u32x2 o; o.x = pk2(acc[0], acc[1]); o.y = pk2(acc[2], acc[3]);
                    *(u32x2*)(GYB + (z ? (((3 - nblk) * 4 + mblk) * 64 + g * 16 + 15 - l15) : ((nblk * 4 + mblk) * 64 + lane)) * 4) = o;
                }
                {
                    f32x4 acc = {0.f, 0.f, 0.f, 0.f};
                    acc = tile_mm(ldz, T_MRB, T_W0B, mblk, nblk, l15, g, acc, 2);
                    acc = tile_mm2<false, true>(ldz, T_MRK, T_V, mblk, nblk, l15, g, acc, 2);
                    u32x2 o;
                    if (z) { o.x = pk2(acc[3], acc[2]); o.y = pk2(acc[1], acc[0]); *(u32x2*)(FYB + ((nblk * 4 + (3 - mblk)) * 64 + (3 - g) * 16 + l15) * 4) = o; }
                    else { o.x = pk2(acc[0], acc[1]); o.y = pk2(acc[2], acc[3]); *(u32x2*)(FYB + ((nblk * 4 + mblk) * 64 + lane) * 4) = o; }
                }
            }
        }
        lds_barrier();
    }
}

__device__ __forceinline__ void ph_scan_state(CPar& p) {
    const int tid = otid(), lane = tid & 63, wv = tid >> 6, l15 = lane & 15, g = lane >> 4;
    if (wv != 0) return;
    for (int u = blockIdx.x; u < 256; u += gridDim.x) {
        const int zh = u >> 2, vq = u & 3;
        const bf16_t* GB = (const bf16_t*)(p.ws + WS_GB) + (size_t)zh * 128 * 4096;
        const bf16_t* FB = (const bf16_t*)(p.ws + WS_FB) + (size_t)zh * 128 * 4096;
        bf16_t* HS = (bf16_t*)(p.ws + WS_HS) + (size_t)zh * 128 * 4096;
        f32x4 acc[4];
#pragma unroll
        for (int mt = 0; mt < 4; ++mt) acc[mt] = (f32x4){0.f, 0.f, 0.f, 0.f};
        u32x2 gq[4][2][2], fq[4], gq2[4][2][2], fq2[4], gq3[4][2][2], fq3[4], gq4[4][2][2], fq4[4];
#define SCAN_LOAD(G_, F_, cidx) do { const bf16_t* gp = GB + (size_t)(cidx) * 4096; const bf16_t* fp = FB + (size_t)(cidx) * 4096; \
            _Pragma("unroll") for (int mt = 0; mt < 4; ++mt) { \
                _Pragma("unroll") for (int ks = 0; ks < 2; ++ks) { G_[mt][ks][0] = *(const u32x2*)(gp + ((mt * 4 + 2 * ks) * 64 + lane) * 4); G_[mt][ks][1] = *(const u32x2*)(gp + ((mt * 4 + 2 * ks + 1) * 64 + lane) * 4); } \
                F_[mt] = *(const u32x2*)(fp + ((vq * 4 + mt) * 64 + lane) * 4); } } while (0)
#define SCAN_STEP(G_, F_, cidx) do { \
            bf16_t* hp = HS + (size_t)(cidx) * 4096 + (vq * 4 * 64 + lane) * 4; \
            u32x2 hb[4]; \
            _Pragma("unroll") for (int mt = 0; mt < 4; ++mt) { hb[mt].x = pk2(acc[mt][0], acc[mt][1]); hb[mt].y = pk2(acc[mt][2], acc[mt][3]); *(u32x2*)(hp + mt * 256) = hb[mt]; } \
            bf16x8 bfr[2]; \
            _Pragma("unroll") for (int ks = 0; ks < 2; ++ks) { u32x4 w = {hb[2 * ks].x, hb[2 * ks].y, hb[2 * ks + 1].x, hb[2 * ks + 1].y}; bfr[ks] = __builtin_bit_cast(bf16x8, w); } \
            _Pragma("unroll") for (int mt = 0; mt < 4; ++mt) { \
                f32x4 a = {bflo(F_[mt].x), bfhi(F_[mt].x), bflo(F_[mt].y), bfhi(F_[mt].y)}; \
                _Pragma("unroll") for (int ks = 0; ks < 2; ++ks) { \
                    u32x4 w = {G_[mt][ks][0].x, G_[mt][ks][0].y, G_[mt][ks][1].x, G_[mt][ks][1].y}; \
                    a = __builtin_amdgcn_mfma_f32_16x16x32_bf16(__builtin_bit_cast(bf16x8, w), bfr[ks], a, 0, 0, 0); } \
                acc[mt] = a; } } while (0)
        SCAN_LOAD(gq, fq, 0); SCAN_LOAD(gq2, fq2, 1); SCAN_LOAD(gq3, fq3, 2); SCAN_LOAD(gq4, fq4, 3);
#pragma unroll 4
        for (int c = 0; c < 128; c += 4) {
            SCAN_STEP(gq, fq, c);
            if (c + 4 < 128) SCAN_LOAD(gq, fq, c + 4);
            SCAN_STEP(gq2, fq2, c + 1);
            if (c + 4 < 128) SCAN_LOAD(gq2, fq2, c + 5);
            SCAN_STEP(gq3, fq3, c + 2);
            if (c + 4 < 128) SCAN_LOAD(gq3, fq3, c + 6);
            SCAN_STEP(gq4, fq4, c + 3);
            if (c + 4 < 128) SCAN_LOAD(gq4, fq4, c + 7);
        }
#undef SCAN_STEP
#undef SCAN_LOAD
    }
}

__device__ __forceinline__ void ph_scan_out(CPar& p, LAS char* lds) {
    const int tid = otid(), lane = tid & 63, wv = tid >> 6, l15 = lane & 15, g = lane >> 4;
    const bf16_t* V2 = (const bf16_t*)(p.ws + WS_V2); const bf16_t* G = (const bf16_t*)(p.ws + WS_G); bf16_t* Z = (bf16_t*)(p.ws + WS_Z);
    const float* sbon = (const float*)(p.ws + WS_SBON); const float* lw = p.in[25]; const float* lb = p.in[26];
    const int vb = wv & 3, tk = tid >> 3, cg = tid & 7;
    const int NU = NH * 128, GS = gridDim.x;
    u32x2 Af[2][2], Aa[2][2][2][2], Ab[2][2][2][2];
    struct BSet { u32x4 vw, gw; f32x4 w0, w1, b0, b1; float s0, s1; };
    BSet B0, B1;
#define OUT_LOADA(u_) do { const int h_ = (u_) & 31, m_ = (u_) >> 5; \
        _Pragma("unroll") for (int i = 0; i < 2; ++i) { const int sb = (wv >> 2) * 2 + i; \
            _Pragma("unroll") for (int z = 0; z < 2; ++z) { const int cc = z ? 127 - m_ : m_; \
                const bf16_t* gy = (const bf16_t*)(p.ws + WS_GYB) + ((size_t)(z * NH + h_) * 128 + m_) * 4096; \
                const bf16_t* fy = (const bf16_t*)(p.ws + WS_FYB) + ((size_t)(z * NH + h_) * 128 + m_) * 4096; \
                const bf16_t* hs = (const bf16_t*)(p.ws + WS_HS) + ((size_t)(z * NH + h_) * 128 + cc) * 4096; \
                Af[i][z] = *(const u32x2*)(fy + ((vb * 4 + sb) * 64 + lane) * 4); \
                _Pragma("unroll") for (int ks = 0; ks < 2; ++ks) { \
                    const bf16_t* gyp = gy + ((sb * 4 + 2 * ks + (g >> 1)) * 64 + (2 * (g & 1)) * 16 + l15) * 4;        \
                    Aa[i][z][ks][0] = *(const u32x2*)gyp; Aa[i][z][ks][1] = *(const u32x2*)(gyp + 64); \
                    const bf16_t* hsp = hs + ((vb * 4 + 2 * ks + (g >> 1)) * 64 + (2 * (g & 1)) * 16 + l15) * 4; \
                    Ab[i][z][ks][0] = *(const u32x2*)hsp; Ab[i][z][ks][1] = *(const u32x2*)(hsp + 64); } } } } while (0)
#define OUT_LOADB(S_, u_) do { const int h_ = (u_) & 31, m_ = (u_) >> 5, t_ = m_ * 64 + tk, c0_ = h_ * HD + cg * 8; const size_t o_ = (size_t)t_ * D + c0_; \
        S_.vw = *(const u32x4*)(V2 + o_); S_.gw = *(const u32x4*)(G + o_); \
        S_.s0 = sbon[(size_t)t_ * NH + h_]; S_.s1 = sbon[(size_t)T * NH + (size_t)t_ * NH + h_]; \
        S_.w0 = *(const f32x4*)(lw + c0_); S_.w1 = *(const f32x4*)(lw + c0_ + 4); S_.b0 = *(const f32x4*)(lb + c0_); S_.b1 = *(const f32x4*)(lb + c0_ + 4); } while (0)
#define OUT_MMA(yt_) do { \
        _Pragma("unroll") for (int i = 0; i < 2; ++i) { const int sb = (wv >> 2) * 2 + i; \
            f32x4 acc = {0.f, 0.f, 0.f, 0.f}; \
            _Pragma("unroll") for (int z = 0; z < 2; ++z) { \
                const u32x2 f = Af[i][z]; \
                acc[0] += bflo(f.x); acc[1] += bfhi(f.x); acc[2] += bflo(f.y); acc[3] += bfhi(f.y); \
                _Pragma("unroll") for (int ks = 0; ks < 2; ++ks) { \
                    const bf16x8 a = __builtin_bit_cast(bf16x8, (u32x4){Aa[i][z][ks][0].x, Aa[i][z][ks][0].y, Aa[i][z][ks][1].x, Aa[i][z][ks][1].y}); \
                    const bf16x8 bq = __builtin_bit_cast(bf16x8, (u32x4){Ab[i][z][ks][0].x, Ab[i][z][ks][0].y, Ab[i][z][ks][1].x, Ab[i][z][ks][1].y}); \
                    acc = __builtin_amdgcn_mfma_f32_16x16x32_bf16(a, bq, acc, 0, 0, 0); } } \
            _Pragma("unroll") for (int e = 0; e < 4; ++e) yt_[(sb * 16 + 4 * g + e) * 64 + vb * 16 + l15] = acc[e]; } } while (0)
#define OUT_NORM(S_, u_, yt_) do { const int h_ = (u_) & 31, m_ = (u_) >> 5, t_ = m_ * 64 + tk, c0_ = h_ * HD + cg * 8; const size_t o_ = (size_t)t_ * D + c0_; \
        const float sbv = S_.s0 + S_.s1; \
        const f32x4 y0 = *(const LAS f32x4*)(yt_ + tk * 64 + cg * 8), y1 = *(const LAS f32x4*)(yt_ + tk * 64 + cg * 8 + 4); \
        float sum = y0[0] + y0[1] + y0[2] + y0[3] + y1[0] + y1[1] + y1[2] + y1[3]; \
        sum += __shfl_xor(sum, 1); sum += __shfl_xor(sum, 2); sum += __shfl_xor(sum, 4); \
        const float mu = sum * (1.f / 64.f); \
        float yv[8], wv8[8], bv8[8], gv[8], vv[8]; \
        _Pragma("unroll") for (int e = 0; e < 4; ++e) { yv[e] = y0[e] - mu; yv[4 + e] = y1[e] - mu; wv8[e] = S_.w0[e]; wv8[4 + e] = S_.w1[e]; bv8[e] = S_.b0[e]; bv8[4 + e] = S_.b1[e]; } \
        _Pragma("unroll") for (int j = 0; j < 8; ++j) gv[j] = (j & 1) ? bfhi(S_.gw[j >> 1]) : bflo(S_.gw[j >> 1]); \
        _Pragma("unroll") for (int j = 0; j < 8; ++j) vv[j] = (j & 1) ? bfhi(S_.vw[j >> 1]) : bflo(S_.vw[j >> 1]); \
        float sq = 0.f; \
        _Pragma("unroll") for (int j = 0; j < 8; ++j) sq += yv[j] * yv[j]; \
        sq += __shfl_xor(sq, 1); sq += __shfl_xor(sq, 2); sq += __shfl_xor(sq, 4); \
        const float rs = rsqrtf(sq * (1.f / 64.f) + 64e-5f); \
        float ov[8]; \
        _Pragma("unroll") for (int j = 0; j < 8; ++j) ov[j] = (yv[j] * rs * wv8[j] + bv8[j] + sbv * vv[j]) * gv[j]; \
        u32x4 pw; pw.x = pk2(ov[0], ov[1]); pw.y = pk2(ov[2], ov[3]); pw.z = pk2(ov[4], ov[5]); pw.w = pk2(ov[6], ov[7]); \
        *(u32x4*)(Z + o_) = pw; } while (0)
    LAS float* yt0 = (LAS float*)lds; LAS float* yt1 = yt0 + 4096;
    int u = blockIdx.x;
    if (u < NU) { OUT_LOADA(u); OUT_LOADB(B0, u); }
    for (; u < NU; u += 2 * GS) {
        OUT_MMA(yt0);
        const int u1 = u + GS;
        if (u1 < NU) { OUT_LOADA(u1); OUT_LOADB(B1, u1); }
        lds_barrier();
        OUT_NORM(B0, u, yt0);
        if (u1 >= NU) break;
        OUT_MMA(yt1);
        const int u2 = u1 + GS;
        if (u2 < NU) { OUT_LOADA(u2); OUT_LOADB(B0, u2); }
        lds_barrier();
        OUT_NORM(B1, u1, yt1);
    }
#undef OUT_LOADA
#undef OUT_LOADB
#undef OUT_MMA
#undef OUT_NORM
}

__device__ __forceinline__ void ph_final(CPar& p) {
    const int tid = otid(), lane = tid & 63, gw = blockIdx.x * 8 + (tid >> 6), nw = gridDim.x * 8;
    float* h3 = p.out; const bf16_t* y = (const bf16_t*)(p.ws + WS_Y); const float* g = p.in[3];
    for (int t = gw; t < T; t += nw) {
        f32x4 x[8]; float ss = 0.f;
#pragma unroll
        for (int j = 0; j < 8; ++j) {
            const int d0 = (j * 64 + lane) * 4;
            x[j] = *(const f32x4*)(h3 + (size_t)t * D + d0);
            const u32x2 a = *(const u32x2*)(y + (size_t)(2 * t) * D + d0), b = *(const u32x2*)(y + (size_t)(2 * t + 1) * D + d0);
            x[j][0] += bflo(a.x) + bflo(b.x); x[j][1] += bfhi(a.x) + bfhi(b.x); x[j][2] += bflo(a.y) + bflo(b.y); x[j][3] += bfhi(a.y) + bfhi(b.y);
            ss += x[j][0] * x[j][0] + x[j][1] * x[j][1] + x[j][2] * x[j][2] + x[j][3] * x[j][3];
        }
        ss = wave_sum(ss);
        const float inv = rsqrtf(ss * (1.f / D) + 1e-6f);
#pragma unroll
        for (int j = 0; j < 8; ++j) {
            const int d0 = (j * 64 + lane) * 4;
            const f32x4 gv = *(const f32x4*)(g + d0);
            f32x4 o = {x[j][0] * inv * gv[0], x[j][1] * inv * gv[1], x[j][2] * inv * gv[2], x[j][3] * inv * gv[3]};
            *(f32x4*)(h3 + (size_t)t * D + d0) = o;
        }
    }
}

constexpr int NPH = 19;
extern __shared__ __attribute__((aligned(16))) char smem[];
__global__ void __launch_bounds__(NTHR, 2) fwd(Params p_unused, int lo, int hi) {
    LAS char* lds = (LAS char*)smem;
    CPar* pp = (CPar*)__builtin_amdgcn_kernarg_segment_ptr();
    if (threadIdx.x == 0) *(LAS u32x4*)(lds + LDS_XB) = (u32x4){0u, 0u, 0u, 0u};
    __syncthreads();
    XcdBarrier bar;
    const bool multi = (hi - lo) > 1;
    if (multi) bar = xcd_barrier_post((unsigned*)(pp->ws + WS_CTL) + CW_BAR, (volatile LAS unsigned*)(lds + LDS_XB));
#define IN(k) (lo <= (k) && (k) < hi)
#define SEAM(k) do { if (IN(k) && IN((k) + 1)) xcd_barrier(bar); } while (0)
#define PHASE(k, call) do { if (IN(k)) { asm volatile("" : "+s"(pp)); CPar& p = *pp; call; } } while (0)
    PHASE(0, ph_prologue(p, lds));
    SEAM(0);
    PHASE(1, ph_qkv(p, lds));
    SEAM(1);
    PHASE(2, ph_attn(p, lds));
    SEAM(2);
    PHASE(3, ph_oproj(p, lds, (const bf16_t*)(p.ws + WS_AO), (const bf16_t*)(p.ws + WS_WONA), p.in[8], p.in[0], p.out));
    SEAM(3);
    PHASE(4, ph_router(p, p.out, 0));
    SEAM(4);
    PHASE(6, ph_moe(p, lds, 0));
    SEAM(6);
    PHASE(7, ph_combine_mix(p));
    SEAM(7);
    PHASE(9, ph_rwkv_proj(p, lds));
    SEAM(9);
    PHASE(11, ph_gate(p, lds));
    PHASE(11, ph_scan_prep(p, lds));
    SEAM(11);
    PHASE(12, ph_scan_state(p));
    SEAM(12);
    PHASE(13, ph_scan_out(p, lds));
    SEAM(13);
    PHASE(14, ph_oproj(p, lds, (const bf16_t*)(p.ws + WS_Z), (const bf16_t*)(p.ws + WS_WORW), nullptr, (const float*)(p.ws + WS_HB), p.out));
    SEAM(14);
    PHASE(15, ph_router(p, p.out, 1));
    SEAM(15);
    PHASE(17, ph_moe(p, lds, 1));
    SEAM(17);
    PHASE(18, ph_final(p));
}

extern "C" void kernel_launch(void* const* d_in, const int* in_sizes, int n_in, void* d_out, int out_size, void* d_ws, size_t ws_size, hipStream_t stream) {
    static int grid = 0;
    if (grid == 0) {
        if (n_in != 34 || out_size != T * D || ws_size < WS_END) { fprintf(stderr, "kernel_launch: unexpected shapes (n_in %d out %d ws %zu)\n", n_in, out_size, ws_size); grid = -1; return; }
        int dev = 0, cus = 0, per_cu = 0;
        if (hipGetDevice(&dev) != hipSuccess || hipDeviceGetAttribute(&cus, hipDeviceAttributeMultiprocessorCount, dev) != hipSuccess) { grid = -1; return; }
        if (hipFuncSetAttribute((const void*)fwd, hipFuncAttributeMaxDynamicSharedMemorySize, LDS_BYTES) != hipSuccess) { fprintf(stderr, "kernel_launch: hipFuncSetAttribute failed\n"); grid = -1; return; }
        if (hipOccupancyMaxActiveBlocksPerMultiprocessor(&per_cu, (const void*)fwd, NTHR, LDS_BYTES) != hipSuccess || per_cu < 1) { fprintf(stderr, "kernel_launch: occupancy query failed (%d)\n", per_cu); grid = -1; return; }
        if (cus < 256) { fprintf(stderr, "kernel_launch: built for a 256-CU device (got %d)\n", cus); grid = -1; return; }
        grid = 256;
    }
    if (grid < 0) return;
    (void)hipMemsetAsync((char*)d_ws + WS_CTL, 0, 1 * MiB, stream);
    Params p{};
    for (int i = 0; i < 34; ++i) p.in[i] = (const float*)d_in[i];
    p.out = (float*)d_out; p.ws = (unsigned char*)d_ws;
#if MK_FUSED
    hipLaunchKernelGGL(fwd, dim3(grid), dim3(NTHR), LDS_BYTES, stream, p, 0, NPH);
#else
    for (int k = 0; k < NPH; ++k) hipLaunchKernelGGL(fwd, dim3(grid), dim3(NTHR), LDS_BYTES, stream, p, k, k + 1);
#endif
}
```

```cpp
#include <hip/hip_runtime.h>
#include <cstdint>
#include <cstdio>

#define LAS __attribute__((address_space(3)))
typedef unsigned short bf16_t;
typedef short bf16x8 __attribute__((ext_vector_type(8)));
typedef float f32x4 __attribute__((ext_vector_type(4)));
typedef float f32x16 __attribute__((ext_vector_type(16)));
typedef unsigned u32x4 __attribute__((ext_vector_type(4)));
typedef unsigned u32x2 __attribute__((ext_vector_type(2)));

constexpr int T = 8192, D = 2048, NH = 32, HD = 64, GW = 64, ROWS = 128;
constexpr int NEXP = 32, FF = 512;
constexpr int NTHR = 512;
#ifndef MK_FUSED
#define MK_FUSED 1
#endif

constexpr size_t MiB = 1u << 20;
constexpr size_t WS_CTL = 0;
constexpr size_t WS_LIST = 1 * MiB;
constexpr size_t WS_CW = 3 * MiB;
constexpr size_t WS_RGF = 3 * MiB + 256 * 1024;
constexpr size_t WS_REF = 3 * MiB + 384 * 1024;
constexpr size_t WS_WQKV = 4 * MiB;
constexpr size_t WS_WONA = 28 * MiB;
constexpr size_t WS_WR = 36 * MiB, WS_WK = 44 * MiB, WS_WV = 52 * MiB, WS_WORW = 60 * MiB;
constexpr size_t WS_W1T = 68 * MiB, WS_A1T = 69 * MiB, WS_G1T = 70 * MiB;
constexpr size_t WS_W2T = 71 * MiB, WS_A2T = 72 * MiB;
constexpr size_t WS_G2T = 73 * MiB;
constexpr size_t WS_GB = 74 * MiB;
constexpr size_t WS_FB = 138 * MiB;
constexpr size_t WS_GYB = 330 * MiB;
constexpr size_t WS_HS = 394 * MiB;
constexpr size_t WS_HB = 458 * MiB;
constexpr size_t WS_HN = 522 * MiB;
constexpr size_t WS_SBON = 522 * MiB;
constexpr size_t WS_ACT = 554 * MiB;
constexpr size_t WS_ACT1 = 666 * MiB;
constexpr size_t WS_Y = 570 * MiB;
constexpr size_t WS_Z = 570 * MiB;
constexpr size_t WS_FYB = 602 * MiB;
constexpr size_t WS_Q = 634 * MiB, WS_K = 666 * MiB, WS_VT = 698 * MiB, WS_AO = 730 * MiB;
constexpr size_t WS_MIX = 698 * MiB;
constexpr size_t WS_G = 698 * MiB;
constexpr size_t WS_R = 890 * MiB, WS_K2 = 922 * MiB, WS_V2 = 954 * MiB;
constexpr size_t WS_LW = 986 * MiB, WS_LA = 990 * MiB, WS_GL = 994 * MiB;
constexpr size_t WS_END = 998 * MiB;

constexpr int CW_BAR = 4096;
constexpr int CW_CNT0 = 16384, CW_CNT1 = 16384 + 64;
constexpr int CW_MOEQ = 20480;
constexpr int CW_MOEMT = 24576;

constexpr int LDS_MISC = 159744;
constexpr int LDS_PREF = LDS_MISC;
constexpr int LDS_XB = LDS_MISC + 256;
constexpr int LDS_SEG = LDS_MISC + 512;
constexpr int LDS_ELEND = LDS_MISC + 1024;
constexpr int LDS_TILE_E = LDS_MISC + 2048;
constexpr int LDS_MOEQ = LDS_MISC + 3072;
constexpr int LDS_BYTES = 163840;

struct Params {
    const float* in[34];
    float* out;
    unsigned char* ws;
};
typedef const __attribute__((address_space(4))) Params CPar;

typedef float f32x2_t __attribute__((ext_vector_type(2)));
typedef __bf16 bf16x2_t __attribute__((ext_vector_type(2)));
__device__ __forceinline__ unsigned pk2(float lo, float hi) { const f32x2_t v = {lo, hi}; return __builtin_bit_cast(unsigned, __builtin_convertvector(v, bf16x2_t)); }
__device__ __forceinline__ unsigned f2bf(float f) { return pk2(f, 0.f) & 0xffffu; }
__device__ __forceinline__ float bflo(unsigned u) { return __builtin_bit_cast(float, u << 16); }
__device__ __forceinline__ float bfhi(unsigned u) { return __builtin_bit_cast(float, u & 0xffff0000u); }
__device__ __forceinline__ float bf2f(bf16_t b) { return __builtin_bit_cast(float, (unsigned)b << 16); }
__device__ __forceinline__ void lds_barrier() { asm volatile("s_waitcnt lgkmcnt(0)" ::: "memory"); __builtin_amdgcn_s_barrier(); asm volatile("" ::: "memory"); }
__device__ __forceinline__ float wave_sum(float v) {
#pragma unroll
    for (int o = 32; o; o >>= 1) v += __shfl_xor(v, o);
    return v;
}
__device__ __forceinline__ int otid() { int t = threadIdx.x; asm volatile("" : "+v"(t)); return t; }
__device__ __forceinline__ float tanhf_(float x) { return 1.f - 2.f * __builtin_amdgcn_rcpf(1.f + __expf(2.f * x)); }
__device__ __forceinline__ float sigmoidf_(float x) { return __builtin_amdgcn_rcpf(1.f + __expf(-x)); }

#define XB_TMO      128
#define XB_XCNT(j)  (256  + 64 * (j))
#define XB_XSUB(j)  (1280 + 64 * (j))
#define XB_XGEN(j)  (2304 + 64 * (j))
#define XB_TOP      3328
#define XB_TOPGEN   3392
#define XCD_BAR_WORDS 3456
#define XB_SPIN_CAP (1u << 18)
__device__ __forceinline__ unsigned xb_ld(unsigned* p)              { return __hip_atomic_load(p, __ATOMIC_RELAXED, __HIP_MEMORY_SCOPE_AGENT); }
__device__ __forceinline__ unsigned xb_add(unsigned* p, unsigned v) { return __hip_atomic_fetch_add(p, v, __ATOMIC_RELAXED, __HIP_MEMORY_SCOPE_AGENT); }
__device__ __forceinline__ unsigned xb_xcc_id() { return (unsigned)__builtin_amdgcn_s_getreg((3 << 11) | 20) & 0xFu; }
#define XB_SPIN(cond, bar) do { unsigned _sp = 0; while (cond) { __builtin_amdgcn_s_sleep(1); \
    if ((++_sp & 255u) == 0u) { if (xb_ld(&(bar)[XB_TMO])) break; if (_sp > XB_SPIN_CAP) { atomicAdd(&(bar)[XB_TMO], 1u); break; } } } } while (0)
struct XcdBarrier { unsigned* bar; unsigned x; volatile LAS unsigned* st; };
__device__ __forceinline__ XcdBarrier xcd_barrier_post(unsigned* bar, volatile LAS unsigned* st) {
    XcdBarrier b; b.bar = bar; b.x = xb_xcc_id(); b.st = st;
    if (threadIdx.x == 0) (void)xb_add(&bar[XB_XCNT(b.x)], 1u);
    return b;
}
__device__ __forceinline__ void xcd_barrier_complete(unsigned* bar, unsigned x, unsigned& nloc, unsigned& nx) {
    const unsigned G = gridDim.x * gridDim.y * gridDim.z;
    unsigned sum, cnt, mine, sp = 0u;
    for (;;) {
        sum = 0u; cnt = 0u; mine = 0u;
#pragma unroll
        for (unsigned j = 0; j < 16; ++j) { const unsigned c = xb_ld(&bar[XB_XCNT(j)]); sum += c; cnt += (c > 0u) ? 1u : 0u; mine = (j == x) ? c : mine; }
        if (sum == G) break;
        __builtin_amdgcn_s_sleep(1);
        if ((++sp & 255u) == 0u) { if (xb_ld(&bar[XB_TMO])) break; if (sp > XB_SPIN_CAP) { atomicAdd(&bar[XB_TMO], 1u); break; } }
    }
    nloc = mine > 0u ? mine : 1u; nx = cnt > 0u ? cnt : 1u;
}
__device__ __forceinline__ void xcd_barrier(const XcdBarrier& b) {
    asm volatile("s_waitcnt vmcnt(0)" ::: "memory");
    __syncthreads();
    if (threadIdx.x == 0) {
        unsigned* bar = b.bar;
        __builtin_amdgcn_s_waitcnt(0);
        unsigned nloc = b.st[0], nx = b.st[1];
        if (nloc == 0u) { xcd_barrier_complete(bar, b.x, nloc, nx); b.st[0] = nloc; b.st[1] = nx; }
        const unsigned old = xb_add(&bar[XB_XSUB(b.x)], 1u);
        const unsigned gen = old / nloc;
        if (old + 1u == (gen + 1u) * nloc) {
            __builtin_amdgcn_fence(__ATOMIC_RELEASE, "agent");
            asm volatile("s_waitcnt vmcnt(0)" ::: "memory");
            const unsigned og = xb_add(&bar[XB_TOP], 1u);
            const unsigned tg = og / nx;
            if (og + 1u == (tg + 1u) * nx) xb_add(&bar[XB_TOPGEN], 1u);
            else XB_SPIN(xb_ld(&bar[XB_TOPGEN]) == tg, bar);
            __builtin_amdgcn_fence(__ATOMIC_ACQUIRE, "agent");
            xb_add(&bar[XB_XGEN(b.x)], 1u);
            asm volatile("s_waitcnt vmcnt(0)" ::: "memory");
        } else {
            XB_SPIN(xb_ld(&bar[XB_XGEN(b.x)]) == gen, bar);
            __builtin_amdgcn_fence(__ATOMIC_ACQUIRE, "agent");
            asm volatile("s_waitcnt vmcnt(0)" ::: "memory");
        }
    }
    __syncthreads();
}

template <class Epi>
__device__ __forceinline__ void gemm_tile_moe(const int tid, LAS char* lds, const bf16_t* __restrict__ A, int lda, const int* __restrict__ rows, int nvalid, int rshift,
                                              const float* __restrict__ bsrc, int ldn, int K, const Epi& epi) {
    const int lane = tid & 63, wid = tid >> 6, wm = wid >> 1, wn = wid & 1;
    const int srow = tid >> 3, sch = tid & 7;
    unsigned offA[4];
#pragma unroll
    for (int i = 0; i < 4; ++i) {
        const int r = srow + i * 64;
        const int rr = r < nvalid ? r : 0;
        offA[i] = (unsigned)(rows[rr] >> rshift) * (unsigned)lda + sch * 8;
    }
#define MOE_KEY(r_) ((((r_) >> 2) & 7) ^ ((((r_) >> 1) & 1) << 2))
    const unsigned ldsw = srow * 128 + ((sch ^ MOE_KEY(srow)) << 4);
    const int nq = tid & 31, kq = tid >> 5;
    unsigned ldsb[4];
#pragma unroll
    for (int c = 0; c < 4; ++c) { const int rho = nq * 4 + c; ldsb[c] = 32768u + rho * 128 + ((((kq >> 1)) ^ MOE_KEY(rho)) << 4) + (kq & 1) * 8; }
    const float* bp = bsrc + (size_t)(kq * 4) * ldn;
    const int l31 = lane & 31, lh = lane >> 5, key = MOE_KEY(l31);
    const unsigned ra = (wm * 64 + l31) * 128;
    const unsigned rb = 32768 + (wn * 64 + l31) * 128;
    unsigned kc[4];
#pragma unroll
    for (int ks = 0; ks < 4; ++ks) kc[ks] = ((ks * 2 + lh) ^ key) << 4;
    f32x16 acc[2][2];
#pragma unroll
    for (int mi = 0; mi < 2; ++mi)
#pragma unroll
        for (int nj = 0; nj < 2; ++nj)
#pragma unroll
            for (int e = 0; e < 16; ++e) acc[mi][nj][e] = 0.f;
    u32x4 xa[4], ya[4]; f32x4 xb[4], yb[4];
    const int nt = K >> 6;
#define MOE_LOAD(ra_, rb_, tt) do { _Pragma("unroll") for (int i = 0; i < 4; ++i) { ra_[i] = *(const u32x4*)(A + offA[i] + (tt) * 64); rb_[i] = *(const f32x4*)(bp + (size_t)((tt) * 64 + i) * ldn); } } while (0)
#define MOE_STORE(ra_, rb_, so_) do { _Pragma("unroll") for (int i = 0; i < 4; ++i) *(LAS u32x4*)(lds + (so_) + ldsw + i * 8192) = ra_[i]; \
        _Pragma("unroll") for (int c = 0; c < 4; ++c) { u32x2 o; o.x = pk2(rb_[0][c], rb_[1][c]); o.y = pk2(rb_[2][c], rb_[3][c]); *(LAS u32x2*)(lds + (so_) + ldsb[c]) = o; } } while (0)
#define MOE_FRAGS(so_, ks, AF, BQ) do { _Pragma("unroll") for (int mi = 0; mi < 2; ++mi) AF[mi] = *(const LAS bf16x8*)(lds + (so_) + ra + mi * 4096 + kc[ks]); \
        _Pragma("unroll") for (int nj = 0; nj < 2; ++nj) BQ[nj] = *(const LAS bf16x8*)(lds + (so_) + rb + nj * 4096 + kc[ks]); } while (0)
#define MOE_MMA(AF, BQ) do { _Pragma("unroll") for (int mi = 0; mi < 2; ++mi) _Pragma("unroll") for (int nj = 0; nj < 2; ++nj) \
        acc[mi][nj] = __builtin_amdgcn_mfma_f32_32x32x16_bf16(BQ[nj], AF[mi], acc[mi][nj], 0, 0, 0); } while (0)
#define MOE_SB __builtin_amdgcn_sched_barrier(0)
#define MOE_COMPUTE(so_) do { bf16x8 afA[2], bqA[2], afB[2], bqB[2]; \
        MOE_FRAGS(so_, 0, afA, bqA); MOE_FRAGS(so_, 1, afB, bqB); MOE_SB; MOE_MMA(afA, bqA); MOE_SB; \
        MOE_FRAGS(so_, 2, afA, bqA); MOE_SB; MOE_MMA(afB, bqB); MOE_SB; \
        MOE_FRAGS(so_, 3, afB, bqB); MOE_SB; MOE_MMA(afA, bqA); MOE_SB; MOE_MMA(afB, bqB); } while (0)
#define MOE_STEP(tt, SA_, SB_, LA_, LB_) do { \
        if ((tt) + 2 < nt) MOE_LOAD(LA_, LB_, (tt) + 2); \
        __builtin_amdgcn_sched_barrier(0); \
        MOE_COMPUTE(((tt) & 1) * 49152u); \
        __builtin_amdgcn_sched_barrier(0); \
        if ((tt) + 1 < nt) MOE_STORE(SA_, SB_, (((tt) + 1) & 1) * 49152u); \
        __syncthreads(); } while (0)
    MOE_LOAD(xa, xb, 0);
    MOE_STORE(xa, xb, 0u);
    if (nt > 1) MOE_LOAD(xa, xb, 1);
    __syncthreads();
    for (int t = 0; t < nt; t += 8) {
        MOE_STEP(t, xa, xb, ya, yb); MOE_STEP(t + 1, ya, yb, xa, xb); MOE_STEP(t + 2, xa, xb, ya, yb); MOE_STEP(t + 3, ya, yb, xa, xb);
        MOE_STEP(t + 4, xa, xb, ya, yb); MOE_STEP(t + 5, ya, yb, xa, xb); MOE_STEP(t + 6, xa, xb, ya, yb); MOE_STEP(t + 7, ya, yb, xa, xb);
    }
#undef MOE_STEP
#undef MOE_COMPUTE
#undef MOE_FRAGS
#undef MOE_MMA
#undef MOE_SB
#undef MOE_LOAD
#undef MOE_STORE
#undef MOE_KEY
    epi(acc, wm, wn, l31, lh);
}

typedef __attribute__((address_space(1))) unsigned gu32;
struct EpiMoeGU3 {
    bf16_t* act; const float* cw; const int* rows; int nvalid; int f0; LAS char* lds; int tid; gu32* mtc;
    __device__ __forceinline__ void operator()(const f32x16 (&acc)[2][2], int wm, int wn, int l31, int lh) const {
#pragma unroll
        for (int mi = 0; mi < 2; ++mi) {
            const int ml = wm * 64 + mi * 32 + l31;
            const float w = ml < nvalid ? cw[rows[ml]] : 0.f;
#pragma unroll
            for (int rg = 0; rg < 4; ++rg) {
                float o[4];
#pragma unroll
                for (int e = 0; e < 4; ++e) { const float g = acc[mi][0][4 * rg + e], u = acc[mi][1][4 * rg + e]; o[e] = g * sigmoidf_(g) * u * w; }
                u32x2 ov; ov.x = pk2(o[0], o[1]); ov.y = pk2(o[2], o[3]);
                *(LAS u32x2*)(lds + ml * 144 + (wn * 32 + 8 * rg + 4 * lh) * 2) = ov;
            }
        }
        __syncthreads();
        const __amdgpu_buffer_rsrc_t rs = __builtin_amdgcn_make_buffer_rsrc((void*)act, 0, 2 * T * FF * 2, 0x00020000);
#pragma unroll
        for (int i = 0; i < 4; ++i) {
            const int row = (tid >> 3) + 64 * i, pc = tid & 7;
            if (row < nvalid) {
                const u32x4 v = *(const LAS u32x4*)(lds + row * 144 + pc * 16);
                __builtin_amdgcn_raw_buffer_store_b128(v, rs, (rows[row] * FF + f0 + pc * 8) * 2, 0,   16);
            }
        }
        asm volatile("s_waitcnt vmcnt(0)" ::: "memory");
        if ((tid & 63) == 0) (void)__hip_atomic_fetch_add(mtc, 1u, __ATOMIC_RELAXED, __HIP_MEMORY_SCOPE_AGENT);
        __syncthreads();
    }
};
struct EpiMoeD2 {
    bf16_t* y; const int* rows; int nvalid; int n0; LAS char* lds; int tid;
    __device__ __forceinline__ void operator()(const f32x16 (&acc)[2][2], int wm, int wn, int l31, int lh) const {
#pragma unroll
        for (int mi = 0; mi < 2; ++mi) {
            const int ml = wm * 64 + mi * 32 + l31;
#pragma unroll
            for (int nj = 0; nj < 2; ++nj)
#pragma unroll
                for (int rg = 0; rg < 4; ++rg) {
                    u32x2 o; o.x = pk2(acc[mi][nj][4 * rg], acc[mi][nj][4 * rg + 1]); o.y = pk2(acc[mi][nj][4 * rg + 2], acc[mi][nj][4 * rg + 3]);
                    *(LAS u32x2*)(lds + ml * 272 + (wn * 64 + nj * 32 + 8 * rg + 4 * lh) * 2) = o;
                }
        }
        __syncthreads();
#pragma unroll
        for (int i = 0; i < 8; ++i) {
            const int row = (tid >> 4) + 32 * i, pc = tid & 15;
            if (row < nvalid) {
                const u32x4 v = *(const LAS u32x4*)(lds + row * 272 + pc * 16);
                *(u32x4*)(y + (size_t)rows[row] * D + n0 + pc * 8) = v;
            }
        }
        __syncthreads();
    }
};
namespace pg8 {
#define PG8_LAS __attribute__((address_space(3)))
typedef unsigned short bf16_t;
typedef short bf16x8 __attribute__((ext_vector_type(8)));
typedef float f32x4 __attribute__((ext_vector_type(4)));
typedef unsigned u32x4 __attribute__((ext_vector_type(4)));
constexpr int BM = 256, BK = 64, HALF = 128, HTB = HALF * BK * 2  , STAGE_BYTES = 8 * HTB, NXCD = 8, WGM = 8;

__host__ __device__ __forceinline__ int lds_byte(int r, int c) { const int st = (r >> 4) * 2 + (c >> 5), rr = r & 15, cc = c & 31, ob = rr * 64 + cc * 2; return st * 1024 + (ob ^ (((ob >> 9) & 1) << 5)); }
__host__ __device__ __forceinline__ void stage_rc(int b, int& R, int& C) { const int st = b / 1024, sb = b % 1024, swz = sb ^ (((sb >> 9) & 1) << 5); R = (st >> 1) * 16 + swz / 64; C = (st & 1) * 32 + (swz % 64) / 2; }
__host__ __device__ __forceinline__ int perm32(int rho) { const int n = rho >> 4, i = rho & 15; return 8 * (i >> 2) + 4 * n + (i & 3); }

struct Unit { int pm, pn; };
struct Gemm { const bf16_t* A; const bf16_t* Bt; int M, N, K; };

struct StaticOrder {
    int nM, nN, nwg, G, c;
    __host__ __device__ void init(int M, int N, int G_, int c_) { nM = M / BM; nN = N / BM; nwg = nM * nN; G = G_; c = c_; }
    __host__ __device__ bool next(int i, Unit& u) const {
        const long L = (long)i * G + c; if (L >= nwg) return false;
        int wgid = (int)L; { const int q = nwg / NXCD, r = nwg % NXCD, xcd = wgid % NXCD, off = wgid / NXCD; wgid = (xcd < r ? xcd * (q + 1) : r * (q + 1) + (xcd - r) * q) + off; }
        const int nig = WGM * nN, gid = wgid / nig, fm = gid * WGM, gsz = (nM - fm) < WGM ? (nM - fm) : WGM;
        u.pm = fm + ((wgid % nig) % gsz); u.pn = (wgid % nig) / gsz; return true;
    }
    __device__ __forceinline__ void a_ready(const Unit&) const {}
    __device__ __forceinline__ void done(const Unit&) const {}
};

__device__ __forceinline__ unsigned cvt_pk_bf16(float lo, float hi) { unsigned r; asm volatile("v_cvt_pk_bf16_f32 %0, %1, %2" : "=v"(r) : "v"(lo), "v"(hi)); return r; }

template <class Epi, class Sched, bool ALIGN_EPI = false, bool SP2 = false>
__device__ __forceinline__ void gemm_phase(const int tid, PG8_LAS unsigned char* lds, const Gemm g, const Sched& S, const Epi& E) {
    const int wid = __builtin_amdgcn_readfirstlane(tid >> 6), lane = tid & 63, wr = wid >> 2, wc = wid & 3, fr = lane & 15, fq = lane >> 4;
    const int K = g.K, nt = K / BK;
    unsigned voffA[2], voffB[2];
#pragma unroll
    for (int i = 0; i < 2; ++i) { int R, C; stage_rc(tid * 16 + i * 8192, R, C); const int Rb = Epi::PERM ? ((R & ~31) + perm32(R & 31)) : R;
        voffA[i] = (unsigned)(R * K + C) * 2u; voffB[i] = (unsigned)(Rb * K + C) * 2u; }
    const size_t kstep = (size_t)(BK * 2);
    const size_t hstep = (size_t)HALF * K * 2;
    const size_t tstep = 2 * hstep;
    const unsigned ldsw = (unsigned)wid * 1024u;
    const int aoff = lds_byte(wr * 64 + fr, fq * 8), boff = lds_byte(wc * 32 + fr, fq * 8);
#define PG8_SA(b, h) (((b) * 2 + (h)) * HTB)
#define PG8_SB(b, h) ((4 + (b) * 2 + (h)) * HTB)
#define PG8_STAGE(bufoff, gbase, voff) do { _Pragma("unroll") for (int _i = 0; _i < 2; ++_i) \
        __builtin_amdgcn_global_load_lds((const unsigned*)((const char*)(gbase) + (voff)[_i]), (PG8_LAS unsigned*)(lds + (bufoff) + ldsw + _i * 8192), 16, 0, 0); } while (0)
#define PG8_LDA(dst, b, h) do { _Pragma("unroll") for (int m = 0; m < 4; ++m) _Pragma("unroll") for (int k = 0; k < 2; ++k) dst[m][k] = *(const PG8_LAS bf16x8*)(lds + PG8_SA(b, h) + aoff + m * 2048 + k * 1024); } while (0)
#define PG8_LDB(dst, b, h) do { _Pragma("unroll") for (int n = 0; n < 2; ++n) _Pragma("unroll") for (int k = 0; k < 2; ++k) dst[n][k] = *(const PG8_LAS bf16x8*)(lds + PG8_SB(b, h) + boff + n * 2048 + k * 1024); } while (0)
#define PG8_MMA(ai, bj, At, Bt) do { __builtin_amdgcn_s_setprio(1); _Pragma("unroll") for (int m = 0; m < 4; ++m) _Pragma("unroll") for (int n = 0; n < 2; ++n) _Pragma("unroll") for (int k = 0; k < 2; ++k) \
        acc[ai][bj][m][n] = __builtin_amdgcn_mfma_f32_16x16x32_bf16(Bt[n][k], At[m][k], acc[ai][bj][m][n], 0, 0, 0); __builtin_amdgcn_s_setprio(0); } while (0)
#define PG8_WAIT_V(n) asm volatile("s_waitcnt vmcnt(" #n ")" ::: "memory")
#define PG8_WAIT_L(n) asm volatile("s_waitcnt lgkmcnt(" #n ")" ::: "memory")
#define PG8_BAR __builtin_amdgcn_s_barrier()
#define PG8_SCHED __builtin_amdgcn_sched_barrier(0)
    Unit cur, nxt; int ui = 0;
    if (!S.next(0, cur)) return;
    f32x4 acc[2][2][4][2];
#pragma unroll
    for (int a = 0; a < 2; ++a)
#pragma unroll
        for (int b = 0; b < 2; ++b)
#pragma unroll
            for (int m = 0; m < 4; ++m)
#pragma unroll
                for (int n = 0; n < 2; ++n) acc[a][b][m][n] = (f32x4){0.f, 0.f, 0.f, 0.f};
    bf16x8 At[4][2], B0[2][2], B1[2][2];
    const char* cA = (const char*)g.A + (size_t)cur.pm * tstep; const char* cB = (const char*)g.Bt + (size_t)cur.pn * tstep;
    S.a_ready(cur);
    if constexpr (SP2) {
        PG8_STAGE(PG8_SB(0, 0), cB, voffB); PG8_STAGE(PG8_SB(0, 1), cB + hstep, voffB); PG8_STAGE(PG8_SA(0, 0), cA, voffA); PG8_STAGE(PG8_SA(0, 1), cA + hstep, voffA);
        if (wr == 1) PG8_BAR;
        PG8_WAIT_V(2); PG8_BAR;
        PG8_STAGE(PG8_SB(1, 0), cB + kstep, voffB); PG8_STAGE(PG8_SA(1, 0), cA + kstep, voffA); PG8_STAGE(PG8_SB(1, 1), cB + hstep + kstep, voffB);
        PG8_WAIT_V(6); PG8_BAR;
    } else {
        PG8_STAGE(PG8_SB(0, 0), cB, voffB); PG8_STAGE(PG8_SA(0, 0), cA, voffA); PG8_STAGE(PG8_SB(0, 1), cB + hstep, voffB); PG8_STAGE(PG8_SA(0, 1), cA + hstep, voffA);
        if (wr == 1) PG8_BAR;
        PG8_WAIT_V(4); PG8_BAR;
        PG8_STAGE(PG8_SB(1, 0), cB + kstep, voffB); PG8_STAGE(PG8_SA(1, 0), cA + kstep, voffA); PG8_STAGE(PG8_SB(1, 1), cB + hstep + kstep, voffB);
        PG8_WAIT_V(6); PG8_BAR;
    }
    for (;;) {
        const bool has_next = S.next(ui + 1, nxt);
        const char* nA = has_next ? (const char*)g.A + (size_t)nxt.pm * tstep : cA; const char* nB = has_next ? (const char*)g.Bt + (size_t)nxt.pn * tstep : cB;
        for (int t = 0; t < nt; t += 2) {
            const bool last = (t == nt - 2);
            const char* a1 = cA + (size_t)(t + 1) * kstep;
            const char* a2 = last ? nA : cA + (size_t)(t + 2) * kstep; const char* b2 = last ? nB : cB + (size_t)(t + 2) * kstep;
            const char* a3 = a2 + kstep; const char* b3 = b2 + kstep;
            if (last && has_next) S.a_ready(nxt);
            if constexpr (SP2) {
            PG8_LDB(B0, 0, 0); PG8_LDB(B1, 0, 1); PG8_SCHED; PG8_LDA(At, 0, 0); PG8_STAGE(PG8_SA(1, 1), a1 + hstep, voffA);
            PG8_WAIT_V(8); PG8_WAIT_L(0); PG8_BAR; PG8_MMA(0, 0, At, B0); PG8_MMA(0, 1, At, B1); PG8_BAR; PG8_SCHED;
            PG8_LDA(At, 0, 1); PG8_STAGE(PG8_SB(0, 0), b2, voffB); PG8_STAGE(PG8_SB(0, 1), b2 + hstep, voffB); PG8_STAGE(PG8_SA(0, 0), a2, voffA);
            PG8_WAIT_V(8); PG8_WAIT_L(0); PG8_BAR; PG8_MMA(1, 0, At, B0); PG8_MMA(1, 1, At, B1); PG8_BAR; PG8_SCHED;
            PG8_LDB(B0, 1, 0); PG8_LDB(B1, 1, 1); PG8_SCHED; PG8_LDA(At, 1, 0); PG8_STAGE(PG8_SA(0, 1), a2 + hstep, voffA);
            PG8_WAIT_V(8); PG8_WAIT_L(0); PG8_BAR; PG8_MMA(0, 0, At, B0); PG8_MMA(0, 1, At, B1); PG8_BAR; PG8_SCHED;
            PG8_LDA(At, 1, 1); PG8_STAGE(PG8_SB(1, 0), b3, voffB); PG8_STAGE(PG8_SB(1, 1), b3 + hstep, voffB); PG8_STAGE(PG8_SA(1, 0), a3, voffA);
            PG8_WAIT_V(8); PG8_WAIT_L(0); PG8_BAR; PG8_MMA(1, 0, At, B0); PG8_MMA(1, 1, At, B1); PG8_BAR; PG8_SCHED;
            } else {
            PG8_LDB(B0, 0, 0); PG8_SCHED; PG8_LDA(At, 0, 0); PG8_STAGE(PG8_SA(1, 1), a1 + hstep, voffA);
            PG8_WAIT_L(8); PG8_BAR; PG8_WAIT_L(0); PG8_MMA(0, 0, At, B0); PG8_BAR; PG8_SCHED;
            PG8_LDB(B1, 0, 1); PG8_STAGE(PG8_SB(0, 0), b2, voffB);
            PG8_BAR; PG8_WAIT_L(0); PG8_MMA(0, 1, At, B1); PG8_BAR;
            PG8_LDA(At, 0, 1); PG8_STAGE(PG8_SA(0, 0), a2, voffA);
            PG8_BAR; PG8_WAIT_L(0); PG8_MMA(1, 0, At, B0); PG8_BAR; PG8_SCHED;
            PG8_STAGE(PG8_SB(0, 1), b2 + hstep, voffB);
            PG8_WAIT_V(6); PG8_BAR; PG8_MMA(1, 1, At, B1); PG8_BAR;
            PG8_LDB(B0, 1, 0); PG8_SCHED; PG8_LDA(At, 1, 0); PG8_STAGE(PG8_SA(0, 1), a2 + hstep, voffA);
            PG8_WAIT_L(8); PG8_BAR; PG8_WAIT_L(0); PG8_MMA(0, 0, At, B0); PG8_BAR; PG8_SCHED;
            PG8_LDB(B1, 1, 1); PG8_STAGE(PG8_SB(1, 0), b3, voffB);
            PG8_BAR; PG8_WAIT_L(0); PG8_MMA(0, 1, At, B1); PG8_BAR;
            PG8_LDA(At, 1, 1); PG8_STAGE(PG8_SA(1, 0), a3, voffA);
            PG8_BAR; PG8_WAIT_L(0); PG8_MMA(1, 0, At, B0); PG8_BAR; PG8_SCHED;
            PG8_STAGE(PG8_SB(1, 1), b3 + hstep, voffB);
            PG8_WAIT_V(6); PG8_BAR; PG8_MMA(1, 1, At, B1); PG8_BAR;
            }
        }
        if constexpr (ALIGN_EPI) { if (wr == 0) PG8_BAR; }
        if constexpr (!Epi::AFTER_DRAIN) { E(acc, cur, wr, wc, fr, fq); S.done(cur); }
        if (!has_next) break;
#pragma unroll
        for (int a = 0; a < 2; ++a)
#pragma unroll
            for (int b = 0; b < 2; ++b)
#pragma unroll
                for (int m = 0; m < 4; ++m)
#pragma unroll
                    for (int n = 0; n < 2; ++n) acc[a][b][m][n] = (f32x4){0.f, 0.f, 0.f, 0.f};
        cur = nxt; cA = nA; cB = nB; ++ui;
        if constexpr (ALIGN_EPI) { if (wr == 1) PG8_BAR; }
    }
    PG8_WAIT_V(0);
    if constexpr (!ALIGN_EPI) { if (wr == 0) PG8_BAR; }
    PG8_BAR;
    if constexpr (Epi::AFTER_DRAIN) { E.fused(acc, cur, wr, wc, fr, fq, lds, wid, lane); S.done(cur); }
#undef PG8_SA
#undef PG8_SB
#undef PG8_STAGE
#undef PG8_LDA
#undef PG8_LDB
#undef PG8_MMA
#undef PG8_WAIT_V
#undef PG8_WAIT_L
#undef PG8_BAR
#undef PG8_SCHED
}

struct PEpiQK {
    static constexpr bool PERM = true, AFTER_DRAIN = false;
    bf16_t* q; bf16_t* k; const float* bias;
    __device__ __forceinline__ void operator()(const f32x4 (&acc)[2][2][4][2], const Unit& u, int wr, int wc, int fr, int fq) const {
        const int row0 = u.pm * BM + wr * 64 + fr, colt = u.pn * BM;
        const bool isq = colt < 2048; const float sc = isq ? 0.125f : 1.f;
        const int cbase = (isq ? colt : colt - 2048) + wc * 32 + 8 * fq, bcol = colt + wc * 32 + 8 * fq;
#pragma unroll
        for (int bj = 0; bj < 2; ++bj) {
            const f32x4 b0 = *(const f32x4*)(bias + bcol + bj * HALF), b1 = *(const f32x4*)(bias + bcol + bj * HALF + 4);
            const int kc = cbase + bj * HALF, hh = kc >> 6, d0 = kc & 63;
#pragma unroll
            for (int ai = 0; ai < 2; ++ai)
#pragma unroll
                for (int m = 0; m < 4; ++m) {
                    const f32x4 v0 = (acc[ai][bj][m][0] + b0) * sc, v1 = (acc[ai][bj][m][1] + b1) * sc;
                    u32x4 w; w.x = cvt_pk_bf16(v0[0], v0[1]); w.y = cvt_pk_bf16(v0[2], v0[3]); w.z = cvt_pk_bf16(v1[0], v1[1]); w.w = cvt_pk_bf16(v1[2], v1[3]);
                    const int tok = row0 + ai * HALF + m * 16;
                    if (isq) *(u32x4*)(q + (size_t)tok * 2048 + kc) = w;
                    else { const int R = tok >> 6, c = tok & 63;
                        *(u32x4*)(k + ((((((size_t)(R * 32 + hh) * 8 + (c >> 3)) * 2 + ((c >> 2) & 1)) * 2 + (d0 >> 5)) * 4 + (c & 3)) * 4 + ((d0 >> 3) & 3)) * 8) = w; }
                }
        }
    }
};
struct PEpiVT {
    static constexpr bool PERM = true, AFTER_DRAIN = false;
    bf16_t* vt; const float* bias;
    __device__ __forceinline__ void operator()(const f32x4 (&acc)[2][2][4][2], const Unit& u, int wr, int wc, int fr, int fq) const {
        const int row0 = u.pm * BM + wr * 64 + fr, col0 = u.pn * BM + wc * 32 + 8 * fq;
#pragma unroll
        for (int ai = 0; ai < 2; ++ai)
#pragma unroll
            for (int m = 0; m < 4; ++m) {
                const int c = row0 + ai * HALF + m * 16; const float b = bias[c];
#pragma unroll
                for (int bj = 0; bj < 2; ++bj) {
                    const f32x4 v0 = acc[ai][bj][m][0] + b, v1 = acc[ai][bj][m][1] + b;
                    u32x4 w; w.x = cvt_pk_bf16(v0[0], v0[1]); w.y = cvt_pk_bf16(v0[2], v0[3]); w.z = cvt_pk_bf16(v1[0], v1[1]); w.w = cvt_pk_bf16(v1[2], v1[3]);
                    { const int tok = col0 + bj * HALF, R = tok >> 6, cgp = (tok & 63) >> 3;
                      *(u32x4*)(vt + ((((size_t)(R * 32 + (c >> 6)) * 8 + cgp) * 64 + (c & 63)) * 8)) = w; }
                }
            }
    }
};
struct PEpiResid {
    static constexpr bool PERM = false, AFTER_DRAIN = false;
    const float* src; float* dst; const float* bias;
    __device__ __forceinline__ void operator()(const f32x4 (&acc)[2][2][4][2], const Unit& u, int wr, int wc, int fr, int fq) const {
        const int row0 = u.pm * BM + wr * 64 + fr, col0 = u.pn * BM + wc * 32 + 4 * fq;
        f32x4 bv[2][2];
#pragma unroll
        for (int bj = 0; bj < 2; ++bj)
#pragma unroll
            for (int n = 0; n < 2; ++n) bv[bj][n] = bias ? *(const f32x4*)(bias + col0 + bj * HALF + n * 16) : (f32x4){0.f, 0.f, 0.f, 0.f};
#pragma unroll
        for (int ai = 0; ai < 2; ++ai)
#pragma unroll
            for (int mh = 0; mh < 2; ++mh) {
                f32x4 sv[2][2][2];
#pragma unroll
                for (int ml = 0; ml < 2; ++ml)
#pragma unroll
                    for (int bj = 0; bj < 2; ++bj)
#pragma unroll
                        for (int n = 0; n < 2; ++n) sv[ml][bj][n] = *(const f32x4*)(src + (size_t)(row0 + ai * HALF + (mh * 2 + ml) * 16) * 2048 + col0 + bj * HALF + n * 16);
                asm volatile("" ::: "memory");
#pragma unroll
                for (int ml = 0; ml < 2; ++ml)
#pragma unroll
                    for (int bj = 0; bj < 2; ++bj)
#pragma unroll
                        for (int n = 0; n < 2; ++n) *(f32x4*)(dst + (size_t)(row0 + ai * HALF + (mh * 2 + ml) * 16) * 2048 + col0 + bj * HALF + n * 16) = sv[ml][bj][n] + acc[ai][bj][mh * 2 + ml][n] + bv[bj][n];
                asm volatile("" ::: "memory");
            }
    }
};
struct PEpiRwkv {
    static constexpr bool PERM = true, AFTER_DRAIN = false;
    bf16_t* rkv;
    bf16_t* lw; bf16_t* la; bf16_t* gl;
    __device__ __forceinline__ void operator()(const f32x4 (&acc)[2][2][4][2], const Unit& u, int wr, int wc, int fr, int fq) const {
        const int which = u.pm >> 5, row0 = (u.pm & 31) * BM + wr * 64 + fr;
#pragma unroll
        for (int bj = 0; bj < 2; ++bj)
#pragma unroll
            for (int ai = 0; ai < 2; ++ai)
#pragma unroll
                for (int m = 0; m < 4; ++m) {
                    f32x4 v0 = acc[ai][bj][m][0], v1 = acc[ai][bj][m][1];
                    const int t = row0 + ai * HALF + m * 16;
                    bf16_t* dp;
                    if (which < 3) dp = rkv + (size_t)which * 8192 * 2048 + (size_t)t * 2048 + (u.pn - which * 8) * BM + bj * HALF + wc * 32 + 8 * fq;
                    else {
                        const int j = bj * HALF + wc * 32 + 8 * fq;
#pragma unroll
                        for (int e = 0; e < 4; ++e) {
                            if (which == 3) { v0[e] = tanhf_(v0[e]); v1[e] = tanhf_(v1[e]); }
                            else if (which == 5) { v0[e] = __builtin_amdgcn_rcpf(1.f + __expf(-v0[e])); v1[e] = __builtin_amdgcn_rcpf(1.f + __expf(-v1[e])); }
                        }
                        dp = which == 5 ? gl + (size_t)t * 256 + j : (which == 3 ? lw : la) + ((((size_t)(j >> 7) * 512 + (t >> 4)) * 4 + ((j & 127) >> 5)) * 64 + ((j >> 3) & 3) * 16 + (t & 15)) * 8;
                    }
                    u32x4 w; w.x = cvt_pk_bf16(v0[0], v0[1]); w.y = cvt_pk_bf16(v0[2], v0[3]); w.z = cvt_pk_bf16(v1[0], v1[1]); w.w = cvt_pk_bf16(v1[2], v1[3]);
                    *(u32x4*)dp = w;
                }
    }
};
struct PEpiPlain {
    static constexpr bool PERM = true, AFTER_DRAIN = false;
    bf16_t* dst;
    __device__ __forceinline__ void operator()(const f32x4 (&acc)[2][2][4][2], const Unit& u, int wr, int wc, int fr, int fq) const {
        const int row0 = u.pm * BM + wr * 64 + fr, col0 = u.pn * BM + wc * 32 + 8 * fq;
#pragma unroll
        for (int ai = 0; ai < 2; ++ai)
#pragma unroll
            for (int m = 0; m < 4; ++m)
#pragma unroll
                for (int bj = 0; bj < 2; ++bj) {
                    const f32x4 v0 = acc[ai][bj][m][0], v1 = acc[ai][bj][m][1];
                    u32x4 w; w.x = cvt_pk_bf16(v0[0], v0[1]); w.y = cvt_pk_bf16(v0[2], v0[3]); w.z = cvt_pk_bf16(v1[0], v1[1]); w.w = cvt_pk_bf16(v1[2], v1[3]);
                    *(u32x4*)(dst + (size_t)(row0 + ai * HALF + m * 16) * 2048 + col0 + bj * HALF) = w;
                }
    }
};
struct RwkvOrder {
    int G, c;
    __device__ bool next(int i, Unit& u) const {
        const int L = i * G + ((c & 7) * (G >> 3) + (c >> 3));
        if (L >= 864) return false;
        if (L < 768) { const int which = L >> 8, r = L & 255; u.pm = which * 32 + (r >> 3); u.pn = which * 8 + (r & 7); }
        else { const int r = L - 768, which = 3 + (r >> 5); u.pm = which * 32 + (r & 31); u.pn = 32 + (which - 3); }
        return true;
    }
    __device__ __forceinline__ void a_ready(const Unit&) const {}
    __device__ __forceinline__ void done(const Unit&) const {}
};
}

struct ConvJob { const float* src; bf16_t* dst; int ldn, Kreal, Nreal, k0, n0, ldk, mode; };
constexpr int CONV_LDS = 64 * 132 * 4;
__device__ __forceinline__ void conv_load(const int tid, const ConvJob& j, f32x4 (&w)[4]) {
    const int kq = tid >> 5, nc = (tid & 31) * 4;
#pragma unroll
    for (int i = 0; i < 4; ++i) {
        const int k = j.k0 + kq * 4 + i;
        w[i] = (f32x4){0.f, 0.f, 0.f, 0.f};
        if (k < j.Kreal && j.n0 + nc < j.Nreal) w[i] = *(const f32x4*)(j.src + (size_t)k * j.ldn + j.n0 + nc);
    }
}
__device__ __forceinline__ void conv_stage(const int tid, LAS char* lb, const f32x4 (&w)[4]) {
    const int kq = tid >> 5, nc = (tid & 31) * 4;
#pragma unroll
    for (int i = 0; i < 4; ++i) *(LAS f32x4*)(lb + ((kq * 4 + i) * 132 + nc) * 4) = w[i];
}
__device__ __forceinline__ void conv_finish(const int tid, const LAS char* lb, const ConvJob& j) {
    const int n = tid >> 2, part = tid & 3;
    float w[16];
#pragma unroll
    for (int i = 0; i < 16; ++i) w[i] = *(const LAS float*)(lb + ((part * 16 + i) * 132 + n) * 4);
    u32x4 o0, o1;
    o0.x = pk2(w[0], w[1]); o0.y = pk2(w[2], w[3]); o0.z = pk2(w[4], w[5]); o0.w = pk2(w[6], w[7]);
    o1.x = pk2(w[8], w[9]); o1.y = pk2(w[10], w[11]); o1.z = pk2(w[12], w[13]); o1.w = pk2(w[14], w[15]);
    if (j.mode == 3) {
        const int nn = j.n0 + n, kk = j.k0 + part * 16;
        bf16_t* dp = j.dst + ((((size_t)(nn >> 4) * 4 + (kk >> 5)) * 64 + ((kk >> 3) & 3) * 16 + (nn & 15)) * 8);
        *(u32x4*)dp = o0; *(u32x4*)(dp + 128) = o1;
    } else {
        bf16_t* dp = j.dst + (size_t)(j.n0 + n) * j.ldk + j.k0 + part * 16;
        *(u32x4*)dp = o0; *(u32x4*)(dp + 8) = o1;
    }
}
__device__ __forceinline__ ConvJob conv_decode(CPar& p, int id) {
    unsigned char* ws = p.ws;
    if (id < 1536) { const int kt = id / 48, nt = id % 48; return ConvJob{p.in[4], (bf16_t*)(ws + WS_WQKV), 3 * D, D, 3 * D, kt * 64, nt * 128, D, 0}; }
    id -= 1536;
    if (id < 2560) {
        const int w = id / 512, r = id % 512, kt = r / 16, nt = r % 16;
        const float* src = w == 0 ? p.in[7] : w == 1 ? p.in[10] : w == 2 ? p.in[11] : w == 3 ? p.in[12] : p.in[13];
        const size_t off = w == 0 ? WS_WONA : w == 1 ? WS_WR : w == 2 ? WS_WK : w == 3 ? WS_WV : WS_WORW;
        return ConvJob{src, (bf16_t*)(ws + off), D, D, D, kt * 64, nt * 128, D, 0};
    }
    id -= 2560;
    if (id < 128) {
        const int which = id / 64, r = id % 64, z = r / 32, kt = r % 32;
        const float* src = (which == 0 ? p.in[15] : p.in[18]) + (size_t)z * D * 96;
        bf16_t* dst = (bf16_t*)(ws + (which == 0 ? WS_W1T : WS_A1T)) + (size_t)z * 128 * D;
        return ConvJob{src, dst, 96, D, 96, kt * 64, 0, D, 0};
    }
    id -= 128;
    if (id < 64) { const int kt = id / 2, nt = id % 2; return ConvJob{p.in[20], (bf16_t*)(ws + WS_G1T), 256, D, 256, kt * 64, nt * 128, D, 0}; }
    id -= 64;
    if (id < 128) {
        const int which = id / 64, r = id % 64, z = r / 32, r2 = r % 32, kt = r2 / 16, nt = r2 % 16;
        const float* src = (which == 0 ? p.in[16] : p.in[19]) + (size_t)z * 96 * D;
        bf16_t* dst = (bf16_t*)(ws + (which == 0 ? WS_W2T : WS_A2T)) + (size_t)z * D * 128;
        return ConvJob{src, dst, D, 96, D, kt * 64, nt * 128, 128, 3};
    }
    id -= 128;
    const int kt = id / 16, nt = id % 16;
    return ConvJob{p.in[21], (bf16_t*)(ws + WS_G2T), D, 256, D, kt * 64, nt * 128, 256, 0};
}
constexpr int N_CONV_JOBS = 1536 + 2560 + 128 + 64 + 128 + 64;

__device__ __forceinline__ void rms_row_bf16(const f32x4 (&x)[8], const LAS float* g, bf16_t* __restrict__ dst, int lane) {
    float ss = 0.f;
#pragma unroll
    for (int j = 0; j < 8; ++j) ss += x[j][0] * x[j][0] + x[j][1] * x[j][1] + x[j][2] * x[j][2] + x[j][3] * x[j][3];
    ss = wave_sum(ss);
    const float inv = rsqrtf(ss * (1.f / D) + 1e-6f);
#pragma unroll
    for (int j = 0; j < 8; ++j) {
        const f32x4 gv = *(const LAS f32x4*)(g + (j * 64 + lane) * 4);
        u32x2 o; o.x = pk2(x[j][0] * inv * gv[0], x[j][1] * inv * gv[1]); o.y = pk2(x[j][2] * inv * gv[2], x[j][3] * inv * gv[3]);
        *(u32x2*)(dst + (j * 64 + lane) * 4) = o;
    }
}

__device__ __forceinline__ void ph_prologue(CPar& p, LAS char* lds) {
    const int tid = otid();
    {
        int id = blockIdx.x, buf = 0;
        ConvJob cur{}; f32x4 w[4];
        if (id < N_CONV_JOBS) { cur = conv_decode(p, id); conv_load(tid, cur, w); }
        for (; id < N_CONV_JOBS; id += gridDim.x) {
            LAS char* lb = lds + buf * CONV_LDS;
            conv_stage(tid, lb, w);
            __syncthreads();
            ConvJob nxt = cur;
            if (id + (int)gridDim.x < N_CONV_JOBS) { nxt = conv_decode(p, id + gridDim.x); conv_load(tid, nxt, w); }
            conv_finish(tid, lb, cur);
            cur = nxt; buf ^= 1;
        }
    }
    {
        float* rgf = (float*)(p.ws + WS_RGF); float* ref = (float*)(p.ws + WS_REF);
        for (int i = blockIdx.x * NTHR + tid; i < 2 * 8 * 4 * 64; i += gridDim.x * NTHR) {
            const int ln = i & 63, c = (i >> 6) & 3, j = (i >> 8) & 7, layer = i >> 11, d = (j * 64 + ln) * 4 + c;
            *(f32x4*)(rgf + (size_t)i * 4) = *(const f32x4*)(p.in[27] + ((size_t)layer * D + d) * 4);
        }
        for (int i = blockIdx.x * NTHR + tid; i < 2 * 4 * 8 * 4 * 2 * 64; i += gridDim.x * NTHR) {
            const int ln = i & 63, hf = (i >> 6) & 1, c = (i >> 7) & 3, j = (i >> 9) & 7, gq = (i >> 12) & 3, layer = i >> 14, d = (j * 64 + ln) * 4 + c;
            *(f32x4*)(ref + (size_t)i * 4) = *(const f32x4*)(p.in[29] + (((size_t)layer * 4 + gq) * D + d) * 8 + hf * 4);
        }
    }
    const int lane = tid & 63, gw = blockIdx.x * 8 + (tid >> 6), nw = gridDim.x * 8;
    bf16_t* hn = (bf16_t*)(p.ws + WS_HN);
    __syncthreads();
    LAS float* lg = (LAS float*)lds;
    for (int i = tid; i < D / 4; i += NTHR) *(LAS f32x4*)(lg + i * 4) = *(const f32x4*)(p.in[1] + i * 4);
    __syncthreads();
    f32x4 x[8], xn[8];
    if (gw < T) {
#pragma unroll
        for (int j = 0; j < 8; ++j) x[j] = *(const f32x4*)(p.in[0] + (size_t)gw * D + (j * 64 + lane) * 4);
    }
    for (int t = gw; t < T; t += nw) {
        const int tn = t + nw < T ? t + nw : t;
#pragma unroll
        for (int j = 0; j < 8; ++j) xn[j] = *(const f32x4*)(p.in[0] + (size_t)tn * D + (j * 64 + lane) * 4);
        rms_row_bf16(x, lg, hn + (size_t)t * D, lane);
#pragma unroll
        for (int j = 0; j < 8; ++j) x[j] = xn[j];
    }
}

__device__ __forceinline__ void ph_qkv(CPar& p, LAS char* lds) {
    const int tid = otid();
    const bf16_t* hn = (const bf16_t*)(p.ws + WS_HN); const bf16_t* w = (const bf16_t*)(p.ws + WS_WQKV);
    {
        pg8::Gemm g{hn, w, T, 2 * D, D}; pg8::StaticOrder S; S.init(T, 2 * D, (int)gridDim.x, (int)blockIdx.x);
        pg8::PEpiQK E{(bf16_t*)(p.ws + WS_Q), (bf16_t*)(p.ws + WS_K), p.in[5]};
        pg8::gemm_phase<pg8::PEpiQK, pg8::StaticOrder, true, true>(tid, (LAS unsigned char*)lds, g, S, E);
    }
    {
        pg8::Gemm g{w + (size_t)2 * D * D, hn, D, T, D}; pg8::StaticOrder S; S.init(D, T, (int)gridDim.x, (int)blockIdx.x);
        pg8::PEpiVT E{(bf16_t*)(p.ws + WS_VT), p.in[5] + 2 * D};
        pg8::gemm_phase<pg8::PEpiVT, pg8::StaticOrder, true, true>(tid, (LAS unsigned char*)lds, g, S, E);
    }
}

template <int OFF>
__device__ __forceinline__ void attn_pair(const int lane, const bf16_t* __restrict__ Q, const bf16_t* __restrict__ Kp, const bf16_t* __restrict__ Vt, bf16_t* __restrict__ AO,
                                          const LAS float* rb, const int r0, const int h, const int cb, const int rs0) {
    constexpr int NR = 8 + OFF;
    const int qi = lane & 15, g = lane >> 4;
    int bs = cb * 16 - 8; bs = bs < 0 ? 0 : (bs > 32 ? 32 : bs);
    const int qc = cb * 16 + qi;
    int wsx = qc - 8; wsx = wsx < 0 ? 0 : (wsx > 48 ? 48 : wsx);
    const size_t tq = (size_t)r0 * GW + qc;
    bf16x8 qf[2][2];
#pragma unroll
    for (int q = 0; q < 2; ++q) {
        qf[q][0] = *(const bf16x8*)(Q + (tq + q * GW) * D + h * HD + 8 * g);
        qf[q][1] = *(const bf16x8*)(Q + (tq + q * GW) * D + h * HD + 32 + 8 * g);
    }
    f32x4 s[2][8][2];
#pragma unroll
    for (int i = 0; i < NR; ++i)
#pragma unroll
        for (int tt = 0; tt < 2; ++tt) {
            const bf16_t* kp = Kp + ((((((size_t)((rs0 + i) * 32 + h) * 8 + (bs >> 3) + (qi >> 2)) * 2 + tt) * 2) * 4 + (qi & 3)) * 4 + g) * 8;
            const bf16x8 kf0 = *(const bf16x8*)kp;
            const bf16x8 kf1 = *(const bf16x8*)(kp + 128);
            if (i < 8) {
                f32x4 a = {0.f, 0.f, 0.f, 0.f};
                a = __builtin_amdgcn_mfma_f32_16x16x32_bf16(kf0, qf[0][0], a, 0, 0, 0);
                a = __builtin_amdgcn_mfma_f32_16x16x32_bf16(kf1, qf[0][1], a, 0, 0, 0);
                s[0][i][tt] = a;
            }
            if (i >= OFF) {
                f32x4 a = {0.f, 0.f, 0.f, 0.f};
                a = __builtin_amdgcn_mfma_f32_16x16x32_bf16(kf0, qf[1][0], a, 0, 0, 0);
                a = __builtin_amdgcn_mfma_f32_16x16x32_bf16(kf1, qf[1][1], a, 0, 0, 0);
                s[1][i - OFF][tt] = a;
            }
        }
    int relx[2][4]; bool okc[2][4];
#pragma unroll
    for (int tt = 0; tt < 2; ++tt)
#pragma unroll
        for (int e = 0; e < 4; ++e) {
            const int kcol = bs + 8 * g + 4 * tt + e;
            int rel = kcol - qc; rel = rel < -15 ? -15 : (rel > 15 ? 15 : rel);
            relx[tt][e] = rel + 15; okc[tt][e] = (kcol >= wsx) && (kcol < wsx + 16);
        }
    float inv[2];
    u32x4 pw[2][8];
#pragma unroll
    for (int q = 0; q < 2; ++q) {
        float mx = -1e30f;
#pragma unroll
        for (int j = 0; j < 8; ++j) {
            const int ri = (rs0 + q * OFF + j) - (r0 + q) + 7;
#pragma unroll
            for (int tt = 0; tt < 2; ++tt)
#pragma unroll
                for (int e = 0; e < 4; ++e) {
                    const float bv = rb[ri * 31 + relx[tt][e]];
                    const float v = okc[tt][e] ? s[q][j][tt][e] + bv : -1e30f;
                    s[q][j][tt][e] = v; mx = fmaxf(mx, v);
                }
        }
        mx = fmaxf(mx, __shfl_xor(mx, 16)); mx = fmaxf(mx, __shfl_xor(mx, 32));
        float sum = 0.f;
#pragma unroll
        for (int j = 0; j < 8; ++j) {
            float pv[2][4];
#pragma unroll
            for (int tt = 0; tt < 2; ++tt)
#pragma unroll
                for (int e = 0; e < 4; ++e) { pv[tt][e] = __expf(s[q][j][tt][e] - mx); sum += pv[tt][e]; }
            pw[q][j].x = pk2(pv[0][0], pv[0][1]); pw[q][j].y = pk2(pv[0][2], pv[0][3]); pw[q][j].z = pk2(pv[1][0], pv[1][1]); pw[q][j].w = pk2(pv[1][2], pv[1][3]);
        }
        sum += __shfl_xor(sum, 16); sum += __shfl_xor(sum, 32);
        inv[q] = 1.f / sum;
    }
    f32x4 o[2][4];
#pragma unroll
    for (int q = 0; q < 2; ++q)
#pragma unroll
        for (int dt = 0; dt < 4; ++dt) o[q][dt] = (f32x4){0.f, 0.f, 0.f, 0.f};
#pragma unroll
    for (int i0 = 0; i0 < NR; i0 += 3) {
        u32x4 va[3][4];
#pragma unroll
        for (int ii = 0; ii < 3; ++ii)
            if (i0 + ii < NR) {
                const bf16_t* vp = Vt + (((size_t)((rs0 + i0 + ii) * 32 + h) * 8 + (bs >> 3) + g) * 64 + qi) * 8;
#pragma unroll
                for (int dt = 0; dt < 4; ++dt) va[ii][dt] = *(const u32x4*)(vp + dt * 128);
            }
#pragma unroll
        for (int ii = 0; ii < 3; ++ii)
            if (i0 + ii < NR) {
                const int i = i0 + ii;
                if (i < 8) {
                    const bf16x8 pf = __builtin_bit_cast(bf16x8, pw[0][i]);
#pragma unroll
                    for (int dt = 0; dt < 4; ++dt) o[0][dt] = __builtin_amdgcn_mfma_f32_16x16x32_bf16(__builtin_bit_cast(bf16x8, va[ii][dt]), pf, o[0][dt], 0, 0, 0);
                }
                if (i >= OFF) {
                    const bf16x8 pf = __builtin_bit_cast(bf16x8, pw[1][i - OFF]);
#pragma unroll
                    for (int dt = 0; dt < 4; ++dt) o[1][dt] = __builtin_amdgcn_mfma_f32_16x16x32_bf16(__builtin_bit_cast(bf16x8, va[ii][dt]), pf, o[1][dt], 0, 0, 0);
                }
            }
    }
#pragma unroll
    for (int q = 0; q < 2; ++q)
#pragma unroll
        for (int dt = 0; dt < 4; ++dt) {
            u32x2 ov; ov.x = pk2(o[q][dt][0] * inv[q], o[q][dt][1] * inv[q]); ov.y = pk2(o[q][dt][2] * inv[q], o[q][dt][3] * inv[q]);
            *(u32x2*)(AO + (tq + q * GW) * D + h * HD + dt * 16 + 4 * g) = ov;
        }
}
__device__ __forceinline__ void ph_attn(CPar& p, LAS char* lds) {
    const int tid = otid(), lane = tid & 63, gw = blockIdx.x * 8 + __builtin_amdgcn_readfirstlane(tid >> 6), nw = gridDim.x * 8;
    const bf16_t* Q = (const bf16_t*)(p.ws + WS_Q); const bf16_t* Kp = (const bf16_t*)(p.ws + WS_K); const bf16_t* Vt = (const bf16_t*)(p.ws + WS_VT);
    bf16_t* AO = (bf16_t*)(p.ws + WS_AO);
    LAS float* rpbs = (LAS float*)lds;
    for (int i = tid; i < NH * 15 * 31; i += NTHR) rpbs[i] = p.in[6][i];
    __syncthreads();
    for (int u = gw; u < (ROWS / 2) * NH * 4; u += nw) {
        const int cb = u & 3, h = (u >> 2) & 31, r0 = (u >> 7) * 2;
        int rs0 = r0 - 4; rs0 = rs0 < 0 ? 0 : (rs0 > ROWS - 8 ? ROWS - 8 : rs0);
        int rs1 = r0 - 3; rs1 = rs1 < 0 ? 0 : (rs1 > ROWS - 8 ? ROWS - 8 : rs1);
        const LAS float* rb = rpbs + h * 15 * 31;
        if (rs1 != rs0) attn_pair<1>(lane, Q, Kp, Vt, AO, rb, r0, h, cb, rs0);
        else attn_pair<0>(lane, Q, Kp, Vt, AO, rb, r0, h, cb, rs0);
    }
}

__device__ __forceinline__ void ph_oproj(CPar& p, LAS char* lds, const bf16_t* A, const bf16_t* W, const float* bias, const float* src, float* dst) {
    const int tid = otid();
    pg8::Gemm g{A, W, T, D, D}; pg8::StaticOrder S; S.init(T, D, (int)gridDim.x, (int)blockIdx.x);
    pg8::PEpiResid E{src, dst, bias};
    pg8::gemm_phase<pg8::PEpiResid, pg8::StaticOrder, true, true>(tid, (LAS unsigned char*)lds, g, S, E);
}

__device__ __forceinline__ void ph_router(CPar& p, const float* __restrict__ h, int layer) {
    const int tid = otid(), lane = tid & 63, gw = blockIdx.x * 8 + (tid >> 6), nw = gridDim.x * 8;
    bf16_t* hn = (bf16_t*)(p.ws + WS_HN);
    const float* g = p.in[2] + layer * D;
    const float* wrg = (const float*)(p.ws + WS_RGF) + (size_t)layer * 8 * 4 * 64 * 4; const float* brg = p.in[28] + layer * 4;
    const float* wre = (const float*)(p.ws + WS_REF) + (size_t)layer * 4 * 8 * 4 * 2 * 64 * 4; const float* bre = p.in[30] + layer * 32;
    unsigned* cnt = (unsigned*)(p.ws + WS_CTL) + (layer ? CW_CNT1 : CW_CNT0);
    int* list = (int*)(p.ws + WS_LIST) + (size_t)layer * NEXP * T;
    float* cw = (float*)(p.ws + WS_CW) + (size_t)layer * 2 * T;
    for (int t0 = gw; t0 < T; t0 += 2 * nw) {
        const float* hrow[2]; float inv[2];
#pragma unroll
        for (int k = 0; k < 2; ++k) hrow[k] = h + (size_t)(t0 + k * nw) * D;
        {
            float ss[2] = {0.f, 0.f};
#pragma unroll 2
            for (int j = 0; j < 8; ++j)
#pragma unroll
                for (int k = 0; k < 2; ++k) { const f32x4 xv = *(const f32x4*)(hrow[k] + (j * 64 + lane) * 4); ss[k] += xv[0] * xv[0] + xv[1] * xv[1] + xv[2] * xv[2] + xv[3] * xv[3]; }
#pragma unroll
            for (int k = 0; k < 2; ++k) inv[k] = rsqrtf(wave_sum(ss[k]) * (1.f / D) + 1e-6f);
        }
        float gl[2][4];
#pragma unroll
        for (int k = 0; k < 2; ++k)
#pragma unroll
            for (int e = 0; e < 4; ++e) gl[k][e] = 0.f;
#pragma unroll 1
        for (int j = 0; j < 8; ++j) {
            const int d0 = (j * 64 + lane) * 4;
            const f32x4 gv = *(const f32x4*)(g + d0);
            f32x4 wr4[4];
#pragma unroll
            for (int c = 0; c < 4; ++c) wr4[c] = *(const f32x4*)(wrg + ((size_t)(j * 4 + c) * 64 + lane) * 4);
#pragma unroll
            for (int k = 0; k < 2; ++k) {
                f32x4 xv = *(const f32x4*)(hrow[k] + d0);
                xv[0] *= inv[k] * gv[0]; xv[1] *= inv[k] * gv[1]; xv[2] *= inv[k] * gv[2]; xv[3] *= inv[k] * gv[3];
                u32x2 o; o.x = pk2(xv[0], xv[1]); o.y = pk2(xv[2], xv[3]);
                *(u32x2*)(hn + (size_t)(t0 + k * nw) * D + d0) = o;
#pragma unroll
                for (int c = 0; c < 4; ++c) { gl[k][0] += xv[c] * wr4[c][0]; gl[k][1] += xv[c] * wr4[c][1]; gl[k][2] += xv[c] * wr4[c][2]; gl[k][3] += xv[c] * wr4[c][3]; }
            }
        }
        int gi[2]; float gwt[2];
#pragma unroll
        for (int k = 0; k < 2; ++k) {
            const float l0 = wave_sum(gl[k][0]) + brg[0], l1 = wave_sum(gl[k][1]) + brg[1], l2 = wave_sum(gl[k][2]) + brg[2], l3 = wave_sum(gl[k][3]) + brg[3];
            int gq = 0; float gm = l0;
            if (l1 > gm) { gm = l1; gq = 1; }
            if (l2 > gm) { gm = l2; gq = 2; }
            if (l3 > gm) { gm = l3; gq = 3; }
            gwt[k] = 1.f / (__expf(l0 - gm) + __expf(l1 - gm) + __expf(l2 - gm) + __expf(l3 - gm));
            gi[k] = __builtin_amdgcn_readfirstlane(gq);
        }
        float el[2][8];
#pragma unroll
        for (int k = 0; k < 2; ++k)
#pragma unroll
            for (int e = 0; e < 8; ++e) el[k][e] = 0.f;
#pragma unroll 1
        for (int j = 0; j < 8; ++j) {
            const int d0 = (j * 64 + lane) * 4;
            const f32x4 gv = *(const f32x4*)(g + d0);
#pragma unroll
            for (int k = 0; k < 2; ++k) {
                const float* we = wre + (size_t)gi[k] * 8 * 4 * 2 * 64 * 4;
                f32x4 xv = *(const f32x4*)(hrow[k] + d0);
                xv[0] *= inv[k] * gv[0]; xv[1] *= inv[k] * gv[1]; xv[2] *= inv[k] * gv[2]; xv[3] *= inv[k] * gv[3];
#pragma unroll
                for (int c = 0; c < 4; ++c) {
                    const f32x4 w0 = *(const f32x4*)(we + ((size_t)((j * 4 + c) * 2) * 64 + lane) * 4), w1 = *(const f32x4*)(we + ((size_t)((j * 4 + c) * 2 + 1) * 64 + lane) * 4);
                    el[k][0] += xv[c] * w0[0]; el[k][1] += xv[c] * w0[1]; el[k][2] += xv[c] * w0[2]; el[k][3] += xv[c] * w0[3];
                    el[k][4] += xv[c] * w1[0]; el[k][5] += xv[c] * w1[1]; el[k][6] += xv[c] * w1[2]; el[k][7] += xv[c] * w1[3];
                }
            }
        }
#pragma unroll
        for (int k = 0; k < 2; ++k) {
            const int t = t0 + k * nw;
            int i1 = 0; float m1 = -1e30f;
#pragma unroll
            for (int e = 0; e < 8; ++e) { el[k][e] = wave_sum(el[k][e]) + bre[gi[k] * 8 + e]; if (el[k][e] > m1) { m1 = el[k][e]; i1 = e; } }
            int i2 = 0; float m2 = -1e30f;
#pragma unroll
            for (int e = 0; e < 8; ++e) { if (e != i1 && el[k][e] > m2) { m2 = el[k][e]; i2 = e; } }
            const float e21 = __expf(m2 - m1);
            const float w1 = 1.f / (1.f + e21), w2 = e21 / (1.f + e21);
            if (lane == 0) {
                const int ea = gi[k] * 8 + i1, eb = gi[k] * 8 + i2;
                const unsigned pa = atomicAdd(&cnt[ea], 1u); list[ea * T + pa] = 2 * t; cw[2 * t] = gwt[k] * w1;
                const unsigned pb = atomicAdd(&cnt[eb], 1u); list[eb * T + pb] = 2 * t + 1; cw[2 * t + 1] = gwt[k] * w2;
            }
        }
    }
}

__device__ __forceinline__ void moe_prefix(const int tid, CPar& p, LAS char* lds, int layer) {
    const unsigned* cnt = (const unsigned*)(p.ws + WS_CTL) + (layer ? CW_CNT1 : CW_CNT0);
    LAS int* pref = (LAS int*)(lds + LDS_PREF);
    __syncthreads();
    if (tid == 0) {
        LAS int* te = (LAS int*)(lds + LDS_TILE_E);
        int acc = 0;
        for (int e = 0; e < NEXP; ++e) { pref[e] = acc; const int n = (int)((cnt[e] + 255u) >> 8); for (int k = 0; k < n; ++k) te[acc + k] = e; acc += n; }
        pref[NEXP] = acc;
    }
    __syncthreads();
}
__device__ __forceinline__ void ph_moe(CPar& p, LAS char* lds, int layer) {
    const int tid0 = otid();
    moe_prefix(tid0, p, lds, layer);
    LAS int* pref = (LAS int*)(lds + LDS_PREF);
    LAS int* curp = (LAS int*)(lds + LDS_MOEQ);
    const unsigned* cnt = (const unsigned*)(p.ws + WS_CTL) + (layer ? CW_CNT1 : CW_CNT0);
    gu32* qh = (gu32*)((unsigned*)(p.ws + WS_CTL) + CW_MOEQ + layer * 64);
    gu32* mtc0 = (gu32*)((unsigned*)(p.ws + WS_CTL) + CW_MOEMT + layer * 4096);
    unsigned* tmo = (unsigned*)(p.ws + WS_CTL) + CW_BAR + XB_TMO;
    const int* list = (const int*)(p.ws + WS_LIST) + (size_t)layer * NEXP * T;
    const float* cw = (const float*)(p.ws + WS_CW) + (size_t)layer * 2 * T;
    const bf16_t* hn = (const bf16_t*)(p.ws + WS_HN);
    bf16_t* act = (bf16_t*)(p.ws + (layer ? WS_ACT1 : WS_ACT));
    const int ntile = pref[NEXP], ngu = ntile * 8, total = ntile * 24;
    if (tid0 == 0) curp[0] = (int)__hip_atomic_fetch_add(qh, 1u, __ATOMIC_RELAXED, __HIP_MEMORY_SCOPE_AGENT);
    __syncthreads();
    int cur = __builtin_amdgcn_readfirstlane(curp[0]);
    while (cur < total) {
        int tid = tid0; asm volatile("" : "+v"(tid));
        unsigned nxt = 0u;
        if (tid == 0) nxt = __hip_atomic_fetch_add(qh, 1u, __ATOMIC_RELAXED, __HIP_MEMORY_SCOPE_AGENT);
        if (cur < ngu) {
            const int mt = cur >> 3, j = cur & 7;
            const int e = ((LAS int*)(lds + LDS_TILE_E))[mt];
            const int lt = mt - pref[e];
            const int nvalid = min(256, (int)cnt[e] - lt * 256);
            const int* rows = list + e * T + lt * 256;
            const int rho0 = (tid & 31) * 4;
            const float* wsrc = ((rho0 >> 5) & 1 ? p.in[32] : p.in[31]) + (size_t)(layer * NEXP + e) * D * FF + j * 64 + (rho0 >> 6) * 32 + (rho0 & 31);
            EpiMoeGU3 ep{act, cw, rows, nvalid, j * 64, lds, tid, mtc0 + mt * 32};
            gemm_tile_moe(tid, lds, hn, D, rows, nvalid, 1, wsrc, FF, D, ep);
        } else {
            const int d = cur - ngu, mt = d >> 4, pn = d & 15;
            if ((tid >> 6) == 0) {
                gu32* c = mtc0 + mt * 32;
                unsigned sp = 0u;
                while ((unsigned)__builtin_amdgcn_readfirstlane(__hip_atomic_load(c, __ATOMIC_RELAXED, __HIP_MEMORY_SCOPE_AGENT)) < 64u) {
                    __builtin_amdgcn_s_sleep(1);
                    if ((++sp & 255u) == 0u) { if (xb_ld(tmo)) break; if (sp > XB_SPIN_CAP) { atomicAdd(tmo, 1u); break; } }
                }
                __builtin_amdgcn_fence(__ATOMIC_ACQUIRE, "agent");
                asm volatile("s_waitcnt vmcnt(0)" ::: "memory");
            }
            __syncthreads();
            const int e = ((LAS int*)(lds + LDS_TILE_E))[mt];
            const int lt = mt - pref[e];
            const int nvalid = min(256, (int)cnt[e] - lt * 256);
            const int* rows = list + e * T + lt * 256;
            const float* wsrc = p.in[33] + (size_t)(layer * NEXP + e) * FF * D + pn * 128 + (tid & 31) * 4;
            EpiMoeD2 ep{(bf16_t*)(p.ws + WS_Y), rows, nvalid, pn * 128, lds, tid};
            gemm_tile_moe(tid, lds, act, FF, rows, nvalid, 0, wsrc, D, FF, ep);
        }
        if (tid == 0) curp[0] = (int)nxt;
        __syncthreads();
        cur = __builtin_amdgcn_readfirstlane(curp[0]);
    }
}

__device__ __forceinline__ void ph_combine_mix(CPar& p, LAS char* lds) {
    const int tid = otid(), lane = tid & 63, gw = blockIdx.x * 8 + (tid >> 6), nw = gridDim.x * 8;
    const float* h1 = p.out; float* h2 = (float*)(p.ws + WS_HB);
    const bf16_t* y = (const bf16_t*)(p.ws + WS_Y); const float* g = p.in[1] + D; bf16_t* mixo = (bf16_t*)(p.ws + WS_MIX); const float* mix = p.in[9];
    LAS float* lg = (LAS float*)lds; LAS float* lmix = (LAS float*)(lds + 8192);
    for (int i = tid; i < D / 4; i += NTHR) *(LAS f32x4*)(lg + i * 4) = *(const f32x4*)(g + i * 4);
    for (int i = tid; i < 6 * D / 4; i += NTHR) *(LAS f32x4*)(lmix + i * 4) = *(const f32x4*)(mix + i * 4);
    __syncthreads();
#define CM_ROW(dst, r, own) do { const int r_ = (r); \
        if (r_ < 0 || r_ >= T) { _Pragma("unroll") for (int j = 0; j < 8; ++j) dst[j] = (f32x4){0.f, 0.f, 0.f, 0.f}; } \
        else { float ss = 0.f; \
            _Pragma("unroll") for (int j = 0; j < 8; ++j) { const int d0 = (j * 64 + lane) * 4; \
                f32x4 x = *(const f32x4*)(h1 + (size_t)r_ * D + d0); \
                const u32x2 a = *(const u32x2*)(y + (size_t)(2 * r_) * D + d0), bq = *(const u32x2*)(y + (size_t)(2 * r_ + 1) * D + d0); \
                x[0] += bflo(a.x) + bflo(bq.x); x[1] += bfhi(a.x) + bfhi(bq.x); x[2] += bflo(a.y) + bflo(bq.y); x[3] += bfhi(a.y) + bfhi(bq.y); \
                if (own) *(f32x4*)(h2 + (size_t)r_ * D + d0) = x; \
                ss += x[0] * x[0] + x[1] * x[1] + x[2] * x[2] + x[3] * x[3]; dst[j] = x; } \
            const float inv = rsqrtf(wave_sum(ss) * (1.f / D) + 1e-6f); \
            _Pragma("unroll") for (int j = 0; j < 8; ++j) { const f32x4 gv = *(const LAS f32x4*)(lg + (j * 64 + lane) * 4); dst[j] = dst[j] * gv * inv; } } } while (0)
    for (int run = gw; run < T / 4; run += nw) {
        const int t0 = run * 4;
        f32x4 pv[8], cu[8], nx[8];
        CM_ROW(pv, t0 - 1, false);
        CM_ROW(cu, t0, true);
#pragma unroll 1
        for (int i = 0; i < 4; ++i) {
            const int t = t0 + i;
            CM_ROW(nx, t + 1, i < 3);
            unsigned mo = 8192u; asm volatile("" : "+s"(mo));
            const LAS float* mx = (const LAS float*)(lds + mo);
#pragma unroll
            for (int j = 0; j < 8; ++j) {
                const int d0 = (j * 64 + lane) * 4;
                const f32x4 xx = (pv[j] + nx[j]) * 0.5f - cu[j];
#pragma unroll
                for (int m = 0; m < 6; ++m) {
                    const f32x4 mv = *(const LAS f32x4*)(mx + m * D + d0);
                    const f32x4 o = cu[j] + xx * mv;
                    u32x2 ov; ov.x = pk2(o[0], o[1]); ov.y = pk2(o[2], o[3]);
                    const int slot = m == 1 ? 3 : (m == 2 ? 1 : (m == 3 ? 2 : m));
                    *(u32x2*)(mixo + ((size_t)slot * T + t) * D + d0) = ov;
                }
                pv[j] = cu[j]; cu[j] = nx[j];
            }
        }
    }
#undef CM_ROW
}
__device__ __forceinline__ void ph_rwkv_proj(CPar& p, LAS char* lds) {
    const int tid = otid();
    pg8::Gemm g{(const bf16_t*)(p.ws + WS_MIX), (const bf16_t*)(p.ws + WS_WR), 6 * T, 35 * 256, D};
    pg8::RwkvOrder S{(int)gridDim.x, (int)blockIdx.x};
    pg8::PEpiRwkv E{(bf16_t*)(p.ws + WS_R), (bf16_t*)(p.ws + WS_LW), (bf16_t*)(p.ws + WS_LA), (bf16_t*)(p.ws + WS_GL)};
    pg8::gemm_phase<pg8::PEpiRwkv, pg8::RwkvOrder, true, true>(tid, (LAS unsigned char*)lds, g, S, E);
}
__device__ __forceinline__ unsigned toff(int row, int col) { return (unsigned)(row * 128 + ((((col >> 3) ^ (row >> 1)) & 7) << 4) + (col & 7) * 2); }
constexpr unsigned T_AQ = 0, T_RQ = 8192, T_BK = 16384, T_KK = 24576, T_V = 32768, T_L = 40960, T_DL = 49152  ,
                   T_TII = 53248  , T_MAK = 55296, T_MRB = 63488, T_MRK = 71680, T_ZS = 79872,
                   T_W0A = T_AQ, T_W0B = T_MAK,
                   T_LIN = 40960, T_AS = 57344;
__device__ __forceinline__ f32x4 tile_mm(LAS char* lds, unsigned abase, unsigned bbase, int mblk, int nblk, int l15, int g, f32x4 acc, int nks) {
    for (int ks = 0; ks < nks; ++ks) {
        const bf16x8 a = *(const LAS bf16x8*)(lds + abase + toff(mblk * 16 + l15, ks * 32 + 8 * g));
        const bf16x8 b = *(const LAS bf16x8*)(lds + bbase + toff(nblk * 16 + l15, ks * 32 + 8 * g));
        acc = __builtin_amdgcn_mfma_f32_16x16x32_bf16(a, b, acc, 0, 0, 0);
    }
    return acc;
}
__device__ __forceinline__ void tile_st(LAS char* lds, unsigned base, int n, int m0, f32x4 v) {
    u32x2 o; o.x = pk2(v[0], v[1]); o.y = pk2(v[2], v[3]);
    *(LAS u32x2*)(lds + base + toff(n, m0)) = o;
}

typedef short v4i16_t __attribute__((ext_vector_type(4)));
__device__ __forceinline__ bf16x8 frag_row(LAS char* lds, unsigned base, int blk, int ks, int l15, int g) {
    return *(const LAS bf16x8*)(lds + base + toff(blk * 16 + l15, ks * 32 + 8 * g));
}
__device__ __forceinline__ bf16x8 frag_tr(LAS char* lds, unsigned base, int blk, int ks, int l15, int g) {
    const int q = l15 >> 2, pp = l15 & 3;
    const v4i16_t v0 = __builtin_amdgcn_ds_read_tr16_b64_v4i16((LAS v4i16_t*)(lds + base + toff(ks * 32 + 8 * g + q, blk * 16 + 4 * pp)));
    const v4i16_t v1 = __builtin_amdgcn_ds_read_tr16_b64_v4i16((LAS v4i16_t*)(lds + base + toff(ks * 32 + 8 * g + 4 + q, blk * 16 + 4 * pp)));
    return (bf16x8){v0[0], v0[1], v0[2], v0[3], v1[0], v1[1], v1[2], v1[3]};
}
template <bool ATR, bool BTR>
__device__ __forceinline__ f32x4 tile_mm2(LAS char* lds, unsigned abase, unsigned bbase, int mblk, int nblk, int l15, int g, f32x4 acc, int nks) {
    for (int ks = 0; ks < nks; ++ks) {
        const bf16x8 a = ATR ? frag_tr(lds, abase, mblk, ks, l15, g) : frag_row(lds, abase, mblk, ks, l15, g);
        const bf16x8 b = BTR ? frag_tr(lds, bbase, nblk, ks, l15, g) : frag_row(lds, bbase, nblk, ks, l15, g);
        acc = __builtin_amdgcn_mfma_f32_16x16x32_bf16(a, b, acc, 0, 0, 0);
    }
    return acc;
}

__device__ __forceinline__ void ph_gate(CPar& p, LAS char* lds) {
    const int tid = otid();
    pg8::Gemm g{(const bf16_t*)(p.ws + WS_GL), (const bf16_t*)(p.ws + WS_G2T), T, D, 256}; pg8::StaticOrder S; S.init(T, D, (int)gridDim.x, (int)blockIdx.x);
    pg8::PEpiPlain E{(bf16_t*)(p.ws + WS_G)};
    pg8::gemm_phase<pg8::PEpiPlain, pg8::StaticOrder, true, true>(tid, (LAS unsigned char*)lds, g, S, E);
    __syncthreads();
}
__device__ __forceinline__ void ph_scan_prep(CPar& p, LAS char* lds) {
    const int tid0 = otid(), wv = tid0 >> 6;
    const bf16_t* R = (const bf16_t*)(p.ws + WS_R); const bf16_t* K2 = (const bf16_t*)(p.ws + WS_K2); const bf16_t* V2 = (const bf16_t*)(p.ws + WS_V2);
    const float* k_k = p.in[22]; const float* k_a = p.in[23]; const float* r_k = p.in[24];
    for (int u = blockIdx.x; u < NH * 128; u += gridDim.x) {
        int tid = tid0; asm volatile("" : "+v"(tid));
        const int lane = tid & 63, l15 = lane & 15, g = lane >> 4;
        const int h = u & 31, m = u >> 5;
        {
            const int z = wv >> 2, nblk = wv & 3;
            LAS char* ldz = lds + z * T_ZS;
            LAS float* LIN = (LAS float*)(ldz + T_LIN); LAS float* AS = (LAS float*)(ldz + T_AS); LAS float* lendp = (LAS float*)(lds + LDS_SEG) + z * 64;
            bf16x8 afr[2][4][3], bfr[2][3];
            float bias[2];
#pragma unroll
            for (int isa = 0; isa < 2; ++isa) {
                const bf16_t* lsrc = (const bf16_t*)(p.ws + (isa ? WS_LA : WS_LW)) + (size_t)z * 512 * 4 * 64 * 8;
                const bf16_t* wsrc = (const bf16_t*)(p.ws + (isa ? WS_A2T : WS_W2T)) + (size_t)z * D * 128 + ((size_t)(h * 4 + nblk) * 4 * 64 + g * 16 + l15) * 8;
                bias[isa] = (isa ? p.in[17] : p.in[14])[z * D + h * HD + nblk * 16 + l15];
#pragma unroll
                for (int ks = 0; ks < 3; ++ks) bfr[isa][ks] = *(const bf16x8*)(wsrc + ks * 512);
#pragma unroll
                for (int mblk = 0; mblk < 4; ++mblk) {
                    const int tb = m * 4 + (z ? 3 - mblk : mblk), r15 = z ? 15 - l15 : l15;
#pragma unroll
                    for (int ks = 0; ks < 3; ++ks) afr[isa][mblk][ks] = *(const bf16x8*)(lsrc + (((size_t)tb * 4 + ks) * 64 + g * 16 + r15) * 8);
                }
            }
            float carry = 0.f;
#pragma unroll
            for (int mblk = 0; mblk < 4; ++mblk) {
                f32x4 accw = {0.f, 0.f, 0.f, 0.f}, acca = {0.f, 0.f, 0.f, 0.f};
#pragma unroll
                for (int ks = 0; ks < 3; ++ks) { accw = __builtin_amdgcn_mfma_f32_16x16x32_bf16(afr[0][mblk][ks], bfr[0][ks], accw, 0, 0, 0); acca = __builtin_amdgcn_mfma_f32_16x16x32_bf16(afr[1][mblk][ks], bfr[1][ks], acca, 0, 0, 0); }
                float o[4], oa[4];
#pragma unroll
                for (int e = 0; e < 4; ++e) {
                    oa[e] = sigmoidf_(acca[e] + bias[1]);
                    o[e] = -0.60653066f * sigmoidf_(accw[e] + bias[0]);
                }
                o[1] += o[0]; o[2] += o[1]; o[3] += o[2];
                const float tot = o[3];
                const float u1 = __shfl_up(tot, 16); const float s2 = tot + (g >= 1 ? u1 : 0.f);
                const float u2 = __shfl_up(s2, 32); const float incl = s2 + (g >= 2 ? u2 : 0.f);
                const float tt = __shfl(incl, 48 + l15);
                const float base = carry + incl - tot;
                carry += tt;
#pragma unroll
                for (int e = 0; e < 4; ++e) { LIN[(mblk * 16 + 4 * g + e) * 64 + nblk * 16 + l15] = o[e] + base; AS[(mblk * 16 + 4 * g + e) * 64 + nblk * 16 + l15] = oa[e]; }
            }
            if (g == 0) lendp[nblk * 16 + l15] = carry;
        }
        __syncthreads();
        {
            const int tau = tid >> 3, cg = tid & 7, c0 = h * HD + cg * 8;
            const int t = m * 64 + tau; const size_t o = (size_t)t * D + c0;
            const u32x4 kw = *(const u32x4*)(K2 + o), rw = *(const u32x4*)(R + o), vw = *(const u32x4*)(V2 + o);
            float kx[8], rx[8], kk[8], kac[8], rkc[8];
            float n2 = 0.f;
#pragma unroll
            for (int q4 = 0; q4 < 2; ++q4) {
                const f32x4 k4 = *(const f32x4*)(k_k + c0 + q4 * 4), ka4 = *(const f32x4*)(k_a + c0 + q4 * 4), rk4 = *(const f32x4*)(r_k + c0 + q4 * 4);
#pragma unroll
                for (int e = 0; e < 4; ++e) {
                    const int j = q4 * 4 + e; const unsigned kwj = kw[j >> 1], rwj = rw[j >> 1];
                    kx[j] = (j & 1) ? bfhi(kwj) : bflo(kwj); rx[j] = (j & 1) ? bfhi(rwj) : bflo(rwj);
                    kk[j] = kx[j] * k4[e]; n2 += kk[j] * kk[j]; kac[j] = ka4[e]; rkc[j] = rk4[e];
                }
            }
            n2 += __shfl_xor(n2, 1); n2 += __shfl_xor(n2, 2); n2 += __shfl_xor(n2, 4);
            const float rn = __builtin_amdgcn_rcpf(fmaxf(sqrtf(n2), 1e-12f));
#pragma unroll
            for (int j = 0; j < 8; ++j) kk[j] *= rn;
#pragma unroll
            for (int z = 0; z < 2; ++z) {
                LAS char* ldz = lds + z * T_ZS;
                LAS float* LIN = (LAS float*)(ldz + T_LIN); LAS float* AS = (LAS float*)(ldz + T_AS); LAS float* lendp = (LAS float*)(lds + LDS_SEG) + z * 64;
                LAS float* elend = (LAS float*)(lds + LDS_ELEND) + z * 64;
                float* sbon = (float*)(p.ws + WS_SBON) + (size_t)z * T * NH;
                const int sidx = z ? 63 - tau : tau;
                float lin[8], lex[8], av[8];
#pragma unroll
                for (int q4 = 0; q4 < 2; ++q4) {
                    const f32x4 a4 = *(const LAS f32x4*)(AS + sidx * 64 + cg * 8 + q4 * 4), l4 = *(const LAS f32x4*)(LIN + sidx * 64 + cg * 8 + q4 * 4);
                    f32x4 p4 = {0.f, 0.f, 0.f, 0.f};
                    if (sidx > 0) p4 = *(const LAS f32x4*)(LIN + (sidx - 1) * 64 + cg * 8 + q4 * 4);
#pragma unroll
                    for (int e = 0; e < 4; ++e) { av[q4 * 4 + e] = a4[e]; lin[q4 * 4 + e] = l4[e]; lex[q4 * 4 + e] = p4[e]; }
                }
                float kd[8], sb = 0.f;
#pragma unroll
                for (int j = 0; j < 8; ++j) { kd[j] = kx[j] * (1.f + (av[j] - 1.f) * kac[j]); sb += rx[j] * kd[j] * rkc[j]; }
                sb += __shfl_xor(sb, 1); sb += __shfl_xor(sb, 2); sb += __shfl_xor(sb, 4);
                if (cg == 0) sbon[(size_t)t * NH + h] = sb;
                float aq[8], rq[8], bk[8], kq[8];
#pragma unroll
                for (int j = 0; j < 8; ++j) {
                    const float b = kk[j] * av[j];
                    const float elin = __expf(lin[j]), elex = __expf(lex[j]), enl = __expf(-lin[j]);
                    aq[j] = -kk[j] * elex; bk[j] = b * enl; kq[j] = kd[j] * enl; rq[j] = rx[j] * elin;
                }
                const unsigned wo = toff(sidx, cg * 8);
                *(LAS u32x4*)(ldz + T_AQ + wo) = (u32x4){pk2(aq[0], aq[1]), pk2(aq[2], aq[3]), pk2(aq[4], aq[5]), pk2(aq[6], aq[7])};
                *(LAS u32x4*)(ldz + T_RQ + wo) = (u32x4){pk2(rq[0], rq[1]), pk2(rq[2], rq[3]), pk2(rq[4], rq[5]), pk2(rq[6], rq[7])};
                *(LAS u32x4*)(ldz + T_BK + wo) = (u32x4){pk2(bk[0], bk[1]), pk2(bk[2], bk[3]), pk2(bk[4], bk[5]), pk2(bk[6], bk[7])};
                *(LAS u32x4*)(ldz + T_KK + wo) = (u32x4){pk2(kq[0], kq[1]), pk2(kq[2], kq[3]), pk2(kq[4], kq[5]), pk2(kq[6], kq[7])};
                *(LAS u32x4*)(ldz + T_V + wo) = vw;
                if (tau == 0) {
#pragma unroll
                    for (int q4 = 0; q4 < 2; ++q4) { const f32x4 e4 = *(const LAS f32x4*)(lendp + cg * 8 + q4 * 4);
#pragma unroll
                        for (int e = 0; e < 4; ++e) elend[cg * 8 + q4 * 4 + e] = __expf(e4[e]); }
                }
            }
        }
        __syncthreads();
#pragma unroll
        for (int z = 0; z < 2; ++z) {
            LAS char* ldz = lds + z * T_ZS;
            const int nblk = wv & 3;
#pragma unroll
            for (int pid = 0; pid < 4; ++pid) {
                const unsigned ab = (pid & 1) ? T_KK : T_BK, bb = pid < 2 ? T_AQ : T_RQ;
                const unsigned db = pid == 0 ? T_L : (pid == 1 ? T_MAK : (pid == 2 ? T_MRB : T_MRK));
#pragma unroll
                for (int i = 0; i < 2; ++i) {
                    const int mblk = (wv >> 2) * 2 + i;
                    f32x4 acc = {0.f, 0.f, 0.f, 0.f};
                    if (mblk <= nblk) {
                        acc = tile_mm(ldz, ab, bb, mblk, nblk, l15, g, acc, 2);
                        const int n = nblk * 16 + l15, m0 = mblk * 16 + 4 * g;
#pragma unroll
                        for (int e = 0; e < 4; ++e) { const bool keep = pid < 2 ? (m0 + e < n) : (m0 + e <= n); acc[e] = keep ? acc[e] : 0.f; }
                        if (pid == 0 && mblk == nblk) *(LAS f32x4*)(ldz + T_DL + ((nblk * 16 + l15) * 16 + 4 * g) * 4) = acc;
                    }
                    tile_st(ldz, db, nblk * 16 + l15, mblk * 16 + 4 * g, acc);
                }
            }
        }
        __syncthreads();
        f32x4 xacc[2][4];
        const int wcol = (wv & 3) * 16 + l15;
#pragma unroll
        for (int z = 0; z < 2; ++z) {
            LAS char* ldz = lds + z * T_ZS;
            if (wv >= 4) {
#pragma unroll
                for (int sb = 0; sb < 4; ++sb) {
                    f32x4 acc = {0.f, 0.f, 0.f, 0.f};
                    xacc[z][sb] = tile_mm2<false, true>(ldz, T_MAK, T_V, sb, wv - 4, l15, g, acc, sb < 2 ? 1 : 2);
                }
            } else {
#pragma unroll
                for (int sb = 0; sb < 4; ++sb) {
                    const v4i16_t w = __builtin_amdgcn_ds_read_tr16_b64_v4i16((LAS v4i16_t*)(ldz + T_AQ + toff(sb * 16 + 4 * g + (l15 >> 2), (wv & 3) * 16 + 4 * (l15 & 3))));
                    xacc[z][sb] = (f32x4){bf2f((bf16_t)w[0]), bf2f((bf16_t)w[1]), bf2f((bf16_t)w[2]), bf2f((bf16_t)w[3])};
                }
            }
        }
        if (wv < 2) {
            LAS char* ldz = lds + wv * T_ZS;
            float tc[16];
#pragma unroll
            for (int r = 0; r < 16; ++r) {
                float v = (r == l15) ? 1.f : 0.f;
#pragma unroll
                for (int q4 = 0; q4 < (r + 3) / 4; ++q4) {
                    const f32x4 lr = *(const LAS f32x4*)(ldz + T_DL + ((g * 16 + r) * 16 + q4 * 4) * 4);
#pragma unroll
                    for (int e = 0; e < 4; ++e) if (q4 * 4 + e < r) v += lr[e] * tc[q4 * 4 + e];
                }
                tc[r] = v;
                *(LAS bf16_t*)(ldz + T_TII + ((g * 16 + r) * 16 + l15) * 2) = (bf16_t)f2bf(v);
            }
        }
        __syncthreads();
#pragma unroll
        for (int z = 0; z < 2; ++z) {
            LAS char* ldz = lds + z * T_ZS;
            const unsigned wbase = (wv < 4 ? T_W0A : T_W0B);
            unsigned wp[4][2];
#pragma unroll
            for (int i = 0; i < 4; ++i) {
                f32x4 r = xacc[z][i];
                if (i >= 1) {
                    const u32x2 l0 = *(const LAS u32x2*)(ldz + T_L + toff(i * 16 + l15, 4 * g));
                    u32x2 l1 = {0u, 0u};
                    if (i >= 2) l1 = *(const LAS u32x2*)(ldz + T_L + toff(i * 16 + l15, 16 + 4 * g));
                    const u32x4 aw = {l0.x, l0.y, l1.x, l1.y};
                    const u32x4 bw = {wp[0][0], wp[0][1], i >= 2 ? wp[1][0] : 0u, i >= 2 ? wp[1][1] : 0u};
                    r = __builtin_amdgcn_mfma_f32_16x16x32_bf16(__builtin_bit_cast(bf16x8, aw), __builtin_bit_cast(bf16x8, bw), r, 0, 0, 0);
                }
                if (i == 3) {
                    const u32x2 l2 = *(const LAS u32x2*)(ldz + T_L + toff(48 + l15, 32 + 4 * g));
                    const u32x4 aw = {l2.x, l2.y, 0u, 0u};
                    const u32x4 bw = {wp[2][0], wp[2][1], 0u, 0u};
                    r = __builtin_amdgcn_mfma_f32_16x16x32_bf16(__builtin_bit_cast(bf16x8, aw), __builtin_bit_cast(bf16x8, bw), r, 0, 0, 0);
                }
                const u32x2 tw = *(const LAS u32x2*)(ldz + T_TII + ((i * 16 + l15) * 16 + 4 * g) * 2);
                const u32x4 aw = {tw.x, tw.y, 0u, 0u};
                const u32x4 bw = {pk2(r[0], r[1]), pk2(r[2], r[3]), 0u, 0u};
                f32x4 w = {0.f, 0.f, 0.f, 0.f};
                w = __builtin_amdgcn_mfma_f32_16x16x32_bf16(__builtin_bit_cast(bf16x8, aw), __builtin_bit_cast(bf16x8, bw), w, 0, 0, 0);
                wp[i][0] = pk2(w[0], w[1]); wp[i][1] = pk2(w[2], w[3]);
                *(LAS u32x2*)(ldz + wbase + toff(wcol, i * 16 + 4 * g)) = (u32x2){wp[i][0], wp[i][1]};
            }
        }
        __syncthreads();
#pragma unroll
        for (int z = 0; z < 2; ++z) {
            LAS char* ldz = lds + z * T_ZS;
            LAS float* elend = (LAS float*)(lds + LDS_ELEND) + z * 64;
            const int cc = z ? 127 - m : m;
            const size_t uc = ((size_t)(z * NH + h) * 128 + cc) * 4096, um = ((size_t)(z * NH + h) * 128 + m) * 4096;
            bf16_t* GB = (bf16_t*)(p.ws + WS_GB) + uc; bf16_t* FB = (bf16_t*)(p.ws + WS_FB) + uc;
            bf16_t* GYB = (bf16_t*)(p.ws + WS_GYB) + um; bf16_t* FYB = (bf16_t*)(p.ws + WS_FYB) + um;
#pragma unroll
            for (int i = 0; i < 2; ++i) {
                const int tile = wv * 2 + i, mblk = tile >> 2, nblk = tile & 3;
                const int n = nblk * 16 + l15, m0 = mblk * 16 + 4 * g;
                {
                    f32x4 acc = {0.f, 0.f, 0.f, 0.f};
                    acc = tile_mm2<false, true>(ldz, T_W0A, T_BK, mblk, nblk, l15, g, acc, 2);
                    const float el = elend[n];
#pragma unroll
                    for (int e = 0; e < 4; ++e) acc[e] = (acc[e] + (m0 + e == n ? 1.f : 0.f)) * el;
                    u32x2 o; o.x = pk2(acc[0], acc[1]); o.y = pk2(acc[2], acc[3]);
                    *(u32x2*)(GB + ((nblk * 4 + mblk) * 64 + lane) * 4) = o;
                }
                {
                    f32x4 acc = {0.f, 0.f, 0.f, 0.f};
                    acc = tile_mm2<true, false>(ldz, T_BK, T_W0B, mblk, nblk, l15, g, acc, 2);
                    acc = tile_mm2<true, true>(ldz, T_KK, T_V, mblk, nblk, l15, g, acc, 2);
                    const f32x4 el4 = *(const LAS f32x4*)(elend + m0);
                    u32x2 o; o.x = pk2(acc[0] * el4[0], acc[1] * el4[1]); o.y = pk2(acc[2] * el4[2], acc[3] * el4[3]);
                    *(u32x2*)(FB + ((nblk * 4 + mblk) * 64 + lane) * 4) = o;
                }
                {
                    f32x4 acc = {0.f, 0.f, 0.f, 0.f};
                    acc = tile_mm(ldz, T_W0A, T_MRB, mblk, nblk, l15, g, acc, 2);
                    const u32x2 rq = *(const LAS u32x2*)(ldz + T_RQ + toff(n, m0));
                    acc[0] += bflo(rq.x); acc[1] += bfhi(rq.x); acc[2] += bflo(rq.y); acc[3] += bfhi(rq.y);
                    u32x2 o; o.x = pk2(acc[0], acc[1]); o.y = pk2(acc[2], acc[3]);
                    *(u32x2*)(GYB + (z ? (((3 - nblk) * 4 + mblk) * 64 + g * 16 + 15 - l15) : ((nblk * 4 + mblk) * 64 + lane)) * 4) = o;
                }
                {
                    f32x4 acc = {0.f, 0.f, 0.f, 0.f};
                    acc = tile_mm(ldz, T_MRB, T_W0B, mblk, nblk, l15, g, acc, 2);
                    acc = tile_mm2<false, true>(ldz, T_MRK, T_V, mblk, nblk, l15, g, acc, 2);
                    u32x2 o;
                    if (z) { o.x = pk2(acc[3], acc[2]); o.y = pk2(acc[1], acc[0]); *(u32x2*)(FYB + ((nblk * 4 + (3 - mblk)) * 64 + (3 - g) * 16 + l15) * 4) = o; }
                    else { o.x = pk2(acc[0], acc[1]); o.y = pk2(acc[2], acc[3]); *(u32x2*)(FYB + ((nblk * 4 + mblk) * 64 + lane) * 4) = o; }
                }
            }
        }
        lds_barrier();
    }
}

__device__ __forceinline__ void ph_scan_state(CPar& p) {
    const int tid = otid(), lane = tid & 63, wv = tid >> 6, l15 = lane & 15, g = lane >> 4;
    if (wv != 0) return;
    for (int u = blockIdx.x; u < 256; u += gridDim.x) {
        const int zh = u >> 2, vq = u & 3;
        const bf16_t* GB = (const bf16_t*)(p.ws + WS_GB) + (size_t)zh * 128 * 4096;
        const bf16_t* FB = (const bf16_t*)(p.ws + WS_FB) + (size_t)zh * 128 * 4096;
        bf16_t* HS = (bf16_t*)(p.ws + WS_HS) + (size_t)zh * 128 * 4096;
        f32x4 acc[4];
#pragma unroll
        for (int mt = 0; mt < 4; ++mt) acc[mt] = (f32x4){0.f, 0.f, 0.f, 0.f};
        u32x2 gq[4][2][2], fq[4], gq2[4][2][2], fq2[4], gq3[4][2][2], fq3[4], gq4[4][2][2], fq4[4];
#define SCAN_LOAD(G_, F_, cidx) do { const bf16_t* gp = GB + (size_t)(cidx) * 4096; const bf16_t* fp = FB + (size_t)(cidx) * 4096; \
            _Pragma("unroll") for (int mt = 0; mt < 4; ++mt) { \
                _Pragma("unroll") for (int ks = 0; ks < 2; ++ks) { G_[mt][ks][0] = *(const u32x2*)(gp + ((mt * 4 + 2 * ks) * 64 + lane) * 4); G_[mt][ks][1] = *(const u32x2*)(gp + ((mt * 4 + 2 * ks + 1) * 64 + lane) * 4); } \
                F_[mt] = *(const u32x2*)(fp + ((vq * 4 + mt) * 64 + lane) * 4); } } while (0)
#define SCAN_STEP(G_, F_, cidx) do { \
            bf16_t* hp = HS + (size_t)(cidx) * 4096 + (vq * 4 * 64 + lane) * 4; \
            u32x2 hb[4]; \
            _Pragma("unroll") for (int mt = 0; mt < 4; ++mt) { hb[mt].x = pk2(acc[mt][0], acc[mt][1]); hb[mt].y = pk2(acc[mt][2], acc[mt][3]); *(u32x2*)(hp + mt * 256) = hb[mt]; } \
            bf16x8 bfr[2]; \
            _Pragma("unroll") for (int ks = 0; ks < 2; ++ks) { u32x4 w = {hb[2 * ks].x, hb[2 * ks].y, hb[2 * ks + 1].x, hb[2 * ks + 1].y}; bfr[ks] = __builtin_bit_cast(bf16x8, w); } \
            _Pragma("unroll") for (int mt = 0; mt < 4; ++mt) { \
                f32x4 a = {bflo(F_[mt].x), bfhi(F_[mt].x), bflo(F_[mt].y), bfhi(F_[mt].y)}; \
                _Pragma("unroll") for (int ks = 0; ks < 2; ++ks) { \
                    u32x4 w = {G_[mt][ks][0].x, G_[mt][ks][0].y, G_[mt][ks][1].x, G_[mt][ks][1].y}; \
                    a = __builtin_amdgcn_mfma_f32_16x16x32_bf16(__builtin_bit_cast(bf16x8, w), bfr[ks], a, 0, 0, 0); } \
                acc[mt] = a; } } while (0)
        SCAN_LOAD(gq, fq, 0); SCAN_LOAD(gq2, fq2, 1); SCAN_LOAD(gq3, fq3, 2); SCAN_LOAD(gq4, fq4, 3);
#pragma unroll 4
        for (int c = 0; c < 128; c += 4) {
            SCAN_STEP(gq, fq, c);
            if (c + 4 < 128) SCAN_LOAD(gq, fq, c + 4);
            SCAN_STEP(gq2, fq2, c + 1);
            if (c + 4 < 128) SCAN_LOAD(gq2, fq2, c + 5);
            SCAN_STEP(gq3, fq3, c + 2);
            if (c + 4 < 128) SCAN_LOAD(gq3, fq3, c + 6);
            SCAN_STEP(gq4, fq4, c + 3);
            if (c + 4 < 128) SCAN_LOAD(gq4, fq4, c + 7);
        }
#undef SCAN_STEP
#undef SCAN_LOAD
    }
}

__device__ __forceinline__ void ph_scan_out(CPar& p, LAS char* lds) {
    const int tid = otid(), lane = tid & 63, wv = tid >> 6, l15 = lane & 15, g = lane >> 4;
    const bf16_t* V2 = (const bf16_t*)(p.ws + WS_V2); const bf16_t* G = (const bf16_t*)(p.ws + WS_G); bf16_t* Z = (bf16_t*)(p.ws + WS_Z);
    const float* sbon = (const float*)(p.ws + WS_SBON); const float* lw = p.in[25]; const float* lb = p.in[26];
    const int vb = wv & 3, tk = tid >> 3, cg = tid & 7;
    const int NU = NH * 128, GS = gridDim.x;
    u32x2 Af[2][2], Aa[2][2][2][2], Ab[2][2][2][2];
    struct BSet { u32x4 vw, gw; f32x4 w0, w1, b0, b1; float s0, s1; };
    BSet B0, B1;
#define OUT_LOADA(u_) do { const int h_ = (u_) & 31, m_ = (u_) >> 5; \
        _Pragma("unroll") for (int i = 0; i < 2; ++i) { const int sb = (wv >> 2) * 2 + i; \
            _Pragma("unroll") for (int z = 0; z < 2; ++z) { const int cc = z ? 127 - m_ : m_; \
                const bf16_t* gy = (const bf16_t*)(p.ws + WS_GYB) + ((size_t)(z * NH + h_) * 128 + m_) * 4096; \
                const bf16_t* fy = (const bf16_t*)(p.ws + WS_FYB) + ((size_t)(z * NH + h_) * 128 + m_) * 4096; \
                const bf16_t* hs = (const bf16_t*)(p.ws + WS_HS) + ((size_t)(z * NH + h_) * 128 + cc) * 4096; \
                Af[i][z] = *(const u32x2*)(fy + ((vb * 4 + sb) * 64 + lane) * 4); \
                _Pragma("unroll") for (int ks = 0; ks < 2; ++ks) { \
                    const bf16_t* gyp = gy + ((sb * 4 + 2 * ks + (g >> 1)) * 64 + (2 * (g & 1)) * 16 + l15) * 4;        \
                    Aa[i][z][ks][0] = *(const u32x2*)gyp; Aa[i][z][ks][1] = *(const u32x2*)(gyp + 64); \
                    const bf16_t* hsp = hs + ((vb * 4 + 2 * ks + (g >> 1)) * 64 + (2 * (g & 1)) * 16 + l15) * 4; \
                    Ab[i][z][ks][0] = *(const u32x2*)hsp; Ab[i][z][ks][1] = *(const u32x2*)(hsp + 64); } } } } while (0)
#define OUT_LOADB(S_, u_) do { const int h_ = (u_) & 31, m_ = (u_) >> 5, t_ = m_ * 64 + tk, c0_ = h_ * HD + cg * 8; const size_t o_ = (size_t)t_ * D + c0_; \
        S_.vw = *(const u32x4*)(V2 + o_); S_.gw = *(const u32x4*)(G + o_); \
        S_.s0 = sbon[(size_t)t_ * NH + h_]; S_.s1 = sbon[(size_t)T * NH + (size_t)t_ * NH + h_]; \
        S_.w0 = *(const f32x4*)(lw + c0_); S_.w1 = *(const f32x4*)(lw + c0_ + 4); S_.b0 = *(const f32x4*)(lb + c0_); S_.b1 = *(const f32x4*)(lb + c0_ + 4); } while (0)
#define OUT_MMA(yt_) do { \
        _Pragma("unroll") for (int i = 0; i < 2; ++i) { const int sb = (wv >> 2) * 2 + i; \
            f32x4 acc = {0.f, 0.f, 0.f, 0.f}; \
            _Pragma("unroll") for (int z = 0; z < 2; ++z) { \
                const u32x2 f = Af[i][z]; \
                acc[0] += bflo(f.x); acc[1] += bfhi(f.x); acc[2] += bflo(f.y); acc[3] += bfhi(f.y); \
                _Pragma("unroll") for (int ks = 0; ks < 2; ++ks) { \
                    const bf16x8 a = __builtin_bit_cast(bf16x8, (u32x4){Aa[i][z][ks][0].x, Aa[i][z][ks][0].y, Aa[i][z][ks][1].x, Aa[i][z][ks][1].y}); \
                    const bf16x8 bq = __builtin_bit_cast(bf16x8, (u32x4){Ab[i][z][ks][0].x, Ab[i][z][ks][0].y, Ab[i][z][ks][1].x, Ab[i][z][ks][1].y}); \
                    acc = __builtin_amdgcn_mfma_f32_16x16x32_bf16(a, bq, acc, 0, 0, 0); } } \
            _Pragma("unroll") for (int e = 0; e < 4; ++e) yt_[(sb * 16 + 4 * g + e) * 64 + vb * 16 + l15] = acc[e]; } } while (0)
#define OUT_NORM(S_, u_, yt_) do { const int h_ = (u_) & 31, m_ = (u_) >> 5, t_ = m_ * 64 + tk, c0_ = h_ * HD + cg * 8; const size_t o_ = (size_t)t_ * D + c0_; \
        const float sbv = S_.s0 + S_.s1; \
        const f32x4 y0 = *(const LAS f32x4*)(yt_ + tk * 64 + cg * 8), y1 = *(const LAS f32x4*)(yt_ + tk * 64 + cg * 8 + 4); \
        float sum = y0[0] + y0[1] + y0[2] + y0[3] + y1[0] + y1[1] + y1[2] + y1[3]; \
        sum += __shfl_xor(sum, 1); sum += __shfl_xor(sum, 2); sum += __shfl_xor(sum, 4); \
        const float mu = sum * (1.f / 64.f); \
        float yv[8], wv8[8], bv8[8], gv[8], vv[8]; \
        _Pragma("unroll") for (int e = 0; e < 4; ++e) { yv[e] = y0[e] - mu; yv[4 + e] = y1[e] - mu; wv8[e] = S_.w0[e]; wv8[4 + e] = S_.w1[e]; bv8[e] = S_.b0[e]; bv8[4 + e] = S_.b1[e]; } \
        _Pragma("unroll") for (int j = 0; j < 8; ++j) gv[j] = (j & 1) ? bfhi(S_.gw[j >> 1]) : bflo(S_.gw[j >> 1]); \
        _Pragma("unroll") for (int j = 0; j < 8; ++j) vv[j] = (j & 1) ? bfhi(S_.vw[j >> 1]) : bflo(S_.vw[j >> 1]); \
        float sq = 0.f; \
        _Pragma("unroll") for (int j = 0; j < 8; ++j) sq += yv[j] * yv[j]; \
        sq += __shfl_xor(sq, 1); sq += __shfl_xor(sq, 2); sq += __shfl_xor(sq, 4); \
        const float rs = rsqrtf(sq * (1.f / 64.f) + 64e-5f); \
        float ov[8]; \
        _Pragma("unroll") for (int j = 0; j < 8; ++j) ov[j] = (yv[j] * rs * wv8[j] + bv8[j] + sbv * vv[j]) * gv[j]; \
        u32x4 pw; pw.x = pk2(ov[0], ov[1]); pw.y = pk2(ov[2], ov[3]); pw.z = pk2(ov[4], ov[5]); pw.w = pk2(ov[6], ov[7]); \
        *(u32x4*)(Z + o_) = pw; } while (0)
    LAS float* yt0 = (LAS float*)lds; LAS float* yt1 = yt0 + 4096;
    int u = blockIdx.x;
    if (u < NU) { OUT_LOADA(u); OUT_LOADB(B0, u); }
    for (; u < NU; u += 2 * GS) {
        OUT_MMA(yt0);
        const int u1 = u + GS;
        if (u1 < NU) { OUT_LOADA(u1); OUT_LOADB(B1, u1); }
        lds_barrier();
        OUT_NORM(B0, u, yt0);
        if (u1 >= NU) break;
        OUT_MMA(yt1);
        const int u2 = u1 + GS;
        if (u2 < NU) { OUT_LOADA(u2); OUT_LOADB(B0, u2); }
        lds_barrier();
        OUT_NORM(B1, u1, yt1);
    }
#undef OUT_LOADA
#undef OUT_LOADB
#undef OUT_MMA
#undef OUT_NORM
}

__device__ __forceinline__ void ph_final(CPar& p, LAS char* lds) {
    const int tid = otid(), lane = tid & 63, gw = blockIdx.x * 8 + (tid >> 6), nw = gridDim.x * 8;
    float* h3 = p.out; const bf16_t* y = (const bf16_t*)(p.ws + WS_Y); const float* g = p.in[3];
    LAS float* lg = (LAS float*)lds;
    for (int i = tid; i < D / 4; i += NTHR) *(LAS f32x4*)(lg + i * 4) = *(const f32x4*)(g + i * 4);
    __syncthreads();
    for (int t = gw; t < T; t += nw) {
        f32x4 x[8]; float ss = 0.f;
#pragma unroll
        for (int j = 0; j < 8; ++j) {
            const int d0 = (j * 64 + lane) * 4;
            x[j] = *(const f32x4*)(h3 + (size_t)t * D + d0);
            const u32x2 a = *(const u32x2*)(y + (size_t)(2 * t) * D + d0), b = *(const u32x2*)(y + (size_t)(2 * t + 1) * D + d0);
            x[j][0] += bflo(a.x) + bflo(b.x); x[j][1] += bfhi(a.x) + bfhi(b.x); x[j][2] += bflo(a.y) + bflo(b.y); x[j][3] += bfhi(a.y) + bfhi(b.y);
            ss += x[j][0] * x[j][0] + x[j][1] * x[j][1] + x[j][2] * x[j][2] + x[j][3] * x[j][3];
        }
        ss = wave_sum(ss);
        const float inv = rsqrtf(ss * (1.f / D) + 1e-6f);
#pragma unroll
        for (int j = 0; j < 8; ++j) {
            const int d0 = (j * 64 + lane) * 4;
            const f32x4 gv = *(const LAS f32x4*)(lg + d0);
            f32x4 o = {x[j][0] * inv * gv[0], x[j][1] * inv * gv[1], x[j][2] * inv * gv[2], x[j][3] * inv * gv[3]};
            *(f32x4*)(h3 + (size_t)t * D + d0) = o;
        }
    }
}

constexpr int NPH = 19;
extern __shared__ __attribute__((aligned(16))) char smem[];
__global__ void __launch_bounds__(NTHR, 2) fwd(Params p_unused, int lo, int hi) {
    LAS char* lds = (LAS char*)smem;
    CPar* pp = (CPar*)__builtin_amdgcn_kernarg_segment_ptr();
    if (threadIdx.x == 0) *(LAS u32x4*)(lds + LDS_XB) = (u32x4){0u, 0u, 0u, 0u};
    __syncthreads();
    XcdBarrier bar;
    const bool multi = (hi - lo) > 1;
    if (multi) bar = xcd_barrier_post((unsigned*)(pp->ws + WS_CTL) + CW_BAR, (volatile LAS unsigned*)(lds + LDS_XB));
#define IN(k) (lo <= (k) && (k) < hi)
#define SEAM(k) do { if (IN(k) && IN((k) + 1)) xcd_barrier(bar); } while (0)
#define PHASE(k, call) do { if (IN(k)) { asm volatile("" : "+s"(pp)); CPar& p = *pp; call; } } while (0)
    PHASE(0, ph_prologue(p, lds));
    SEAM(0);
    PHASE(1, ph_qkv(p, lds));
    SEAM(1);
    PHASE(2, ph_attn(p, lds));
    SEAM(2);
    PHASE(3, ph_oproj(p, lds, (const bf16_t*)(p.ws + WS_AO), (const bf16_t*)(p.ws + WS_WONA), p.in[8], p.in[0], p.out));
    SEAM(3);
    PHASE(4, ph_router(p, p.out, 0));
    SEAM(4);
    PHASE(6, ph_moe(p, lds, 0));
    SEAM(6);
    PHASE(7, ph_combine_mix(p, lds));
    SEAM(7);
    PHASE(9, ph_rwkv_proj(p, lds));
    SEAM(9);
    PHASE(11, ph_gate(p, lds));
    PHASE(11, ph_scan_prep(p, lds));
    SEAM(11);
    PHASE(12, ph_scan_state(p));
    SEAM(12);
    PHASE(13, ph_scan_out(p, lds));
    SEAM(13);
    PHASE(14, ph_oproj(p, lds, (const bf16_t*)(p.ws + WS_Z), (const bf16_t*)(p.ws + WS_WORW), nullptr, (const float*)(p.ws + WS_HB), p.out));
    SEAM(14);
    PHASE(15, ph_router(p, p.out, 1));
    SEAM(15);
    PHASE(17, ph_moe(p, lds, 1));
    SEAM(17);
    PHASE(18, ph_final(p, lds));
}

extern "C" void kernel_launch(void* const* d_in, const int* in_sizes, int n_in, void* d_out, int out_size, void* d_ws, size_t ws_size, hipStream_t stream) {
    static int grid = 0;
    if (grid == 0) {
        if (n_in != 34 || out_size != T * D || ws_size < WS_END) { fprintf(stderr, "kernel_launch: unexpected shapes (n_in %d out %d ws %zu)\n", n_in, out_size, ws_size); grid = -1; return; }
        int dev = 0, cus = 0, per_cu = 0;
        if (hipGetDevice(&dev) != hipSuccess || hipDeviceGetAttribute(&cus, hipDeviceAttributeMultiprocessorCount, dev) != hipSuccess) { grid = -1; return; }
        if (hipFuncSetAttribute((const void*)fwd, hipFuncAttributeMaxDynamicSharedMemorySize, LDS_BYTES) != hipSuccess) { fprintf(stderr, "kernel_launch: hipFuncSetAttribute failed\n"); grid = -1; return; }
        if (hipOccupancyMaxActiveBlocksPerMultiprocessor(&per_cu, (const void*)fwd, NTHR, LDS_BYTES) != hipSuccess || per_cu < 1) { fprintf(stderr, "kernel_launch: occupancy query failed (%d)\n", per_cu); grid = -1; return; }
        if (cus < 256) { fprintf(stderr, "kernel_launch: built for a 256-CU device (got %d)\n", cus); grid = -1; return; }
        grid = 256;
    }
    if (grid < 0) return;
    (void)hipMemsetAsync((char*)d_ws + WS_CTL, 0, 1 * MiB, stream);
    Params p{};
    for (int i = 0; i < 34; ++i) p.in[i] = (const float*)d_in[i];
    p.out = (float*)d_out; p.ws = (unsigned char*)d_ws;
#if MK_FUSED
    hipLaunchKernelGGL(fwd, dim3(grid), dim3(NTHR), LDS_BYTES, stream, p, 0, NPH);
#else
    for (int k = 0; k < NPH; ++k) hipLaunchKernelGGL(fwd, dim3(grid), dim3(NTHR), LDS_BYTES, stream, p, k, k + 1);
#endif
}
```

```cpp
#include <hip/hip_runtime.h>
#include <cstdint>
#include <cstdio>

#define LAS __attribute__((address_space(3)))
typedef unsigned short bf16_t;
typedef short bf16x8 __attribute__((ext_vector_type(8)));
typedef float f32x4 __attribute__((ext_vector_type(4)));
typedef float f32x16 __attribute__((ext_vector_type(16)));
typedef unsigned u32x4 __attribute__((ext_vector_type(4)));
typedef unsigned u32x2 __attribute__((ext_vector_type(2)));

constexpr int T = 8192, D = 2048, NH = 32, HD = 64, GW = 64, ROWS = 128;
constexpr int NEXP = 32, FF = 512;
constexpr int NTHR = 512;
#ifndef MK_FUSED
#define MK_FUSED 1
#endif

constexpr size_t MiB = 1u << 20;
constexpr size_t WS_CTL = 0;
constexpr size_t WS_LIST = 1 * MiB;
constexpr size_t WS_CW = 3 * MiB;
constexpr size_t WS_RGF = 3 * MiB + 256 * 1024;
constexpr size_t WS_REF = 3 * MiB + 384 * 1024;
constexpr size_t WS_WQKV = 4 * MiB;
constexpr size_t WS_WONA = 28 * MiB;
constexpr size_t WS_WR = 36 * MiB, WS_WK = 44 * MiB, WS_WV = 52 * MiB, WS_WORW = 60 * MiB;
constexpr size_t WS_W1T = 68 * MiB, WS_A1T = 69 * MiB, WS_G1T = 70 * MiB;
constexpr size_t WS_W2T = 71 * MiB, WS_A2T = 72 * MiB;
constexpr size_t WS_G2T = 73 * MiB;
constexpr size_t WS_GB = 74 * MiB;
constexpr size_t WS_FB = 138 * MiB;
constexpr size_t WS_GYB = 330 * MiB;
constexpr size_t WS_HS = 394 * MiB;
constexpr size_t WS_HB = 458 * MiB;
constexpr size_t WS_HN = 522 * MiB;
constexpr size_t WS_SBON = 522 * MiB;
constexpr size_t WS_ACT = 554 * MiB;
constexpr size_t WS_ACT1 = 666 * MiB;
constexpr size_t WS_Y = 570 * MiB;
constexpr size_t WS_Z = 570 * MiB;
constexpr size_t WS_FYB = 602 * MiB;
constexpr size_t WS_Q = 634 * MiB, WS_K = 666 * MiB, WS_VT = 698 * MiB, WS_AO = 730 * MiB;
constexpr size_t WS_MIX = 698 * MiB;
constexpr size_t WS_G = 698 * MiB;
constexpr size_t WS_R = 890 * MiB, WS_K2 = 922 * MiB, WS_V2 = 954 * MiB;
constexpr size_t WS_LW = 986 * MiB, WS_LA = 990 * MiB, WS_GL = 994 * MiB;
constexpr size_t WS_END = 998 * MiB;

constexpr int CW_BAR = 4096;
constexpr int CW_CNT0 = 16384, CW_CNT1 = 16384 + 64;
constexpr int CW_MOEQ = 20480;
constexpr int CW_MOEMT = 24576;

constexpr int LDS_MISC = 159744;
constexpr int LDS_PREF = LDS_MISC;
constexpr int LDS_XB = LDS_MISC + 256;
constexpr int LDS_SEG = LDS_MISC + 512;
constexpr int LDS_ELEND = LDS_MISC + 1024;
constexpr int LDS_TILE_E = LDS_MISC + 2048;
constexpr int LDS_MOEQ = LDS_MISC + 3072;
constexpr int LDS_BYTES = 163840;

struct Params {
    const float* in[34];
    float* out;
    unsigned char* ws;
};
typedef const __attribute__((address_space(4))) Params CPar;

typedef float f32x2_t __attribute__((ext_vector_type(2)));
typedef __bf16 bf16x2_t __attribute__((ext_vector_type(2)));
__device__ __forceinline__ unsigned pk2(float lo, float hi) { const f32x2_t v = {lo, hi}; return __builtin_bit_cast(unsigned, __builtin_convertvector(v, bf16x2_t)); }
__device__ __forceinline__ unsigned f2bf(float f) { return pk2(f, 0.f) & 0xffffu; }
__device__ __forceinline__ float bflo(unsigned u) { return __builtin_bit_cast(float, u << 16); }
__device__ __forceinline__ float bfhi(unsigned u) { return __builtin_bit_cast(float, u & 0xffff0000u); }
__device__ __forceinline__ float bf2f(bf16_t b) { return __builtin_bit_cast(float, (unsigned)b << 16); }
__device__ __forceinline__ void lds_barrier() { asm volatile("s_waitcnt lgkmcnt(0)" ::: "memory"); __builtin_amdgcn_s_barrier(); asm volatile("" ::: "memory"); }
__device__ __forceinline__ float wave_sum(float v) {
#pragma unroll
    for (int o = 32; o; o >>= 1) v += __shfl_xor(v, o);
    return v;
}
__device__ __forceinline__ int otid() { int t = threadIdx.x; asm volatile("" : "+v"(t)); return t; }
__device__ __forceinline__ float tanhf_(float x) { return 1.f - 2.f * __builtin_amdgcn_rcpf(1.f + __expf(2.f * x)); }
__device__ __forceinline__ float sigmoidf_(float x) { return __builtin_amdgcn_rcpf(1.f + __expf(-x)); }

#define XB_TMO      128
#define XB_XCNT(j)  (256  + 64 * (j))
#define XB_XSUB(j)  (1280 + 64 * (j))
#define XB_XGEN(j)  (2304 + 64 * (j))
#define XB_TOP      3328
#define XB_TOPGEN   3392
#define XCD_BAR_WORDS 3456
#define XB_SPIN_CAP (1u << 18)
__device__ __forceinline__ unsigned xb_ld(unsigned* p)              { return __hip_atomic_load(p, __ATOMIC_RELAXED, __HIP_MEMORY_SCOPE_AGENT); }
__device__ __forceinline__ unsigned xb_add(unsigned* p, unsigned v) { return __hip_atomic_fetch_add(p, v, __ATOMIC_RELAXED, __HIP_MEMORY_SCOPE_AGENT); }
__device__ __forceinline__ unsigned xb_xcc_id() { return (unsigned)__builtin_amdgcn_s_getreg((3 << 11) | 20) & 0xFu; }
#define XB_SPIN(cond, bar) do { unsigned _sp = 0; while (cond) { __builtin_amdgcn_s_sleep(1); \
    if ((++_sp & 255u) == 0u) { if (xb_ld(&(bar)[XB_TMO])) break; if (_sp > XB_SPIN_CAP) { atomicAdd(&(bar)[XB_TMO], 1u); break; } } } } while (0)
struct XcdBarrier { unsigned* bar; unsigned x; volatile LAS unsigned* st; };
__device__ __forceinline__ XcdBarrier xcd_barrier_post(unsigned* bar, volatile LAS unsigned* st) {
    XcdBarrier b; b.bar = bar; b.x = xb_xcc_id(); b.st = st;
    if (threadIdx.x == 0) (void)xb_add(&bar[XB_XCNT(b.x)], 1u);
    return b;
}
__device__ __forceinline__ void xcd_barrier_complete(unsigned* bar, unsigned x, unsigned& nloc, unsigned& nx) {
    const unsigned G = gridDim.x * gridDim.y * gridDim.z;
    unsigned sum, cnt, mine, sp = 0u;
    for (;;) {
        sum = 0u; cnt = 0u; mine = 0u;
#pragma unroll
        for (unsigned j = 0; j < 16; ++j) { const unsigned c = xb_ld(&bar[XB_XCNT(j)]); sum += c; cnt += (c > 0u) ? 1u : 0u; mine = (j == x) ? c : mine; }
        if (sum == G) break;
        __builtin_amdgcn_s_sleep(1);
        if ((++sp & 255u) == 0u) { if (xb_ld(&bar[XB_TMO])) break; if (sp > XB_SPIN_CAP) { atomicAdd(&bar[XB_TMO], 1u); break; } }
    }
    nloc = mine > 0u ? mine : 1u; nx = cnt > 0u ? cnt : 1u;
}
__device__ __forceinline__ void xcd_barrier(const XcdBarrier& b) {
    asm volatile("s_waitcnt vmcnt(0)" ::: "memory");
    __syncthreads();
    if (threadIdx.x == 0) {
        unsigned* bar = b.bar;
        __builtin_amdgcn_s_waitcnt(0);
        unsigned nloc = b.st[0], nx = b.st[1];
        if (nloc == 0u) { xcd_barrier_complete(bar, b.x, nloc, nx); b.st[0] = nloc; b.st[1] = nx; }
        const unsigned old = xb_add(&bar[XB_XSUB(b.x)], 1u);
        const unsigned gen = old / nloc;
        if (old + 1u == (gen + 1u) * nloc) {
            __builtin_amdgcn_fence(__ATOMIC_RELEASE, "agent");
            asm volatile("s_waitcnt vmcnt(0)" ::: "memory");
            const unsigned og = xb_add(&bar[XB_TOP], 1u);
            const unsigned tg = og / nx;
            if (og + 1u == (tg + 1u) * nx) xb_add(&bar[XB_TOPGEN], 1u);
            else XB_SPIN(xb_ld(&bar[XB_TOPGEN]) == tg, bar);
            __builtin_amdgcn_fence(__ATOMIC_ACQUIRE, "agent");
            xb_add(&bar[XB_XGEN(b.x)], 1u);
            asm volatile("s_waitcnt vmcnt(0)" ::: "memory");
        } else {
            XB_SPIN(xb_ld(&bar[XB_XGEN(b.x)]) == gen, bar);
            __builtin_amdgcn_fence(__ATOMIC_ACQUIRE, "agent");
            asm volatile("s_waitcnt vmcnt(0)" ::: "memory");
        }
    }
    __syncthreads();
}

template <class Epi>
__device__ __forceinline__ void gemm_tile_moe(const int tid, LAS char* lds, const bf16_t* __restrict__ A, int lda, const int* __restrict__ rows, int nvalid, int rshift,
                                              const float* __restrict__ bsrc, int ldn, int K, const Epi& epi) {
    const int lane = tid & 63, wid = tid >> 6, wm = wid >> 1, wn = wid & 1;
    const int srow = tid >> 3, sch = tid & 7;
    unsigned offA[4];
#pragma unroll
    for (int i = 0; i < 4; ++i) {
        const int r = srow + i * 64;
        const int rr = r < nvalid ? r : 0;
        offA[i] = (unsigned)(rows[rr] >> rshift) * (unsigned)lda + sch * 8;
    }
#define MOE_KEY(r_) ((((r_) >> 2) & 7) ^ ((((r_) >> 1) & 1) << 2))
    const unsigned ldsw = srow * 128 + ((sch ^ MOE_KEY(srow)) << 4);
    const int nq = tid & 31, kq = tid >> 5;
    unsigned ldsb[4];
#pragma unroll
    for (int c = 0; c < 4; ++c) { const int rho = nq * 4 + c; ldsb[c] = 32768u + rho * 128 + ((((kq >> 1)) ^ MOE_KEY(rho)) << 4) + (kq & 1) * 8; }
    const float* bp = bsrc + (size_t)(kq * 4) * ldn;
    const int l31 = lane & 31, lh = lane >> 5, key = MOE_KEY(l31);
    const unsigned ra = (wm * 64 + l31) * 128;
    const unsigned rb = 32768 + (wn * 64 + l31) * 128;
    unsigned kc[4];
#pragma unroll
    for (int ks = 0; ks < 4; ++ks) kc[ks] = ((ks * 2 + lh) ^ key) << 4;
    f32x16 acc[2][2];
#pragma unroll
    for (int mi = 0; mi < 2; ++mi)
#pragma unroll
        for (int nj = 0; nj < 2; ++nj)
#pragma unroll
            for (int e = 0; e < 16; ++e) acc[mi][nj][e] = 0.f;
    u32x4 xa[4], ya[4]; f32x4 xb[4], yb[4];
    const int nt = K >> 6;
#define MOE_LOAD(ra_, rb_, tt) do { _Pragma("unroll") for (int i = 0; i < 4; ++i) { ra_[i] = *(const u32x4*)(A + offA[i] + (tt) * 64); rb_[i] = *(const f32x4*)(bp + (size_t)((tt) * 64 + i) * ldn); } } while (0)
#define MOE_STORE(ra_, rb_, so_) do { _Pragma("unroll") for (int i = 0; i < 4; ++i) *(LAS u32x4*)(lds + (so_) + ldsw + i * 8192) = ra_[i]; \
        _Pragma("unroll") for (int c = 0; c < 4; ++c) { u32x2 o; o.x = pk2(rb_[0][c], rb_[1][c]); o.y = pk2(rb_[2][c], rb_[3][c]); *(LAS u32x2*)(lds + (so_) + ldsb[c]) = o; } } while (0)
#define MOE_FRAGS(so_, ks, AF, BQ) do { _Pragma("unroll") for (int mi = 0; mi < 2; ++mi) AF[mi] = *(const LAS bf16x8*)(lds + (so_) + ra + mi * 4096 + kc[ks]); \
        _Pragma("unroll") for (int nj = 0; nj < 2; ++nj) BQ[nj] = *(const LAS bf16x8*)(lds + (so_) + rb + nj * 4096 + kc[ks]); } while (0)
#define MOE_MMA(AF, BQ) do { _Pragma("unroll") for (int mi = 0; mi < 2; ++mi) _Pragma("unroll") for (int nj = 0; nj < 2; ++nj) \
        acc[mi][nj] = __builtin_amdgcn_mfma_f32_32x32x16_bf16(BQ[nj], AF[mi], acc[mi][nj], 0, 0, 0); } while (0)
#define MOE_SB __builtin_amdgcn_sched_barrier(0)
#define MOE_COMPUTE(so_) do { bf16x8 afA[2], bqA[2], afB[2], bqB[2]; \
        MOE_FRAGS(so_, 0, afA, bqA); MOE_FRAGS(so_, 1, afB, bqB); MOE_SB; MOE_MMA(afA, bqA); MOE_SB; \
        MOE_FRAGS(so_, 2, afA, bqA); MOE_SB; MOE_MMA(afB, bqB); MOE_SB; \
        MOE_FRAGS(so_, 3, afB, bqB); MOE_SB; MOE_MMA(afA, bqA); MOE_SB; MOE_MMA(afB, bqB); } while (0)
#define MOE_STEP(tt, SA_, SB_, LA_, LB_) do { \
        if ((tt) + 2 < nt) MOE_LOAD(LA_, LB_, (tt) + 2); \
        __builtin_amdgcn_sched_barrier(0); \
        MOE_COMPUTE(((tt) & 1) * 49152u); \
        __builtin_amdgcn_sched_barrier(0); \
        if ((tt) + 1 < nt) MOE_STORE(SA_, SB_, (((tt) + 1) & 1) * 49152u); \
        __syncthreads(); } while (0)
    MOE_LOAD(xa, xb, 0);
    MOE_STORE(xa, xb, 0u);
    if (nt > 1) MOE_LOAD(xa, xb, 1);
    __syncthreads();
    for (int t = 0; t < nt; t += 8) {
        MOE_STEP(t, xa, xb, ya, yb); MOE_STEP(t + 1, ya, yb, xa, xb); MOE_STEP(t + 2, xa, xb, ya, yb); MOE_STEP(t + 3, ya, yb, xa, xb);
        MOE_STEP(t + 4, xa, xb, ya, yb); MOE_STEP(t + 5, ya, yb, xa, xb); MOE_STEP(t + 6, xa, xb, ya, yb); MOE_STEP(t + 7, ya, yb, xa, xb);
    }
#undef MOE_STEP
#undef MOE_COMPUTE
#undef MOE_FRAGS
#undef MOE_MMA
#undef MOE_SB
#undef MOE_LOAD
#undef MOE_STORE
#undef MOE_KEY
    epi(acc, wm, wn, l31, lh);
}

typedef __attribute__((address_space(1))) unsigned gu32;
struct EpiMoeGU3 {
    bf16_t* act; const float* cw; const int* rows; int nvalid; int f0; LAS char* lds; int tid; gu32* mtc;
    __device__ __forceinline__ void operator()(const f32x16 (&acc)[2][2], int wm, int wn, int l31, int lh) const {
#pragma unroll
        for (int mi = 0; mi < 2; ++mi) {
            const int ml = wm * 64 + mi * 32 + l31;
            const float w = ml < nvalid ? cw[rows[ml]] : 0.f;
#pragma unroll
            for (int rg = 0; rg < 4; ++rg) {
                float o[4];
#pragma unroll
                for (int e = 0; e < 4; ++e) { const float g = acc[mi][0][4 * rg + e], u = acc[mi][1][4 * rg + e]; o[e] = g * sigmoidf_(g) * u * w; }
                u32x2 ov; ov.x = pk2(o[0], o[1]); ov.y = pk2(o[2], o[3]);
                *(LAS u32x2*)(lds + ml * 144 + (wn * 32 + 8 * rg + 4 * lh) * 2) = ov;
            }
        }
        __syncthreads();
        const __amdgpu_buffer_rsrc_t rs = __builtin_amdgcn_make_buffer_rsrc((void*)act, 0, 2 * T * FF * 2, 0x00020000);
#pragma unroll
        for (int i = 0; i < 4; ++i) {
            const int row = (tid >> 3) + 64 * i, pc = tid & 7;
            if (row < nvalid) {
                const u32x4 v = *(const LAS u32x4*)(lds + row * 144 + pc * 16);
                __builtin_amdgcn_raw_buffer_store_b128(v, rs, (rows[row] * FF + f0 + pc * 8) * 2, 0,   16);
            }
        }
        asm volatile("s_waitcnt vmcnt(0)" ::: "memory");
        if ((tid & 63) == 0) (void)__hip_atomic_fetch_add(mtc, 1u, __ATOMIC_RELAXED, __HIP_MEMORY_SCOPE_AGENT);
        __syncthreads();
    }
};
struct EpiMoeD2 {
    bf16_t* y; const int* rows; int nvalid; int n0; LAS char* lds; int tid;
    __device__ __forceinline__ void operator()(const f32x16 (&acc)[2][2], int wm, int wn, int l31, int lh) const {
#pragma unroll
        for (int mi = 0; mi < 2; ++mi) {
            const int ml = wm * 64 + mi * 32 + l31;
#pragma unroll
            for (int nj = 0; nj < 2; ++nj)
#pragma unroll
                for (int rg = 0; rg < 4; ++rg) {
                    u32x2 o; o.x = pk2(acc[mi][nj][4 * rg], acc[mi][nj][4 * rg + 1]); o.y = pk2(acc[mi][nj][4 * rg + 2], acc[mi][nj][4 * rg + 3]);
                    *(LAS u32x2*)(lds + ml * 272 + (wn * 64 + nj * 32 + 8 * rg + 4 * lh) * 2) = o;
                }
        }
        __syncthreads();
#pragma unroll
        for (int i = 0; i < 8; ++i) {
            const int row = (tid >> 4) + 32 * i, pc = tid & 15;
            if (row < nvalid) {
                const u32x4 v = *(const LAS u32x4*)(lds + row * 272 + pc * 16);
                *(u32x4*)(y + (size_t)rows[row] * D + n0 + pc * 8) = v;
            }
        }
        __syncthreads();
    }
};
namespace pg8 {
#define PG8_LAS __attribute__((address_space(3)))
typedef unsigned short bf16_t;
typedef short bf16x8 __attribute__((ext_vector_type(8)));
typedef float f32x4 __attribute__((ext_vector_type(4)));
typedef unsigned u32x4 __attribute__((ext_vector_type(4)));
constexpr int BM = 256, BK = 64, HALF = 128, HTB = HALF * BK * 2  , STAGE_BYTES = 8 * HTB, NXCD = 8, WGM = 8;

__host__ __device__ __forceinline__ int lds_byte(int r, int c) { const int st = (r >> 4) * 2 + (c >> 5), rr = r & 15, cc = c & 31, ob = rr * 64 + cc * 2; return st * 1024 + (ob ^ (((ob >> 9) & 1) << 5)); }
__host__ __device__ __forceinline__ void stage_rc(int b, int& R, int& C) { const int st = b / 1024, sb = b % 1024, swz = sb ^ (((sb >> 9) & 1) << 5); R = (st >> 1) * 16 + swz / 64; C = (st & 1) * 32 + (swz % 64) / 2; }
__host__ __device__ __forceinline__ int perm32(int rho) { const int n = rho >> 4, i = rho & 15; return 8 * (i >> 2) + 4 * n + (i & 3); }

struct Unit { int pm, pn; };
struct Gemm { const bf16_t* A; const bf16_t* Bt; int M, N, K; };

struct StaticOrder {
    int nM, nN, nwg, G, c;
    __host__ __device__ void init(int M, int N, int G_, int c_) { nM = M / BM; nN = N / BM; nwg = nM * nN; G = G_; c = c_; }
    __host__ __device__ bool next(int i, Unit& u) const {
        const long L = (long)i * G + c; if (L >= nwg) return false;
        int wgid = (int)L; { const int q = nwg / NXCD, r = nwg % NXCD, xcd = wgid % NXCD, off = wgid / NXCD; wgid = (xcd < r ? xcd * (q + 1) : r * (q + 1) + (xcd - r) * q) + off; }
        const int nig = WGM * nN, gid = wgid / nig, fm = gid * WGM, gsz = (nM - fm) < WGM ? (nM - fm) : WGM;
        u.pm = fm + ((wgid % nig) % gsz); u.pn = (wgid % nig) / gsz; return true;
    }
    __device__ __forceinline__ void a_ready(const Unit&) const {}
    __device__ __forceinline__ void done(const Unit&) const {}
};

__device__ __forceinline__ unsigned cvt_pk_bf16(float lo, float hi) { unsigned r; asm volatile("v_cvt_pk_bf16_f32 %0, %1, %2" : "=v"(r) : "v"(lo), "v"(hi)); return r; }

template <class Epi, class Sched, bool ALIGN_EPI = false, bool SP2 = false>
__device__ __forceinline__ void gemm_phase(const int tid, PG8_LAS unsigned char* lds, const Gemm g, const Sched& S, const Epi& E) {
    const int wid = __builtin_amdgcn_readfirstlane(tid >> 6), lane = tid & 63, wr = wid >> 2, wc = wid & 3, fr = lane & 15, fq = lane >> 4;
    const int K = g.K, nt = K / BK;
    unsigned voffA[2], voffB[2];
#pragma unroll
    for (int i = 0; i < 2; ++i) { int R, C; stage_rc(tid * 16 + i * 8192, R, C); const int Rb = Epi::PERM ? ((R & ~31) + perm32(R & 31)) : R;
        voffA[i] = (unsigned)(R * K + C) * 2u; voffB[i] = (unsigned)(Rb * K + C) * 2u; }
    const size_t kstep = (size_t)(BK * 2);
    const size_t hstep = (size_t)HALF * K * 2;
    const size_t tstep = 2 * hstep;
    const unsigned ldsw = (unsigned)wid * 1024u;
    const int aoff = lds_byte(wr * 64 + fr, fq * 8), boff = lds_byte(wc * 32 + fr, fq * 8);
#define PG8_SA(b, h) (((b) * 2 + (h)) * HTB)
#define PG8_SB(b, h) ((4 + (b) * 2 + (h)) * HTB)
#define PG8_STAGE(bufoff, gbase, voff) do { _Pragma("unroll") for (int _i = 0; _i < 2; ++_i) \
        __builtin_amdgcn_global_load_lds((const unsigned*)((const char*)(gbase) + (voff)[_i]), (PG8_LAS unsigned*)(lds + (bufoff) + ldsw + _i * 8192), 16, 0, 0); } while (0)
#define PG8_LDA(dst, b, h) do { _Pragma("unroll") for (int m = 0; m < 4; ++m) _Pragma("unroll") for (int k = 0; k < 2; ++k) dst[m][k] = *(const PG8_LAS bf16x8*)(lds + PG8_SA(b, h) + aoff + m * 2048 + k * 1024); } while (0)
#define PG8_LDB(dst, b, h) do { _Pragma("unroll") for (int n = 0; n < 2; ++n) _Pragma("unroll") for (int k = 0; k < 2; ++k) dst[n][k] = *(const PG8_LAS bf16x8*)(lds + PG8_SB(b, h) + boff + n * 2048 + k * 1024); } while (0)
#define PG8_MMA(ai, bj, At, Bt) do { __builtin_amdgcn_s_setprio(1); _Pragma("unroll") for (int m = 0; m < 4; ++m) _Pragma("unroll") for (int n = 0; n < 2; ++n) _Pragma("unroll") for (int k = 0; k < 2; ++k) \
        acc[ai][bj][m][n] = __builtin_amdgcn_mfma_f32_16x16x32_bf16(Bt[n][k], At[m][k], acc[ai][bj][m][n], 0, 0, 0); __builtin_amdgcn_s_setprio(0); } while (0)
#define PG8_WAIT_V(n) asm volatile("s_waitcnt vmcnt(" #n ")" ::: "memory")
#define PG8_WAIT_L(n) asm volatile("s_waitcnt lgkmcnt(" #n ")" ::: "memory")
#define PG8_BAR __builtin_amdgcn_s_barrier()
#define PG8_SCHED __builtin_amdgcn_sched_barrier(0)
    Unit cur, nxt; int ui = 0;
    if (!S.next(0, cur)) return;
    f32x4 acc[2][2][4][2];
#pragma unroll
    for (int a = 0; a < 2; ++a)
#pragma unroll
        for (int b = 0; b < 2; ++b)
#pragma unroll
            for (int m = 0; m < 4; ++m)
#pragma unroll
                for (int n = 0; n < 2; ++n) acc[a][b][m][n] = (f32x4){0.f, 0.f, 0.f, 0.f};
    bf16x8 At[4][2], B0[2][2], B1[2][2];
    const char* cA = (const char*)g.A + (size_t)cur.pm * tstep; const char* cB = (const char*)g.Bt + (size_t)cur.pn * tstep;
    S.a_ready(cur);
    if constexpr (SP2) {
        PG8_STAGE(PG8_SB(0, 0), cB, voffB); PG8_STAGE(PG8_SB(0, 1), cB + hstep, voffB); PG8_STAGE(PG8_SA(0, 0), cA, voffA); PG8_STAGE(PG8_SA(0, 1), cA + hstep, voffA);
        if (wr == 1) PG8_BAR;
        PG8_WAIT_V(2); PG8_BAR;
        PG8_STAGE(PG8_SB(1, 0), cB + kstep, voffB); PG8_STAGE(PG8_SA(1, 0), cA + kstep, voffA); PG8_STAGE(PG8_SB(1, 1), cB + hstep + kstep, voffB);
        PG8_WAIT_V(6); PG8_BAR;
    } else {
        PG8_STAGE(PG8_SB(0, 0), cB, voffB); PG8_STAGE(PG8_SA(0, 0), cA, voffA); PG8_STAGE(PG8_SB(0, 1), cB + hstep, voffB); PG8_STAGE(PG8_SA(0, 1), cA + hstep, voffA);
        if (wr == 1) PG8_BAR;
        PG8_WAIT_V(4); PG8_BAR;
        PG8_STAGE(PG8_SB(1, 0), cB + kstep, voffB); PG8_STAGE(PG8_SA(1, 0), cA + kstep, voffA); PG8_STAGE(PG8_SB(1, 1), cB + hstep + kstep, voffB);
        PG8_WAIT_V(6); PG8_BAR;
    }
    for (;;) {
        const bool has_next = S.next(ui + 1, nxt);
        const char* nA = has_next ? (const char*)g.A + (size_t)nxt.pm * tstep : cA; const char* nB = has_next ? (const char*)g.Bt + (size_t)nxt.pn * tstep : cB;
        for (int t = 0; t < nt; t += 2) {
            const bool last = (t == nt - 2);
            const char* a1 = cA + (size_t)(t + 1) * kstep;
            const char* a2 = last ? nA : cA + (size_t)(t + 2) * kstep; const char* b2 = last ? nB : cB + (size_t)(t + 2) * kstep;
            const char* a3 = a2 + kstep; const char* b3 = b2 + kstep;
            if (last && has_next) S.a_ready(nxt);
            if constexpr (SP2) {
            PG8_LDB(B0, 0, 0); PG8_LDB(B1, 0, 1); PG8_SCHED; PG8_LDA(At, 0, 0); PG8_STAGE(PG8_SA(1, 1), a1 + hstep, voffA);
            PG8_WAIT_V(8); PG8_WAIT_L(0); PG8_BAR; PG8_MMA(0, 0, At, B0); PG8_MMA(0, 1, At, B1); PG8_BAR; PG8_SCHED;
            PG8_LDA(At, 0, 1); PG8_STAGE(PG8_SB(0, 0), b2, voffB); PG8_STAGE(PG8_SB(0, 1), b2 + hstep, voffB); PG8_STAGE(PG8_SA(0, 0), a2, voffA);
            PG8_WAIT_V(8); PG8_WAIT_L(0); PG8_BAR; PG8_MMA(1, 0, At, B0); PG8_MMA(1, 1, At, B1); PG8_BAR; PG8_SCHED;
            PG8_LDB(B0, 1, 0); PG8_LDB(B1, 1, 1); PG8_SCHED; PG8_LDA(At, 1, 0); PG8_STAGE(PG8_SA(0, 1), a2 + hstep, voffA);
            PG8_WAIT_V(8); PG8_WAIT_L(0); PG8_BAR; PG8_MMA(0, 0, At, B0); PG8_MMA(0, 1, At, B1); PG8_BAR; PG8_SCHED;
            PG8_LDA(At, 1, 1); PG8_STAGE(PG8_SB(1, 0), b3, voffB); PG8_STAGE(PG8_SB(1, 1), b3 + hstep, voffB); PG8_STAGE(PG8_SA(1, 0), a3, voffA);
            PG8_WAIT_V(8); PG8_WAIT_L(0); PG8_BAR; PG8_MMA(1, 0, At, B0); PG8_MMA(1, 1, At, B1); PG8_BAR; PG8_SCHED;
            } else {
            PG8_LDB(B0, 0, 0); PG8_SCHED; PG8_LDA(At, 0, 0); PG8_STAGE(PG8_SA(1, 1), a1 + hstep, voffA);
            PG8_WAIT_L(8); PG8_BAR; PG8_WAIT_L(0); PG8_MMA(0, 0, At, B0); PG8_BAR; PG8_SCHED;
            PG8_LDB(B1, 0, 1); PG8_STAGE(PG8_SB(0, 0), b2, voffB);
            PG8_BAR; PG8_WAIT_L(0); PG8_MMA(0, 1, At, B1); PG8_BAR;
            PG8_LDA(At, 0, 1); PG8_STAGE(PG8_SA(0, 0), a2, voffA);
            PG8_BAR; PG8_WAIT_L(0); PG8_MMA(1, 0, At, B0); PG8_BAR; PG8_SCHED;
            PG8_STAGE(PG8_SB(0, 1), b2 + hstep, voffB);
            PG8_WAIT_V(6); PG8_BAR; PG8_MMA(1, 1, At, B1); PG8_BAR;
            PG8_LDB(B0, 1, 0); PG8_SCHED; PG8_LDA(At, 1, 0); PG8_STAGE(PG8_SA(0, 1), a2 + hstep, voffA);
            PG8_WAIT_L(8); PG8_BAR; PG8_WAIT_L(0); PG8_MMA(0, 0, At, B0); PG8_BAR; PG8_SCHED;
            PG8_LDB(B1, 1, 1); PG8_STAGE(PG8_SB(1, 0), b3, voffB);
            PG8_BAR; PG8_WAIT_L(0); PG8_MMA(0, 1, At, B1); PG8_BAR;
            PG8_LDA(At, 1, 1); PG8_STAGE(PG8_SA(1, 0), a3, voffA);
            PG8_BAR; PG8_WAIT_L(0); PG8_MMA(1, 0, At, B0); PG8_BAR; PG8_SCHED;
            PG8_STAGE(PG8_SB(1, 1), b3 + hstep, voffB);
            PG8_WAIT_V(6); PG8_BAR; PG8_MMA(1, 1, At, B1); PG8_BAR;
            }
        }
        if constexpr (ALIGN_EPI) { if (wr == 0) PG8_BAR; }
        if constexpr (!Epi::AFTER_DRAIN) { E(acc, cur, wr, wc, fr, fq); S.done(cur); }
        if (!has_next) break;
#pragma unroll
        for (int a = 0; a < 2; ++a)
#pragma unroll
            for (int b = 0; b < 2; ++b)
#pragma unroll
                for (int m = 0; m < 4; ++m)
#pragma unroll
                    for (int n = 0; n < 2; ++n) acc[a][b][m][n] = (f32x4){0.f, 0.f, 0.f, 0.f};
        cur = nxt; cA = nA; cB = nB; ++ui;
        if constexpr (ALIGN_EPI) { if (wr == 1) PG8_BAR; }
    }
    PG8_WAIT_V(0);
    if constexpr (!ALIGN_EPI) { if (wr == 0) PG8_BAR; }
    PG8_BAR;
    if constexpr (Epi::AFTER_DRAIN) { E.fused(acc, cur, wr, wc, fr, fq, lds, wid, lane); S.done(cur); }
#undef PG8_SA
#undef PG8_SB
#undef PG8_STAGE
#undef PG8_LDA
#undef PG8_LDB
#undef PG8_MMA
#undef PG8_WAIT_V
#undef PG8_WAIT_L
#undef PG8_BAR
#undef PG8_SCHED
}

struct PEpiQK {
    static constexpr bool PERM = true, AFTER_DRAIN = false;
    bf16_t* q; bf16_t* k; const float* bias;
    __device__ __forceinline__ void operator()(const f32x4 (&acc)[2][2][4][2], const Unit& u, int wr, int wc, int fr, int fq) const {
        const int row0 = u.pm * BM + wr * 64 + fr, colt = u.pn * BM;
        const bool isq = colt < 2048; const float sc = isq ? 0.125f : 1.f;
        const int cbase = (isq ? colt : colt - 2048) + wc * 32 + 8 * fq, bcol = colt + wc * 32 + 8 * fq;
#pragma unroll
        for (int bj = 0; bj < 2; ++bj) {
            const f32x4 b0 = *(const f32x4*)(bias + bcol + bj * HALF), b1 = *(const f32x4*)(bias + bcol + bj * HALF + 4);
            const int kc = cbase + bj * HALF, hh = kc >> 6, d0 = kc & 63;
#pragma unroll
            for (int ai = 0; ai < 2; ++ai)
#pragma unroll
                for (int m = 0; m < 4; ++m) {
                    const f32x4 v0 = (acc[ai][bj][m][0] + b0) * sc, v1 = (acc[ai][bj][m][1] + b1) * sc;
                    u32x4 w; w.x = cvt_pk_bf16(v0[0], v0[1]); w.y = cvt_pk_bf16(v0[2], v0[3]); w.z = cvt_pk_bf16(v1[0], v1[1]); w.w = cvt_pk_bf16(v1[2], v1[3]);
                    const int tok = row0 + ai * HALF + m * 16;
                    if (isq) *(u32x4*)(q + (size_t)tok * 2048 + kc) = w;
                    else { const int R = tok >> 6, c = tok & 63;
                        *(u32x4*)(k + ((((((size_t)(R * 32 + hh) * 8 + (c >> 3)) * 2 + ((c >> 2) & 1)) * 2 + (d0 >> 5)) * 4 + (c & 3)) * 4 + ((d0 >> 3) & 3)) * 8) = w; }
                }
        }
    }
};
struct PEpiVT {
    static constexpr bool PERM = true, AFTER_DRAIN = false;
    bf16_t* vt; const float* bias;
    __device__ __forceinline__ void operator()(const f32x4 (&acc)[2][2][4][2], const Unit& u, int wr, int wc, int fr, int fq) const {
        const int row0 = u.pm * BM + wr * 64 + fr, col0 = u.pn * BM + wc * 32 + 8 * fq;
#pragma unroll
        for (int ai = 0; ai < 2; ++ai)
#pragma unroll
            for (int m = 0; m < 4; ++m) {
                const int c = row0 + ai * HALF + m * 16; const float b = bias[c];
#pragma unroll
                for (int bj = 0; bj < 2; ++bj) {
                    const f32x4 v0 = acc[ai][bj][m][0] + b, v1 = acc[ai][bj][m][1] + b;
                    u32x4 w; w.x = cvt_pk_bf16(v0[0], v0[1]); w.y = cvt_pk_bf16(v0[2], v0[3]); w.z = cvt_pk_bf16(v1[0], v1[1]); w.w = cvt_pk_bf16(v1[2], v1[3]);
                    { const int tok = col0 + bj * HALF, R = tok >> 6, cgp = (tok & 63) >> 3;
                      *(u32x4*)(vt + ((((size_t)(R * 32 + (c >> 6)) * 8 + cgp) * 64 + (c & 63)) * 8)) = w; }
                }
            }
    }
};
struct PEpiResid {
    static constexpr bool PERM = false, AFTER_DRAIN = false;
    const float* src; float* dst; const float* bias;
    __device__ __forceinline__ void operator()(const f32x4 (&acc)[2][2][4][2], const Unit& u, int wr, int wc, int fr, int fq) const {
        const int row0 = u.pm * BM + wr * 64 + fr, col0 = u.pn * BM + wc * 32 + 4 * fq;
        f32x4 bv[2][2];
#pragma unroll
        for (int bj = 0; bj < 2; ++bj)
#pragma unroll
            for (int n = 0; n < 2; ++n) bv[bj][n] = bias ? *(const f32x4*)(bias + col0 + bj * HALF + n * 16) : (f32x4){0.f, 0.f, 0.f, 0.f};
#pragma unroll
        for (int ai = 0; ai < 2; ++ai)
#pragma unroll
            for (int mh = 0; mh < 2; ++mh) {
                f32x4 sv[2][2][2];
#pragma unroll
                for (int ml = 0; ml < 2; ++ml)
#pragma unroll
                    for (int bj = 0; bj < 2; ++bj)
#pragma unroll
                        for (int n = 0; n < 2; ++n) sv[ml][bj][n] = *(const f32x4*)(src + (size_t)(row0 + ai * HALF + (mh * 2 + ml) * 16) * 2048 + col0 + bj * HALF + n * 16);
                asm volatile("" ::: "memory");
#pragma unroll
                for (int ml = 0; ml < 2; ++ml)
#pragma unroll
                    for (int bj = 0; bj < 2; ++bj)
#pragma unroll
                        for (int n = 0; n < 2; ++n) *(f32x4*)(dst + (size_t)(row0 + ai * HALF + (mh * 2 + ml) * 16) * 2048 + col0 + bj * HALF + n * 16) = sv[ml][bj][n] + acc[ai][bj][mh * 2 + ml][n] + bv[bj][n];
                asm volatile("" ::: "memory");
            }
    }
};
struct PEpiRwkv {
    static constexpr bool PERM = true, AFTER_DRAIN = false;
    bf16_t* rkv;
    bf16_t* lw; bf16_t* la; bf16_t* gl;
    __device__ __forceinline__ void operator()(const f32x4 (&acc)[2][2][4][2], const Unit& u, int wr, int wc, int fr, int fq) const {
        const int which = u.pm >> 5, row0 = (u.pm & 31) * BM + wr * 64 + fr;
#pragma unroll
        for (int bj = 0; bj < 2; ++bj)
#pragma unroll
            for (int ai = 0; ai < 2; ++ai)
#pragma unroll
                for (int m = 0; m < 4; ++m) {
                    f32x4 v0 = acc[ai][bj][m][0], v1 = acc[ai][bj][m][1];
                    const int t = row0 + ai * HALF + m * 16;
                    bf16_t* dp;
                    if (which < 3) dp = rkv + (size_t)which * 8192 * 2048 + (size_t)t * 2048 + (u.pn - which * 8) * BM + bj * HALF + wc * 32 + 8 * fq;
                    else {
                        const int j = bj * HALF + wc * 32 + 8 * fq;
#pragma unroll
                        for (int e = 0; e < 4; ++e) {
                            if (which == 3) { v0[e] = tanhf_(v0[e]); v1[e] = tanhf_(v1[e]); }
                            else if (which == 5) { v0[e] = __builtin_amdgcn_rcpf(1.f + __expf(-v0[e])); v1[e] = __builtin_amdgcn_rcpf(1.f + __expf(-v1[e])); }
                        }
                        dp = which == 5 ? gl + (size_t)t * 256 + j : (which == 3 ? lw : la) + ((((size_t)(j >> 7) * 512 + (t >> 4)) * 4 + ((j & 127) >> 5)) * 64 + ((j >> 3) & 3) * 16 + (t & 15)) * 8;
                    }
                    u32x4 w; w.x = cvt_pk_bf16(v0[0], v0[1]); w.y = cvt_pk_bf16(v0[2], v0[3]); w.z = cvt_pk_bf16(v1[0], v1[1]); w.w = cvt_pk_bf16(v1[2], v1[3]);
                    *(u32x4*)dp = w;
                }
    }
};
struct PEpiPlain {
    static constexpr bool PERM = true, AFTER_DRAIN = false;
    bf16_t* dst;
    __device__ __forceinline__ void operator()(const f32x4 (&acc)[2][2][4][2], const Unit& u, int wr, int wc, int fr, int fq) const {
        const int row0 = u.pm * BM + wr * 64 + fr, col0 = u.pn * BM + wc * 32 + 8 * fq;
#pragma unroll
        for (int ai = 0; ai < 2; ++ai)
#pragma unroll
            for (int m = 0; m < 4; ++m)
#pragma unroll
                for (int bj = 0; bj < 2; ++bj) {
                    const f32x4 v0 = acc[ai][bj][m][0], v1 = acc[ai][bj][m][1];
                    u32x4 w; w.x = cvt_pk_bf16(v0[0], v0[1]); w.y = cvt_pk_bf16(v0[2], v0[3]); w.z = cvt_pk_bf16(v1[0], v1[1]); w.w = cvt_pk_bf16(v1[2], v1[3]);
                    *(u32x4*)(dst + (size_t)(row0 + ai * HALF + m * 16) * 2048 + col0 + bj * HALF) = w;
                }
    }
};
struct RwkvOrder {
    int G, c;
    __device__ bool next(int i, Unit& u) const {
        const int L = i * G + ((c & 7) * (G >> 3) + (c >> 3));
        if (L >= 864) return false;
        if (L < 768) { const int which = L >> 8, r = L & 255; u.pm = which * 32 + (r >> 3); u.pn = which * 8 + (r & 7); }
        else { const int r = L - 768, which = 3 + (r >> 5); u.pm = which * 32 + (r & 31); u.pn = 32 + (which - 3); }
        return true;
    }
    __device__ __forceinline__ void a_ready(const Unit&) const {}
    __device__ __forceinline__ void done(const Unit&) const {}
};
}

struct ConvJob { const float* src; bf16_t* dst; int ldn, Kreal, Nreal, k0, n0, ldk, mode; };
constexpr int CONV_LDS = 64 * 132 * 4;
__device__ __forceinline__ void conv_load(const int tid, const ConvJob& j, f32x4 (&w)[4]) {
    const int kq = tid >> 5, nc = (tid & 31) * 4;
#pragma unroll
    for (int i = 0; i < 4; ++i) {
        const int k = j.k0 + kq * 4 + i;
        w[i] = (f32x4){0.f, 0.f, 0.f, 0.f};
        if (k < j.Kreal && j.n0 + nc < j.Nreal) w[i] = *(const f32x4*)(j.src + (size_t)k * j.ldn + j.n0 + nc);
    }
}
__device__ __forceinline__ void conv_stage(const int tid, LAS char* lb, const f32x4 (&w)[4]) {
    const int kq = tid >> 5, nc = (tid & 31) * 4;
#pragma unroll
    for (int i = 0; i < 4; ++i) *(LAS f32x4*)(lb + ((kq * 4 + i) * 132 + nc) * 4) = w[i];
}
__device__ __forceinline__ void conv_finish(const int tid, const LAS char* lb, const ConvJob& j) {
    const int n = tid >> 2, part = tid & 3;
    float w[16];
#pragma unroll
    for (int i = 0; i < 16; ++i) w[i] = *(const LAS float*)(lb + ((part * 16 + i) * 132 + n) * 4);
    u32x4 o0, o1;
    o0.x = pk2(w[0], w[1]); o0.y = pk2(w[2], w[3]); o0.z = pk2(w[4], w[5]); o0.w = pk2(w[6], w[7]);
    o1.x = pk2(w[8], w[9]); o1.y = pk2(w[10], w[11]); o1.z = pk2(w[12], w[13]); o1.w = pk2(w[14], w[15]);
    if (j.mode == 3) {
        const int nn = j.n0 + n, kk = j.k0 + part * 16;
        bf16_t* dp = j.dst + ((((size_t)(nn >> 4) * 4 + (kk >> 5)) * 64 + ((kk >> 3) & 3) * 16 + (nn & 15)) * 8);
        *(u32x4*)dp = o0; *(u32x4*)(dp + 128) = o1;
    } else {
        bf16_t* dp = j.dst + (size_t)(j.n0 + n) * j.ldk + j.k0 + part * 16;
        *(u32x4*)dp = o0; *(u32x4*)(dp + 8) = o1;
    }
}
__device__ __forceinline__ ConvJob conv_decode(CPar& p, int id) {
    unsigned char* ws = p.ws;
    if (id < 1536) { const int kt = id / 48, nt = id % 48; return ConvJob{p.in[4], (bf16_t*)(ws + WS_WQKV), 3 * D, D, 3 * D, kt * 64, nt * 128, D, 0}; }
    id -= 1536;
    if (id < 2560) {
        const int w = id / 512, r = id % 512, kt = r / 16, nt = r % 16;
        const float* src = w == 0 ? p.in[7] : w == 1 ? p.in[10] : w == 2 ? p.in[11] : w == 3 ? p.in[12] : p.in[13];
        const size_t off = w == 0 ? WS_WONA : w == 1 ? WS_WR : w == 2 ? WS_WK : w == 3 ? WS_WV : WS_WORW;
        return ConvJob{src, (bf16_t*)(ws + off), D, D, D, kt * 64, nt * 128, D, 0};
    }
    id -= 2560;
    if (id < 128) {
        const int which = id / 64, r = id % 64, z = r / 32, kt = r % 32;
        const float* src = (which == 0 ? p.in[15] : p.in[18]) + (size_t)z * D * 96;
        bf16_t* dst = (bf16_t*)(ws + (which == 0 ? WS_W1T : WS_A1T)) + (size_t)z * 128 * D;
        return ConvJob{src, dst, 96, D, 96, kt * 64, 0, D, 0};
    }
    id -= 128;
    if (id < 64) { const int kt = id / 2, nt = id % 2; return ConvJob{p.in[20], (bf16_t*)(ws + WS_G1T), 256, D, 256, kt * 64, nt * 128, D, 0}; }
    id -= 64;
    if (id < 128) {
        const int which = id / 64, r = id % 64, z = r / 32, r2 = r % 32, kt = r2 / 16, nt = r2 % 16;
        const float* src = (which == 0 ? p.in[16] : p.in[19]) + (size_t)z * 96 * D;
        bf16_t* dst = (bf16_t*)(ws + (which == 0 ? WS_W2T : WS_A2T)) + (size_t)z * D * 128;
        return ConvJob{src, dst, D, 96, D, kt * 64, nt * 128, 128, 3};
    }
    id -= 128;
    const int kt = id / 16, nt = id % 16;
    return ConvJob{p.in[21], (bf16_t*)(ws + WS_G2T), D, 256, D, kt * 64, nt * 128, 256, 0};
}
constexpr int N_CONV_JOBS = 1536 + 2560 + 128 + 64 + 128 + 64;

__device__ __forceinline__ void rms_row_bf16(const f32x4 (&x)[8], const LAS float* g, bf16_t* __restrict__ dst, int lane) {
    float ss = 0.f;
#pragma unroll
    for (int j = 0; j < 8; ++j) ss += x[j][0] * x[j][0] + x[j][1] * x[j][1] + x[j][2] * x[j][2] + x[j][3] * x[j][3];
    ss = wave_sum(ss);
    const float inv = rsqrtf(ss * (1.f / D) + 1e-6f);
#pragma unroll
    for (int j = 0; j < 8; ++j) {
        const f32x4 gv = *(const LAS f32x4*)(g + (j * 64 + lane) * 4);
        u32x2 o; o.x = pk2(x[j][0] * inv * gv[0], x[j][1] * inv * gv[1]); o.y = pk2(x[j][2] * inv * gv[2], x[j][3] * inv * gv[3]);
        *(u32x2*)(dst + (j * 64 + lane) * 4) = o;
    }
}

__device__ __forceinline__ void ph_prologue(CPar& p, LAS char* lds) {
    const int tid = otid();
    {
        int id = blockIdx.x, buf = 0;
        ConvJob cur{}; f32x4 w[4];
        if (id < N_CONV_JOBS) { cur = conv_decode(p, id); conv_load(tid, cur, w); }
        for (; id < N_CONV_JOBS; id += gridDim.x) {
            LAS char* lb = lds + buf * CONV_LDS;
            conv_stage(tid, lb, w);
            __syncthreads();
            ConvJob nxt = cur;
            if (id + (int)gridDim.x < N_CONV_JOBS) { nxt = conv_decode(p, id + gridDim.x); conv_load(tid, nxt, w); }
            conv_finish(tid, lb, cur);
            cur = nxt; buf ^= 1;
        }
    }
    {
        float* rgf = (float*)(p.ws + WS_RGF); float* ref = (float*)(p.ws + WS_REF);
        for (int i = blockIdx.x * NTHR + tid; i < 2 * 8 * 4 * 64; i += gridDim.x * NTHR) {
            const int ln = i & 63, c = (i >> 6) & 3, j = (i >> 8) & 7, layer = i >> 11, d = (j * 64 + ln) * 4 + c;
            *(f32x4*)(rgf + (size_t)i * 4) = *(const f32x4*)(p.in[27] + ((size_t)layer * D + d) * 4);
        }
        for (int i = blockIdx.x * NTHR + tid; i < 2 * 4 * 8 * 4 * 2 * 64; i += gridDim.x * NTHR) {
            const int ln = i & 63, hf = (i >> 6) & 1, c = (i >> 7) & 3, j = (i >> 9) & 7, gq = (i >> 12) & 3, layer = i >> 14, d = (j * 64 + ln) * 4 + c;
            *(f32x4*)(ref + (size_t)i * 4) = *(const f32x4*)(p.in[29] + (((size_t)layer * 4 + gq) * D + d) * 8 + hf * 4);
        }
    }
    const int lane = tid & 63, gw = blockIdx.x * 8 + (tid >> 6), nw = gridDim.x * 8;
    bf16_t* hn = (bf16_t*)(p.ws + WS_HN);
    __syncthreads();
    LAS float* lg = (LAS float*)lds;
    for (int i = tid; i < D / 4; i += NTHR) *(LAS f32x4*)(lg + i * 4) = *(const f32x4*)(p.in[1] + i * 4);
    __syncthreads();
    f32x4 x[8], xn[8];
    if (gw < T) {
#pragma unroll
        for (int j = 0; j < 8; ++j) x[j] = *(const f32x4*)(p.in[0] + (size_t)gw * D + (j * 64 + lane) * 4);
    }
    for (int t = gw; t < T; t += nw) {
        const int tn = t + nw < T ? t + nw : t;
#pragma unroll
        for (int j = 0; j < 8; ++j) xn[j] = *(const f32x4*)(p.in[0] + (size_t)tn * D + (j * 64 + lane) * 4);
        rms_row_bf16(x, lg, hn + (size_t)t * D, lane);
#pragma unroll
        for (int j = 0; j < 8; ++j) x[j] = xn[j];
    }
}

__device__ __forceinline__ void ph_qkv(CPar& p, LAS char* lds) {
    const int tid = otid();
    const bf16_t* hn = (const bf16_t*)(p.ws + WS_HN); const bf16_t* w = (const bf16_t*)(p.ws + WS_WQKV);
    {
        pg8::Gemm g{hn, w, T, 2 * D, D}; pg8::StaticOrder S; S.init(T, 2 * D, (int)gridDim.x, (int)blockIdx.x);
        pg8::PEpiQK E{(bf16_t*)(p.ws + WS_Q), (bf16_t*)(p.ws + WS_K), p.in[5]};
        pg8::gemm_phase<pg8::PEpiQK, pg8::StaticOrder, true, true>(tid, (LAS unsigned char*)lds, g, S, E);
    }
    {
        pg8::Gemm g{w + (size_t)2 * D * D, hn, D, T, D}; pg8::StaticOrder S; S.init(D, T, (int)gridDim.x, (int)blockIdx.x);
        pg8::PEpiVT E{(bf16_t*)(p.ws + WS_VT), p.in[5] + 2 * D};
        pg8::gemm_phase<pg8::PEpiVT, pg8::StaticOrder, true, true>(tid, (LAS unsigned char*)lds, g, S, E);
    }
}

template <int OFF>
__device__ __forceinline__ void attn_pair(const int lane, const bf16_t* __restrict__ Q, const bf16_t* __restrict__ Kp, const bf16_t* __restrict__ Vt, bf16_t* __restrict__ AO,
                                          const LAS float* rb, const int r0, const int h, const int cb, const int rs0) {
    constexpr int NR = 8 + OFF;
    const int qi = lane & 15, g = lane >> 4;
    int bs = cb * 16 - 8; bs = bs < 0 ? 0 : (bs > 32 ? 32 : bs);
    const int qc = cb * 16 + qi;
    int wsx = qc - 8; wsx = wsx < 0 ? 0 : (wsx > 48 ? 48 : wsx);
    const size_t tq = (size_t)r0 * GW + qc;
    bf16x8 qf[2][2];
#pragma unroll
    for (int q = 0; q < 2; ++q) {
        qf[q][0] = *(const bf16x8*)(Q + (tq + q * GW) * D + h * HD + 8 * g);
        qf[q][1] = *(const bf16x8*)(Q + (tq + q * GW) * D + h * HD + 32 + 8 * g);
    }
    f32x4 s[2][8][2];
#pragma unroll
    for (int i = 0; i < NR; ++i)
#pragma unroll
        for (int tt = 0; tt < 2; ++tt) {
            const bf16_t* kp = Kp + ((((((size_t)((rs0 + i) * 32 + h) * 8 + (bs >> 3) + (qi >> 2)) * 2 + tt) * 2) * 4 + (qi & 3)) * 4 + g) * 8;
            const bf16x8 kf0 = *(const bf16x8*)kp;
            const bf16x8 kf1 = *(const bf16x8*)(kp + 128);
            if (i < 8) {
                f32x4 a = {0.f, 0.f, 0.f, 0.f};
                a = __builtin_amdgcn_mfma_f32_16x16x32_bf16(kf0, qf[0][0], a, 0, 0, 0);
                a = __builtin_amdgcn_mfma_f32_16x16x32_bf16(kf1, qf[0][1], a, 0, 0, 0);
                s[0][i][tt] = a;
            }
            if (i >= OFF) {
                f32x4 a = {0.f, 0.f, 0.f, 0.f};
                a = __builtin_amdgcn_mfma_f32_16x16x32_bf16(kf0, qf[1][0], a, 0, 0, 0);
                a = __builtin_amdgcn_mfma_f32_16x16x32_bf16(kf1, qf[1][1], a, 0, 0, 0);
                s[1][i - OFF][tt] = a;
            }
        }
    int relx[2][4]; bool okc[2][4];
#pragma unroll
    for (int tt = 0; tt < 2; ++tt)
#pragma unroll
        for (int e = 0; e < 4; ++e) {
            const int kcol = bs + 8 * g + 4 * tt + e;
            int rel = kcol - qc; rel = rel < -15 ? -15 : (rel > 15 ? 15 : rel);
            relx[tt][e] = rel + 15; okc[tt][e] = (kcol >= wsx) && (kcol < wsx + 16);
        }
    float inv[2];
    u32x4 pw[2][8];
#pragma unroll
    for (int q = 0; q < 2; ++q) {
        float mx = -1e30f;
#pragma unroll
        for (int j = 0; j < 8; ++j) {
            const int ri = (rs0 + q * OFF + j) - (r0 + q) + 7;
#pragma unroll
            for (int tt = 0; tt < 2; ++tt)
#pragma unroll
                for (int e = 0; e < 4; ++e) {
                    const float bv = rb[ri * 31 + relx[tt][e]];
                    const float v = okc[tt][e] ? s[q][j][tt][e] + bv : -1e30f;
                    s[q][j][tt][e] = v; mx = fmaxf(mx, v);
                }
        }
        mx = fmaxf(mx, __shfl_xor(mx, 16)); mx = fmaxf(mx, __shfl_xor(mx, 32));
        float sum = 0.f;
#pragma unroll
        for (int j = 0; j < 8; ++j) {
            float pv[2][4];
#pragma unroll
            for (int tt = 0; tt < 2; ++tt)
#pragma unroll
                for (int e = 0; e < 4; ++e) { pv[tt][e] = __expf(s[q][j][tt][e] - mx); sum += pv[tt][e]; }
            pw[q][j].x = pk2(pv[0][0], pv[0][1]); pw[q][j].y = pk2(pv[0][2], pv[0][3]); pw[q][j].z = pk2(pv[1][0], pv[1][1]); pw[q][j].w = pk2(pv[1][2], pv[1][3]);
        }
        sum += __shfl_xor(sum, 16); sum += __shfl_xor(sum, 32);
        inv[q] = 1.f / sum;
    }
    f32x4 o[2][4];
#pragma unroll
    for (int q = 0; q < 2; ++q)
#pragma unroll
        for (int dt = 0; dt < 4; ++dt) o[q][dt] = (f32x4){0.f, 0.f, 0.f, 0.f};
#pragma unroll
    for (int i0 = 0; i0 < NR; i0 += 3) {
        u32x4 va[3][4];
#pragma unroll
        for (int ii = 0; ii < 3; ++ii)
            if (i0 + ii < NR) {
                const bf16_t* vp = Vt + (((size_t)((rs0 + i0 + ii) * 32 + h) * 8 + (bs >> 3) + g) * 64 + qi) * 8;
#pragma unroll
                for (int dt = 0; dt < 4; ++dt) va[ii][dt] = *(const u32x4*)(vp + dt * 128);
            }
#pragma unroll
        for (int ii = 0; ii < 3; ++ii)
            if (i0 + ii < NR) {
                const int i = i0 + ii;
                if (i < 8) {
                    const bf16x8 pf = __builtin_bit_cast(bf16x8, pw[0][i]);
#pragma unroll
                    for (int dt = 0; dt < 4; ++dt) o[0][dt] = __builtin_amdgcn_mfma_f32_16x16x32_bf16(__builtin_bit_cast(bf16x8, va[ii][dt]), pf, o[0][dt], 0, 0, 0);
                }
                if (i >= OFF) {
                    const bf16x8 pf = __builtin_bit_cast(bf16x8, pw[1][i - OFF]);
#pragma unroll
                    for (int dt = 0; dt < 4; ++dt) o[1][dt] = __builtin_amdgcn_mfma_f32_16x16x32_bf16(__builtin_bit_cast(bf16x8, va[ii][dt]), pf, o[1][dt], 0, 0, 0);
                }
            }
    }
#pragma unroll
    for (int q = 0; q < 2; ++q)
#pragma unroll
        for (int dt = 0; dt < 4; ++dt) {
            u32x2 ov; ov.x = pk2(o[q][dt][0] * inv[q], o[q][dt][1] * inv[q]); ov.y = pk2(o[q][dt][2] * inv[q], o[q][dt][3] * inv[q]);
            *(u32x2*)(AO + (tq + q * GW) * D + h * HD + dt * 16 + 4 * g) = ov;
        }
}
__device__ __forceinline__ void ph_attn(CPar& p, LAS char* lds) {
    const int tid = otid(), lane = tid & 63, gw = blockIdx.x * 8 + __builtin_amdgcn_readfirstlane(tid >> 6), nw = gridDim.x * 8;
    const bf16_t* Q = (const bf16_t*)(p.ws + WS_Q); const bf16_t* Kp = (const bf16_t*)(p.ws + WS_K); const bf16_t* Vt = (const bf16_t*)(p.ws + WS_VT);
    bf16_t* AO = (bf16_t*)(p.ws + WS_AO);
    LAS float* rpbs = (LAS float*)lds;
    for (int i = tid; i < NH * 15 * 31; i += NTHR) rpbs[i] = p.in[6][i];
    __syncthreads();
    for (int u = gw; u < (ROWS / 2) * NH * 4; u += nw) {
        const int cb = u & 3, h = (u >> 2) & 31, r0 = (u >> 7) * 2;
        int rs0 = r0 - 4; rs0 = rs0 < 0 ? 0 : (rs0 > ROWS - 8 ? ROWS - 8 : rs0);
        int rs1 = r0 - 3; rs1 = rs1 < 0 ? 0 : (rs1 > ROWS - 8 ? ROWS - 8 : rs1);
        const LAS float* rb = rpbs + h * 15 * 31;
        if (rs1 != rs0) attn_pair<1>(lane, Q, Kp, Vt, AO, rb, r0, h, cb, rs0);
        else attn_pair<0>(lane, Q, Kp, Vt, AO, rb, r0, h, cb, rs0);
    }
}

__device__ __forceinline__ void ph_oproj(CPar& p, LAS char* lds, const bf16_t* A, const bf16_t* W, const float* bias, const float* src, float* dst) {
    const int tid = otid();
    pg8::Gemm g{A, W, T, D, D}; pg8::StaticOrder S; S.init(T, D, (int)gridDim.x, (int)blockIdx.x);
    pg8::PEpiResid E{src, dst, bias};
    pg8::gemm_phase<pg8::PEpiResid, pg8::StaticOrder, true, true>(tid, (LAS unsigned char*)lds, g, S, E);
}

__device__ __forceinline__ void ph_router(CPar& p, LAS char* lds, const float* __restrict__ h, int layer) {
    const int tid = otid(), lane = tid & 63, gw = blockIdx.x * 8 + (tid >> 6), nw = gridDim.x * 8;
    bf16_t* hn = (bf16_t*)(p.ws + WS_HN);
    const float* brg = p.in[28] + layer * 4;
    LAS float* g = (LAS float*)lds; LAS float* wrg = (LAS float*)(lds + 8192);
    {
        const float* gsrc = p.in[2] + layer * D; const float* wsrc = (const float*)(p.ws + WS_RGF) + (size_t)layer * 8 * 4 * 64 * 4;
        for (int i = tid; i < D / 4; i += NTHR) *(LAS f32x4*)(g + i * 4) = *(const f32x4*)(gsrc + i * 4);
        for (int i = tid; i < 8 * 4 * 64; i += NTHR) *(LAS f32x4*)(wrg + i * 4) = *(const f32x4*)(wsrc + i * 4);
        __syncthreads();
    }
    const float* wre = (const float*)(p.ws + WS_REF) + (size_t)layer * 4 * 8 * 4 * 2 * 64 * 4; const float* bre = p.in[30] + layer * 32;
    unsigned* cnt = (unsigned*)(p.ws + WS_CTL) + (layer ? CW_CNT1 : CW_CNT0);
    int* list = (int*)(p.ws + WS_LIST) + (size_t)layer * NEXP * T;
    float* cw = (float*)(p.ws + WS_CW) + (size_t)layer * 2 * T;
    for (int t0 = gw; t0 < T; t0 += 2 * nw) {
        const float* hrow[2]; float inv[2];
#pragma unroll
        for (int k = 0; k < 2; ++k) hrow[k] = h + (size_t)(t0 + k * nw) * D;
        {
            float ss[2] = {0.f, 0.f};
#pragma unroll 2
            for (int j = 0; j < 8; ++j)
#pragma unroll
                for (int k = 0; k < 2; ++k) { const f32x4 xv = *(const f32x4*)(hrow[k] + (j * 64 + lane) * 4); ss[k] += xv[0] * xv[0] + xv[1] * xv[1] + xv[2] * xv[2] + xv[3] * xv[3]; }
#pragma unroll
            for (int k = 0; k < 2; ++k) inv[k] = rsqrtf(wave_sum(ss[k]) * (1.f / D) + 1e-6f);
        }
        float gl[2][4];
#pragma unroll
        for (int k = 0; k < 2; ++k)
#pragma unroll
            for (int e = 0; e < 4; ++e) gl[k][e] = 0.f;
#pragma unroll 1
        for (int j = 0; j < 8; ++j) {
            const int d0 = (j * 64 + lane) * 4;
            const f32x4 gv = *(const LAS f32x4*)(g + d0);
            f32x4 wr4[4];
#pragma unroll
            for (int c = 0; c < 4; ++c) wr4[c] = *(const LAS f32x4*)(wrg + ((j * 4 + c) * 64 + lane) * 4);
#pragma unroll
            for (int k = 0; k < 2; ++k) {
                f32x4 xv = *(const f32x4*)(hrow[k] + d0);
                xv[0] *= inv[k] * gv[0]; xv[1] *= inv[k] * gv[1]; xv[2] *= inv[k] * gv[2]; xv[3] *= inv[k] * gv[3];
                u32x2 o; o.x = pk2(xv[0], xv[1]); o.y = pk2(xv[2], xv[3]);
                *(u32x2*)(hn + (size_t)(t0 + k * nw) * D + d0) = o;
#pragma unroll
                for (int c = 0; c < 4; ++c) { gl[k][0] += xv[c] * wr4[c][0]; gl[k][1] += xv[c] * wr4[c][1]; gl[k][2] += xv[c] * wr4[c][2]; gl[k][3] += xv[c] * wr4[c][3]; }
            }
        }
        int gi[2]; float gwt[2];
#pragma unroll
        for (int k = 0; k < 2; ++k) {
            const float l0 = wave_sum(gl[k][0]) + brg[0], l1 = wave_sum(gl[k][1]) + brg[1], l2 = wave_sum(gl[k][2]) + brg[2], l3 = wave_sum(gl[k][3]) + brg[3];
            int gq = 0; float gm = l0;
            if (l1 > gm) { gm = l1; gq = 1; }
            if (l2 > gm) { gm = l2; gq = 2; }
            if (l3 > gm) { gm = l3; gq = 3; }
            gwt[k] = 1.f / (__expf(l0 - gm) + __expf(l1 - gm) + __expf(l2 - gm) + __expf(l3 - gm));
            gi[k] = __builtin_amdgcn_readfirstlane(gq);
        }
        float el[2][8];
#pragma unroll
        for (int k = 0; k < 2; ++k)
#pragma unroll
            for (int e = 0; e < 8; ++e) el[k][e] = 0.f;
#pragma unroll 1
        for (int j = 0; j < 8; ++j) {
            const int d0 = (j * 64 + lane) * 4;
            const f32x4 gv = *(const LAS f32x4*)(g + d0);
#pragma unroll
            for (int k = 0; k < 2; ++k) {
                const float* we = wre + (size_t)gi[k] * 8 * 4 * 2 * 64 * 4;
                f32x4 xv = *(const f32x4*)(hrow[k] + d0);
                xv[0] *= inv[k] * gv[0]; xv[1] *= inv[k] * gv[1]; xv[2] *= inv[k] * gv[2]; xv[3] *= inv[k] * gv[3];
#pragma unroll
                for (int c = 0; c < 4; ++c) {
                    const f32x4 w0 = *(const f32x4*)(we + ((size_t)((j * 4 + c) * 2) * 64 + lane) * 4), w1 = *(const f32x4*)(we + ((size_t)((j * 4 + c) * 2 + 1) * 64 + lane) * 4);
                    el[k][0] += xv[c] * w0[0]; el[k][1] += xv[c] * w0[1]; el[k][2] += xv[c] * w0[2]; el[k][3] += xv[c] * w0[3];
                    el[k][4] += xv[c] * w1[0]; el[k][5] += xv[c] * w1[1]; el[k][6] += xv[c] * w1[2]; el[k][7] += xv[c] * w1[3];
                }
            }
        }
#pragma unroll
        for (int k = 0; k < 2; ++k) {
            const int t = t0 + k * nw;
            int i1 = 0; float m1 = -1e30f;
#pragma unroll
            for (int e = 0; e < 8; ++e) { el[k][e] = wave_sum(el[k][e]) + bre[gi[k] * 8 + e]; if (el[k][e] > m1) { m1 = el[k][e]; i1 = e; } }
            int i2 = 0; float m2 = -1e30f;
#pragma unroll
            for (int e = 0; e < 8; ++e) { if (e != i1 && el[k][e] > m2) { m2 = el[k][e]; i2 = e; } }
            const float e21 = __expf(m2 - m1);
            const float w1 = 1.f / (1.f + e21), w2 = e21 / (1.f + e21);
            if (lane == 0) {
                const int ea = gi[k] * 8 + i1, eb = gi[k] * 8 + i2;
                const unsigned pa = atomicAdd(&cnt[ea], 1u); list[ea * T + pa] = 2 * t; cw[2 * t] = gwt[k] * w1;
                const unsigned pb = atomicAdd(&cnt[eb], 1u); list[eb * T + pb] = 2 * t + 1; cw[2 * t + 1] = gwt[k] * w2;
            }
        }
    }
}

__device__ __forceinline__ void moe_prefix(const int tid, CPar& p, LAS char* lds, int layer) {
    const unsigned* cnt = (const unsigned*)(p.ws + WS_CTL) + (layer ? CW_CNT1 : CW_CNT0);
    LAS int* pref = (LAS int*)(lds + LDS_PREF);
    __syncthreads();
    if (tid == 0) {
        LAS int* te = (LAS int*)(lds + LDS_TILE_E);
        int acc = 0;
        for (int e = 0; e < NEXP; ++e) { pref[e] = acc; const int n = (int)((cnt[e] + 255u) >> 8); for (int k = 0; k < n; ++k) te[acc + k] = e; acc += n; }
        pref[NEXP] = acc;
    }
    __syncthreads();
}
__device__ __forceinline__ void ph_moe(CPar& p, LAS char* lds, int layer) {
    const int tid0 = otid();
    moe_prefix(tid0, p, lds, layer);
    LAS int* pref = (LAS int*)(lds + LDS_PREF);
    LAS int* curp = (LAS int*)(lds + LDS_MOEQ);
    const unsigned* cnt = (const unsigned*)(p.ws + WS_CTL) + (layer ? CW_CNT1 : CW_CNT0);
    gu32* qh = (gu32*)((unsigned*)(p.ws + WS_CTL) + CW_MOEQ + layer * 64);
    gu32* mtc0 = (gu32*)((unsigned*)(p.ws + WS_CTL) + CW_MOEMT + layer * 4096);
    unsigned* tmo = (unsigned*)(p.ws + WS_CTL) + CW_BAR + XB_TMO;
    const int* list = (const int*)(p.ws + WS_LIST) + (size_t)layer * NEXP * T;
    const float* cw = (const float*)(p.ws + WS_CW) + (size_t)layer * 2 * T;
    const bf16_t* hn = (const bf16_t*)(p.ws + WS_HN);
    bf16_t* act = (bf16_t*)(p.ws + (layer ? WS_ACT1 : WS_ACT));
    const int ntile = pref[NEXP], ngu = ntile * 8, total = ntile * 24;
    if (tid0 == 0) curp[0] = (int)__hip_atomic_fetch_add(qh, 1u, __ATOMIC_RELAXED, __HIP_MEMORY_SCOPE_AGENT);
    __syncthreads();
    int cur = __builtin_amdgcn_readfirstlane(curp[0]);
    while (cur < total) {
        int tid = tid0; asm volatile("" : "+v"(tid));
        unsigned nxt = 0u;
        if (tid == 0) nxt = __hip_atomic_fetch_add(qh, 1u, __ATOMIC_RELAXED, __HIP_MEMORY_SCOPE_AGENT);
        if (cur < ngu) {
            const int mt = cur >> 3, j = cur & 7;
            const int e = ((LAS int*)(lds + LDS_TILE_E))[mt];
            const int lt = mt - pref[e];
            const int nvalid = min(256, (int)cnt[e] - lt * 256);
            const int* rows = list + e * T + lt * 256;
            const int rho0 = (tid & 31) * 4;
            const float* wsrc = ((rho0 >> 5) & 1 ? p.in[32] : p.in[31]) + (size_t)(layer * NEXP + e) * D * FF + j * 64 + (rho0 >> 6) * 32 + (rho0 & 31);
            EpiMoeGU3 ep{act, cw, rows, nvalid, j * 64, lds, tid, mtc0 + mt * 32};
            gemm_tile_moe(tid, lds, hn, D, rows, nvalid, 1, wsrc, FF, D, ep);
        } else {
            const int d = cur - ngu, mt = d >> 4, pn = d & 15;
            if ((tid >> 6) == 0) {
                gu32* c = mtc0 + mt * 32;
                unsigned sp = 0u;
                while ((unsigned)__builtin_amdgcn_readfirstlane(__hip_atomic_load(c, __ATOMIC_RELAXED, __HIP_MEMORY_SCOPE_AGENT)) < 64u) {
                    __builtin_amdgcn_s_sleep(1);
                    if ((++sp & 255u) == 0u) { if (xb_ld(tmo)) break; if (sp > XB_SPIN_CAP) { atomicAdd(tmo, 1u); break; } }
                }
                __builtin_amdgcn_fence(__ATOMIC_ACQUIRE, "agent");
                asm volatile("s_waitcnt vmcnt(0)" ::: "memory");
            }
            __syncthreads();
            const int e = ((LAS int*)(lds + LDS_TILE_E))[mt];
            const int lt = mt - pref[e];
            const int nvalid = min(256, (int)cnt[e] - lt * 256);
            const int* rows = list + e * T + lt * 256;
            const float* wsrc = p.in[33] + (size_t)(layer * NEXP + e) * FF * D + pn * 128 + (tid & 31) * 4;
            EpiMoeD2 ep{(bf16_t*)(p.ws + WS_Y), rows, nvalid, pn * 128, lds, tid};
            gemm_tile_moe(tid, lds, act, FF, rows, nvalid, 0, wsrc, D, FF, ep);
        }
        if (tid == 0) curp[0] = (int)nxt;
        __syncthreads();
        cur = __builtin_amdgcn_readfirstlane(curp[0]);
    }
}

__device__ __forceinline__ void ph_combine_mix(CPar& p, LAS char* lds) {
    const int tid = otid(), lane = tid & 63, gw = blockIdx.x * 8 + (tid >> 6), nw = gridDim.x * 8;
    const float* h1 = p.out; float* h2 = (float*)(p.ws + WS_HB);
    const bf16_t* y = (const bf16_t*)(p.ws + WS_Y); const float* g = p.in[1] + D; bf16_t* mixo = (bf16_t*)(p.ws + WS_MIX); const float* mix = p.in[9];
    LAS float* lg = (LAS float*)lds; LAS float* lmix = (LAS float*)(lds + 8192);
    for (int i = tid; i < D / 4; i += NTHR) *(LAS f32x4*)(lg + i * 4) = *(const f32x4*)(g + i * 4);
    for (int i = tid; i < 6 * D / 4; i += NTHR) *(LAS f32x4*)(lmix + i * 4) = *(const f32x4*)(mix + i * 4);
    __syncthreads();
#define CM_ROW(dst, r, own) do { const int r_ = (r); \
        if (r_ < 0 || r_ >= T) { _Pragma("unroll") for (int j = 0; j < 8; ++j) dst[j] = (f32x4){0.f, 0.f, 0.f, 0.f}; } \
        else { float ss = 0.f; \
            _Pragma("unroll") for (int j = 0; j < 8; ++j) { const int d0 = (j * 64 + lane) * 4; \
                f32x4 x = *(const f32x4*)(h1 + (size_t)r_ * D + d0); \
                const u32x2 a = *(const u32x2*)(y + (size_t)(2 * r_) * D + d0), bq = *(const u32x2*)(y + (size_t)(2 * r_ + 1) * D + d0); \
                x[0] += bflo(a.x) + bflo(bq.x); x[1] += bfhi(a.x) + bfhi(bq.x); x[2] += bflo(a.y) + bflo(bq.y); x[3] += bfhi(a.y) + bfhi(bq.y); \
                if (own) *(f32x4*)(h2 + (size_t)r_ * D + d0) = x; \
                ss += x[0] * x[0] + x[1] * x[1] + x[2] * x[2] + x[3] * x[3]; dst[j] = x; } \
            const float inv = rsqrtf(wave_sum(ss) * (1.f / D) + 1e-6f); \
            _Pragma("unroll") for (int j = 0; j < 8; ++j) { const f32x4 gv = *(const LAS f32x4*)(lg + (j * 64 + lane) * 4); dst[j] = dst[j] * gv * inv; } } } while (0)
    for (int run = gw; run < T / 4; run += nw) {
        const int t0 = run * 4;
        f32x4 pv[8], cu[8], nx[8];
        CM_ROW(pv, t0 - 1, false);
        CM_ROW(cu, t0, true);
#pragma unroll 1
        for (int i = 0; i < 4; ++i) {
            const int t = t0 + i;
            CM_ROW(nx, t + 1, i < 3);
            unsigned mo = 8192u; asm volatile("" : "+s"(mo));
            const LAS float* mx = (const LAS float*)(lds + mo);
#pragma unroll
            for (int j = 0; j < 8; ++j) {
                const int d0 = (j * 64 + lane) * 4;
                const f32x4 xx = (pv[j] + nx[j]) * 0.5f - cu[j];
#pragma unroll
                for (int m = 0; m < 6; ++m) {
                    const f32x4 mv = *(const LAS f32x4*)(mx + m * D + d0);
                    const f32x4 o = cu[j] + xx * mv;
                    u32x2 ov; ov.x = pk2(o[0], o[1]); ov.y = pk2(o[2], o[3]);
                    const int slot = m == 1 ? 3 : (m == 2 ? 1 : (m == 3 ? 2 : m));
                    *(u32x2*)(mixo + ((size_t)slot * T + t) * D + d0) = ov;
                }
                pv[j] = cu[j]; cu[j] = nx[j];
            }
        }
    }
#undef CM_ROW
}
__device__ __forceinline__ void ph_rwkv_proj(CPar& p, LAS char* lds) {
    const int tid = otid();
    pg8::Gemm g{(const bf16_t*)(p.ws + WS_MIX), (const bf16_t*)(p.ws + WS_WR), 6 * T, 35 * 256, D};
    pg8::RwkvOrder S{(int)gridDim.x, (int)blockIdx.x};
    pg8::PEpiRwkv E{(bf16_t*)(p.ws + WS_R), (bf16_t*)(p.ws + WS_LW), (bf16_t*)(p.ws + WS_LA), (bf16_t*)(p.ws + WS_GL)};
    pg8::gemm_phase<pg8::PEpiRwkv, pg8::RwkvOrder, true, true>(tid, (LAS unsigned char*)lds, g, S, E);
}
__device__ __forceinline__ unsigned toff(int row, int col) { return (unsigned)(row * 128 + ((((col >> 3) ^ (row >> 1)) & 7) << 4) + (col & 7) * 2); }
constexpr unsigned T_AQ = 0, T_RQ = 8192, T_BK = 16384, T_KK = 24576, T_V = 32768, T_L = 40960, T_DL = 49152  ,
                   T_TII = 53248  , T_MAK = 55296, T_MRB = 63488, T_MRK = 71680, T_ZS = 79872,
                   T_W0A = T_AQ, T_W0B = T_MAK,
                   T_LIN = 40960, T_AS = 57344;
__device__ __forceinline__ f32x4 tile_mm(LAS char* lds, unsigned abase, unsigned bbase, int mblk, int nblk, int l15, int g, f32x4 acc, int nks) {
    for (int ks = 0; ks < nks; ++ks) {
        const bf16x8 a = *(const LAS bf16x8*)(lds + abase + toff(mblk * 16 + l15, ks * 32 + 8 * g));
        const bf16x8 b = *(const LAS bf16x8*)(lds + bbase + toff(nblk * 16 + l15, ks * 32 + 8 * g));
        acc = __builtin_amdgcn_mfma_f32_16x16x32_bf16(a, b, acc, 0, 0, 0);
    }
    return acc;
}
__device__ __forceinline__ void tile_st(LAS char* lds, unsigned base, int n, int m0, f32x4 v) {
    u32x2 o; o.x = pk2(v[0], v[1]); o.y = pk2(v[2], v[3]);
    *(LAS u32x2*)(lds + base + toff(n, m0)) = o;
}

typedef short v4i16_t __attribute__((ext_vector_type(4)));
__device__ __forceinline__ bf16x8 frag_row(LAS char* lds, unsigned base, int blk, int ks, int l15, int g) {
    return *(const LAS bf16x8*)(lds + base + toff(blk * 16 + l15, ks * 32 + 8 * g));
}
__device__ __forceinline__ bf16x8 frag_tr(LAS char* lds, unsigned base, int blk, int ks, int l15, int g) {
    const int q = l15 >> 2, pp = l15 & 3;
    const v4i16_t v0 = __builtin_amdgcn_ds_read_tr16_b64_v4i16((LAS v4i16_t*)(lds + base + toff(ks * 32 + 8 * g + q, blk * 16 + 4 * pp)));
    const v4i16_t v1 = __builtin_amdgcn_ds_read_tr16_b64_v4i16((LAS v4i16_t*)(lds + base + toff(ks * 32 + 8 * g + 4 + q, blk * 16 + 4 * pp)));
    return (bf16x8){v0[0], v0[1], v0[2], v0[3], v1[0], v1[1], v1[2], v1[3]};
}
template <bool ATR, bool BTR>
__device__ __forceinline__ f32x4 tile_mm2(LAS char* lds, unsigned abase, unsigned bbase, int mblk, int nblk, int l15, int g, f32x4 acc, int nks) {
    for (int ks = 0; ks < nks; ++ks) {
        const bf16x8 a = ATR ? frag_tr(lds, abase, mblk, ks, l15, g) : frag_row(lds, abase, mblk, ks, l15, g);
        const bf16x8 b = BTR ? frag_tr(lds, bbase, nblk, ks, l15, g) : frag_row(lds, bbase, nblk, ks, l15, g);
        acc = __builtin_amdgcn_mfma_f32_16x16x32_bf16(a, b, acc, 0, 0, 0);
    }
    return acc;
}

__device__ __forceinline__ void ph_gate(CPar& p, LAS char* lds) {
    const int tid = otid();
    pg8::Gemm g{(const bf16_t*)(p.ws + WS_GL), (const bf16_t*)(p.ws + WS_G2T), T, D, 256}; pg8::StaticOrder S; S.init(T, D, (int)gridDim.x, (int)blockIdx.x);
    pg8::PEpiPlain E{(bf16_t*)(p.ws + WS_G)};
    pg8::gemm_phase<pg8::PEpiPlain, pg8::StaticOrder, true, true>(tid, (LAS unsigned char*)lds, g, S, E);
    __syncthreads();
}
__device__ __forceinline__ void ph_scan_prep(CPar& p, LAS char* lds) {
    const int tid0 = otid(), wv = tid0 >> 6;
    const bf16_t* R = (const bf16_t*)(p.ws + WS_R); const bf16_t* K2 = (const bf16_t*)(p.ws + WS_K2); const bf16_t* V2 = (const bf16_t*)(p.ws + WS_V2);
    const float* k_k = p.in[22]; const float* k_a = p.in[23]; const float* r_k = p.in[24];
    for (int u = blockIdx.x; u < NH * 128; u += gridDim.x) {
        int tid = tid0; asm volatile("" : "+v"(tid));
        const int lane = tid & 63, l15 = lane & 15, g = lane >> 4;
        const int h = u & 31, m = u >> 5;
        {
            const int z = wv >> 2, nblk = wv & 3;
            LAS char* ldz = lds + z * T_ZS;
            LAS float* LIN = (LAS float*)(ldz + T_LIN); LAS float* AS = (LAS float*)(ldz + T_AS); LAS float* lendp = (LAS float*)(lds + LDS_SEG) + z * 64;
            bf16x8 afr[2][4][3], bfr[2][3];
            float bias[2];
#pragma unroll
            for (int isa = 0; isa < 2; ++isa) {
                const bf16_t* lsrc = (const bf16_t*)(p.ws + (isa ? WS_LA : WS_LW)) + (size_t)z * 512 * 4 * 64 * 8;
                const bf16_t* wsrc = (const bf16_t*)(p.ws + (isa ? WS_A2T : WS_W2T)) + (size_t)z * D * 128 + ((size_t)(h * 4 + nblk) * 4 * 64 + g * 16 + l15) * 8;
                bias[isa] = (isa ? p.in[17] : p.in[14])[z * D + h * HD + nblk * 16 + l15];
#pragma unroll
                for (int ks = 0; ks < 3; ++ks) bfr[isa][ks] = *(const bf16x8*)(wsrc + ks * 512);
#pragma unroll
                for (int mblk = 0; mblk < 4; ++mblk) {
                    const int tb = m * 4 + (z ? 3 - mblk : mblk), r15 = z ? 15 - l15 : l15;
#pragma unroll
                    for (int ks = 0; ks < 3; ++ks) afr[isa][mblk][ks] = *(const bf16x8*)(lsrc + (((size_t)tb * 4 + ks) * 64 + g * 16 + r15) * 8);
                }
            }
            float carry = 0.f;
#pragma unroll
            for (int mblk = 0; mblk < 4; ++mblk) {
                f32x4 accw = {0.f, 0.f, 0.f, 0.f}, acca = {0.f, 0.f, 0.f, 0.f};
#pragma unroll
                for (int ks = 0; ks < 3; ++ks) { accw = __builtin_amdgcn_mfma_f32_16x16x32_bf16(afr[0][mblk][ks], bfr[0][ks], accw, 0, 0, 0); acca = __builtin_amdgcn_mfma_f32_16x16x32_bf16(afr[1][mblk][ks], bfr[1][ks], acca, 0, 0, 0); }
                float o[4], oa[4];
#pragma unroll
                for (int e = 0; e < 4; ++e) {
                    oa[e] = sigmoidf_(acca[e] + bias[1]);
                    o[e] = -0.60653066f * sigmoidf_(accw[e] + bias[0]);
                }
                o[1] += o[0]; o[2] += o[1]; o[3] += o[2];
                const float tot = o[3];
                const float u1 = __shfl_up(tot, 16); const float s2 = tot + (g >= 1 ? u1 : 0.f);
                const float u2 = __shfl_up(s2, 32); const float incl = s2 + (g >= 2 ? u2 : 0.f);
                const float tt = __shfl(incl, 48 + l15);
                const float base = carry + incl - tot;
                carry += tt;
#pragma unroll
                for (int e = 0; e < 4; ++e) { LIN[(mblk * 16 + 4 * g + e) * 64 + nblk * 16 + l15] = o[e] + base; AS[(mblk * 16 + 4 * g + e) * 64 + nblk * 16 + l15] = oa[e]; }
            }
            if (g == 0) lendp[nblk * 16 + l15] = carry;
        }
        __syncthreads();
        {
            const int tau = tid >> 3, cg = tid & 7, c0 = h * HD + cg * 8;
            const int t = m * 64 + tau; const size_t o = (size_t)t * D + c0;
            const u32x4 kw = *(const u32x4*)(K2 + o), rw = *(const u32x4*)(R + o), vw = *(const u32x4*)(V2 + o);
            float kx[8], rx[8], kk[8], kac[8], rkc[8];
            float n2 = 0.f;
#pragma unroll
            for (int q4 = 0; q4 < 2; ++q4) {
                const f32x4 k4 = *(const f32x4*)(k_k + c0 + q4 * 4), ka4 = *(const f32x4*)(k_a + c0 + q4 * 4), rk4 = *(const f32x4*)(r_k + c0 + q4 * 4);
#pragma unroll
                for (int e = 0; e < 4; ++e) {
                    const int j = q4 * 4 + e; const unsigned kwj = kw[j >> 1], rwj = rw[j >> 1];
                    kx[j] = (j & 1) ? bfhi(kwj) : bflo(kwj); rx[j] = (j & 1) ? bfhi(rwj) : bflo(rwj);
                    kk[j] = kx[j] * k4[e]; n2 += kk[j] * kk[j]; kac[j] = ka4[e]; rkc[j] = rk4[e];
                }
            }
            n2 += __shfl_xor(n2, 1); n2 += __shfl_xor(n2, 2); n2 += __shfl_xor(n2, 4);
            const float rn = __builtin_amdgcn_rcpf(fmaxf(sqrtf(n2), 1e-12f));
#pragma unroll
            for (int j = 0; j < 8; ++j) kk[j] *= rn;
#pragma unroll
            for (int z = 0; z < 2; ++z) {
                LAS char* ldz = lds + z * T_ZS;
                LAS float* LIN = (LAS float*)(ldz + T_LIN); LAS float* AS = (LAS float*)(ldz + T_AS); LAS float* lendp = (LAS float*)(lds + LDS_SEG) + z * 64;
                LAS float* elend = (LAS float*)(lds + LDS_ELEND) + z * 64;
                float* sbon = (float*)(p.ws + WS_SBON) + (size_t)z * T * NH;
                const int sidx = z ? 63 - tau : tau;
                float lin[8], lex[8], av[8];
#pragma unroll
                for (int q4 = 0; q4 < 2; ++q4) {
                    const f32x4 a4 = *(const LAS f32x4*)(AS + sidx * 64 + cg * 8 + q4 * 4), l4 = *(const LAS f32x4*)(LIN + sidx * 64 + cg * 8 + q4 * 4);
                    f32x4 p4 = {0.f, 0.f, 0.f, 0.f};
                    if (sidx > 0) p4 = *(const LAS f32x4*)(LIN + (sidx - 1) * 64 + cg * 8 + q4 * 4);
#pragma unroll
                    for (int e = 0; e < 4; ++e) { av[q4 * 4 + e] = a4[e]; lin[q4 * 4 + e] = l4[e]; lex[q4 * 4 + e] = p4[e]; }
                }
                float kd[8], sb = 0.f;
#pragma unroll
                for (int j = 0; j < 8; ++j) { kd[j] = kx[j] * (1.f + (av[j] - 1.f) * kac[j]); sb += rx[j] * kd[j] * rkc[j]; }
                sb += __shfl_xor(sb, 1); sb += __shfl_xor(sb, 2); sb += __shfl_xor(sb, 4);
                if (cg == 0) sbon[(size_t)t * NH + h] = sb;
                float aq[8], rq[8], bk[8], kq[8];
#pragma unroll
                for (int j = 0; j < 8; ++j) {
                    const float b = kk[j] * av[j];
                    const float elin = __expf(lin[j]), elex = __expf(lex[j]), enl = __expf(-lin[j]);
                    aq[j] = -kk[j] * elex; bk[j] = b * enl; kq[j] = kd[j] * enl; rq[j] = rx[j] * elin;
                }
                const unsigned wo = toff(sidx, cg * 8);
                *(LAS u32x4*)(ldz + T_AQ + wo) = (u32x4){pk2(aq[0], aq[1]), pk2(aq[2], aq[3]), pk2(aq[4], aq[5]), pk2(aq[6], aq[7])};
                *(LAS u32x4*)(ldz + T_RQ + wo) = (u32x4){pk2(rq[0], rq[1]), pk2(rq[2], rq[3]), pk2(rq[4], rq[5]), pk2(rq[6], rq[7])};
                *(LAS u32x4*)(ldz + T_BK + wo) = (u32x4){pk2(bk[0], bk[1]), pk2(bk[2], bk[3]), pk2(bk[4], bk[5]), pk2(bk[6], bk[7])};
                *(LAS u32x4*)(ldz + T_KK + wo) = (u32x4){pk2(kq[0], kq[1]), pk2(kq[2], kq[3]), pk2(kq[4], kq[5]), pk2(kq[6], kq[7])};
                *(LAS u32x4*)(ldz + T_V + wo) = vw;
                if (tau == 0) {
#pragma unroll
                    for (int q4 = 0; q4 < 2; ++q4) { const f32x4 e4 = *(const LAS f32x4*)(lendp + cg * 8 + q4 * 4);
#pragma unroll
                        for (int e = 0; e < 4; ++e) elend[cg * 8 + q4 * 4 + e] = __expf(e4[e]); }
                }
            }
        }
        __syncthreads();
#pragma unroll
        for (int z = 0; z < 2; ++z) {
            LAS char* ldz = lds + z * T_ZS;
            const int nblk = wv & 3;
#pragma unroll
            for (int pid = 0; pid < 4; ++pid) {
                const unsigned ab = (pid & 1) ? T_KK : T_BK, bb = pid < 2 ? T_AQ : T_RQ;
                const unsigned db = pid == 0 ? T_L : (pid == 1 ? T_MAK : (pid == 2 ? T_MRB : T_MRK));
#pragma unroll
                for (int i = 0; i < 2; ++i) {
                    const int mblk = (wv >> 2) * 2 + i;
                    f32x4 acc = {0.f, 0.f, 0.f, 0.f};
                    if (mblk <= nblk) {
                        acc = tile_mm(ldz, ab, bb, mblk, nblk, l15, g, acc, 2);
                        const int n = nblk * 16 + l15, m0 = mblk * 16 + 4 * g;
#pragma unroll
                        for (int e = 0; e < 4; ++e) { const bool keep = pid < 2 ? (m0 + e < n) : (m0 + e <= n); acc[e] = keep ? acc[e] : 0.f; }
                        if (pid == 0 && mblk == nblk) *(LAS f32x4*)(ldz + T_DL + ((nblk * 16 + l15) * 16 + 4 * g) * 4) = acc;
                    }
                    tile_st(ldz, db, nblk * 16 + l15, mblk * 16 + 4 * g, acc);
                }
            }
        }
        __syncthreads();
        f32x4 xacc[2][4];
        const int wcol = (wv & 3) * 16 + l15;
#pragma unroll
        for (int z = 0; z < 2; ++z) {
            LAS char* ldz = lds + z * T_ZS;
            if (wv >= 4) {
#pragma unroll
                for (int sb = 0; sb < 4; ++sb) {
                    f32x4 acc = {0.f, 0.f, 0.f, 0.f};
                    xacc[z][sb] = tile_mm2<false, true>(ldz, T_MAK, T_V, sb, wv - 4, l15, g, acc, sb < 2 ? 1 : 2);
                }
            } else {
#pragma unroll
                for (int sb = 0; sb < 4; ++sb) {
                    const v4i16_t w = __builtin_amdgcn_ds_read_tr16_b64_v4i16((LAS v4i16_t*)(ldz + T_AQ + toff(sb * 16 + 4 * g + (l15 >> 2), (wv & 3) * 16 + 4 * (l15 & 3))));
                    xacc[z][sb] = (f32x4){bf2f((bf16_t)w[0]), bf2f((bf16_t)w[1]), bf2f((bf16_t)w[2]), bf2f((bf16_t)w[3])};
                }
            }
        }
        if (wv < 2) {
            LAS char* ldz = lds + wv * T_ZS;
            float tc[16];
#pragma unroll
            for (int r = 0; r < 16; ++r) {
                float v = (r == l15) ? 1.f : 0.f;
#pragma unroll
                for (int q4 = 0; q4 < (r + 3) / 4; ++q4) {
                    const f32x4 lr = *(const LAS f32x4*)(ldz + T_DL + ((g * 16 + r) * 16 + q4 * 4) * 4);
#pragma unroll
                    for (int e = 0; e < 4; ++e) if (q4 * 4 + e < r) v += lr[e] * tc[q4 * 4 + e];
                }
                tc[r] = v;
                *(LAS bf16_t*)(ldz + T_TII + ((g * 16 + r) * 16 + l15) * 2) = (bf16_t)f2bf(v);
            }
        }
        __syncthreads();
#pragma unroll
        for (int z = 0; z < 2; ++z) {
            LAS char* ldz = lds + z * T_ZS;
            const unsigned wbase = (wv < 4 ? T_W0A : T_W0B);
            unsigned wp[4][2];
#pragma unroll
            for (int i = 0; i < 4; ++i) {
                f32x4 r = xacc[z][i];
                if (i >= 1) {
                    const u32x2 l0 = *(const LAS u32x2*)(ldz + T_L + toff(i * 16 + l15, 4 * g));
                    u32x2 l1 = {0u, 0u};
                    if (i >= 2) l1 = *(const LAS u32x2*)(ldz + T_L + toff(i * 16 + l15, 16 + 4 * g));
                    const u32x4 aw = {l0.x, l0.y, l1.x, l1.y};
                    const u32x4 bw = {wp[0][0], wp[0][1], i >= 2 ? wp[1][0] : 0u, i >= 2 ? wp[1][1] : 0u};
                    r = __builtin_amdgcn_mfma_f32_16x16x32_bf16(__builtin_bit_cast(bf16x8, aw), __builtin_bit_cast(bf16x8, bw), r, 0, 0, 0);
                }
                if (i == 3) {
                    const u32x2 l2 = *(const LAS u32x2*)(ldz + T_L + toff(48 + l15, 32 + 4 * g));
                    const u32x4 aw = {l2.x, l2.y, 0u, 0u};
                    const u32x4 bw = {wp[2][0], wp[2][1], 0u, 0u};
                    r = __builtin_amdgcn_mfma_f32_16x16x32_bf16(__builtin_bit_cast(bf16x8, aw), __builtin_bit_cast(bf16x8, bw), r, 0, 0, 0);
                }
                const u32x2 tw = *(const LAS u32x2*)(ldz + T_TII + ((i * 16 + l15) * 16 + 4 * g) * 2);
                const u32x4 aw = {tw.x, tw.y, 0u, 0u};
                const u32x4 bw = {pk2(r[0], r[1]), pk2(r[2], r[3]), 0u, 0u};
                f32x4 w = {0.f, 0.f, 0.f, 0.f};
                w = __builtin_amdgcn_mfma_f32_16x16x32_bf16(__builtin_bit_cast(bf16x8, aw), __builtin_bit_cast(bf16x8, bw), w, 0, 0, 0);
                wp[i][0] = pk2(w[0], w[1]); wp[i][1] = pk2(w[2], w[3]);
                *(LAS u32x2*)(ldz + wbase + toff(wcol, i * 16 + 4 * g)) = (u32x2){wp[i][0], wp[i][1]};
            }
        }
        __syncthreads();
#pragma unroll
        for (int z = 0; z < 2; ++z) {
            LAS char* ldz = lds + z * T_ZS;
            LAS float* elend = (LAS float*)(lds + LDS_ELEND) + z * 64;
            const int cc = z ? 127 - m : m;
            const size_t uc = ((size_t)(z * NH + h) * 128 + cc) * 4096, um = ((size_t)(z * NH + h) * 128 + m) * 4096;
            bf16_t* GB = (bf16_t*)(p.ws + WS_GB) + uc; bf16_t* FB = (bf16_t*)(p.ws + WS_FB) + uc;
            bf16_t* GYB = (bf16_t*)(p.ws + WS_GYB) + um; bf16_t* FYB = (bf16_t*)(p.ws + WS_FYB) + um;
#pragma unroll
            for (int i = 0; i < 2; ++i) {
                const int tile = wv * 2 + i, mblk = tile >> 2, nblk = tile & 3;
                const int n = nblk * 16 + l15, m0 = mblk * 16 + 4 * g;
                {
                    f32x4 acc = {0.f, 0.f, 0.f, 0.f};
                    acc = tile_mm2<false, true>(ldz, T_W0A, T_BK, mblk, nblk, l15, g, acc, 2);
                    const float el = elend[n];
#pragma unroll
                    for (int e = 0; e < 4; ++e) acc[e] = (acc[e] + (m0 + e == n ? 1.f : 0.f)) * el;
                    u32x2 o; o.x = pk2(acc[0], acc[1]); o.y = pk2(acc[2], acc[3]);
                    *(u32x2*)(GB + ((nblk * 4 + mblk) * 64 + lane) * 4) = o;
                }
                {
                    f32x4 acc = {0.f, 0.f, 0.f, 0.f};
                    acc = tile_mm2<true, false>(ldz, T_BK, T_W0B, mblk, nblk, l15, g, acc, 2);
                    acc = tile_mm2<true, true>(ldz, T_KK, T_V, mblk, nblk, l15, g, acc, 2);
                    const f32x4 el4 = *(const LAS f32x4*)(elend + m0);
                    u32x2 o; o.x = pk2(acc[0] * el4[0], acc[1] * el4[1]); o.y = pk2(acc[2] * el4[2], acc[3] * el4[3]);
                    *(u32x2*)(FB + ((nblk * 4 + mblk) * 64 + lane) * 4) = o;
                }
                {
                    f32x4 acc = {0.f, 0.f, 0.f, 0.f};
                    acc = tile_mm(ldz, T_W0A, T_MRB, mblk, nblk, l15, g, acc, 2);
                    const u32x2 rq = *(const LAS u32x2*)(ldz + T_RQ + toff(n, m0));
                    acc[0] += bflo(rq.x); acc[1] += bfhi(rq.x); acc[2] += bflo(rq.y); acc[3] += bfhi(rq.y);
                    u32x2 o; o.x = pk2(acc[0], acc[1]); o.y = pk2(acc[2], acc[3]);
                    *(u32x2*)(GYB + (z ? (((3 - nblk) * 4 + mblk) * 64 + g * 16 + 15 - l15) : ((nblk * 4 + mblk) * 64 + lane)) * 4) = o;
                }
                {
                    f32x4 acc = {0.f, 0.f, 0.f, 0.f};
                    acc = tile_mm(ldz, T_MRB, T_W0B, mblk, nblk, l15, g, acc, 2);
                    acc = tile_mm2<false, true>(ldz, T_MRK, T_V, mblk, nblk, l15, g, acc, 2);
                    u32x2 o;
                    if (z) { o.x = pk2(acc[3], acc[2]); o.y = pk2(acc[1], acc[0]); *(u32x2*)(FYB + ((nblk * 4 + (3 - mblk)) * 64 + (3 - g) * 16 + l15) * 4) = o; }
                    else { o.x = pk2(acc[0], acc[1]); o.y = pk2(acc[2], acc[3]); *(u32x2*)(FYB + ((nblk * 4 + mblk) * 64 + lane) * 4) = o; }
                }
            }
        }
        lds_barrier();
    }
}

__device__ __forceinline__ void ph_scan_state(CPar& p) {
    const int tid = otid(), lane = tid & 63, wv = tid >> 6, l15 = lane & 15, g = lane >> 4;
    if (wv != 0) return;
    for (int u = blockIdx.x; u < 256; u += gridDim.x) {
        const int zh = u >> 2, vq = u & 3;
        const bf16_t* GB = (const bf16_t*)(p.ws + WS_GB) + (size_t)zh * 128 * 4096;
        const bf16_t* FB = (const bf16_t*)(p.ws + WS_FB) + (size_t)zh * 128 * 4096;
        bf16_t* HS = (bf16_t*)(p.ws + WS_HS) + (size_t)zh * 128 * 4096;
        f32x4 acc[4];
#pragma unroll
        for (int mt = 0; mt < 4; ++mt) acc[mt] = (f32x4){0.f, 0.f, 0.f, 0.f};
        u32x2 gq[4][2][2], fq[4], gq2[4][2][2], fq2[4], gq3[4][2][2], fq3[4], gq4[4][2][2], fq4[4];
#define SCAN_LOAD(G_, F_, cidx) do { const bf16_t* gp = GB + (size_t)(cidx) * 4096; const bf16_t* fp = FB + (size_t)(cidx) * 4096; \
            _Pragma("unroll") for (int mt = 0; mt < 4; ++mt) { \
                _Pragma("unroll") for (int ks = 0; ks < 2; ++ks) { G_[mt][ks][0] = *(const u32x2*)(gp + ((mt * 4 + 2 * ks) * 64 + lane) * 4); G_[mt][ks][1] = *(const u32x2*)(gp + ((mt * 4 + 2 * ks + 1) * 64 + lane) * 4); } \
                F_[mt] = *(const u32x2*)(fp + ((vq * 4 + mt) * 64 + lane) * 4); } } while (0)
#define SCAN_STEP(G_, F_, cidx) do { \
            bf16_t* hp = HS + (size_t)(cidx) * 4096 + (vq * 4 * 64 + lane) * 4; \
            u32x2 hb[4]; \
            _Pragma("unroll") for (int mt = 0; mt < 4; ++mt) { hb[mt].x = pk2(acc[mt][0], acc[mt][1]); hb[mt].y = pk2(acc[mt][2], acc[mt][3]); *(u32x2*)(hp + mt * 256) = hb[mt]; } \
            bf16x8 bfr[2]; \
            _Pragma("unroll") for (int ks = 0; ks < 2; ++ks) { u32x4 w = {hb[2 * ks].x, hb[2 * ks].y, hb[2 * ks + 1].x, hb[2 * ks + 1].y}; bfr[ks] = __builtin_bit_cast(bf16x8, w); } \
            _Pragma("unroll") for (int mt = 0; mt < 4; ++mt) { \
                f32x4 a = {bflo(F_[mt].x), bfhi(F_[mt].x), bflo(F_[mt].y), bfhi(F_[mt].y)}; \
                _Pragma("unroll") for (int ks = 0; ks < 2; ++ks) { \
                    u32x4 w = {G_[mt][ks][0].x, G_[mt][ks][0].y, G_[mt][ks][1].x, G_[mt][ks][1].y}; \
                    a = __builtin_amdgcn_mfma_f32_16x16x32_bf16(__builtin_bit_cast(bf16x8, w), bfr[ks], a, 0, 0, 0); } \
                acc[mt] = a; } } while (0)
        SCAN_LOAD(gq, fq, 0); SCAN_LOAD(gq2, fq2, 1); SCAN_LOAD(gq3, fq3, 2); SCAN_LOAD(gq4, fq4, 3);
#pragma unroll 4
        for (int c = 0; c < 128; c += 4) {
            SCAN_STEP(gq, fq, c);
            if (c + 4 < 128) SCAN_LOAD(gq, fq, c + 4);
            SCAN_STEP(gq2, fq2, c + 1);
            if (c + 4 < 128) SCAN_LOAD(gq2, fq2, c + 5);
            SCAN_STEP(gq3, fq3, c + 2);
            if (c + 4 < 128) SCAN_LOAD(gq3, fq3, c + 6);
            SCAN_STEP(gq4, fq4, c + 3);
            if (c + 4 < 128) SCAN_LOAD(gq4, fq4, c + 7);
        }
#undef SCAN_STEP
#undef SCAN_LOAD
    }
}

__device__ __forceinline__ void ph_scan_out(CPar& p, LAS char* lds) {
    const int tid = otid(), lane = tid & 63, wv = tid >> 6, l15 = lane & 15, g = lane >> 4;
    const bf16_t* V2 = (const bf16_t*)(p.ws + WS_V2); const bf16_t* G = (const bf16_t*)(p.ws + WS_G); bf16_t* Z = (bf16_t*)(p.ws + WS_Z);
    const float* sbon = (const float*)(p.ws + WS_SBON); const float* lw = p.in[25]; const float* lb = p.in[26];
    const int vb = wv & 3, tk = tid >> 3, cg = tid & 7;
    const int NU = NH * 128, GS = gridDim.x;
    u32x2 Af[2][2], Aa[2][2][2][2], Ab[2][2][2][2];
    struct BSet { u32x4 vw, gw; f32x4 w0, w1, b0, b1; float s0, s1; };
    BSet B0, B1;
#define OUT_LOADA(u_) do { const int h_ = (u_) & 31, m_ = (u_) >> 5; \
        _Pragma("unroll") for (int i = 0; i < 2; ++i) { const int sb = (wv >> 2) * 2 + i; \
            _Pragma("unroll") for (int z = 0; z < 2; ++z) { const int cc = z ? 127 - m_ : m_; \
                const bf16_t* gy = (const bf16_t*)(p.ws + WS_GYB) + ((size_t)(z * NH + h_) * 128 + m_) * 4096; \
                const bf16_t* fy = (const bf16_t*)(p.ws + WS_FYB) + ((size_t)(z * NH + h_) * 128 + m_) * 4096; \
                const bf16_t* hs = (const bf16_t*)(p.ws + WS_HS) + ((size_t)(z * NH + h_) * 128 + cc) * 4096; \
                Af[i][z] = *(const u32x2*)(fy + ((vb * 4 + sb) * 64 + lane) * 4); \
                _Pragma("unroll") for (int ks = 0; ks < 2; ++ks) { \
                    const bf16_t* gyp = gy + ((sb * 4 + 2 * ks + (g >> 1)) * 64 + (2 * (g & 1)) * 16 + l15) * 4;        \
                    Aa[i][z][ks][0] = *(const u32x2*)gyp; Aa[i][z][ks][1] = *(const u32x2*)(gyp + 64); \
                    const bf16_t* hsp = hs + ((vb * 4 + 2 * ks + (g >> 1)) * 64 + (2 * (g & 1)) * 16 + l15) * 4; \
                    Ab[i][z][ks][0] = *(const u32x2*)hsp; Ab[i][z][ks][1] = *(const u32x2*)(hsp + 64); } } } } while (0)
#define OUT_LOADB(S_, u_) do { const int h_ = (u_) & 31, m_ = (u_) >> 5, t_ = m_ * 64 + tk, c0_ = h_ * HD + cg * 8; const size_t o_ = (size_t)t_ * D + c0_; \
        S_.vw = *(const u32x4*)(V2 + o_); S_.gw = *(const u32x4*)(G + o_); \
        S_.s0 = sbon[(size_t)t_ * NH + h_]; S_.s1 = sbon[(size_t)T * NH + (size_t)t_ * NH + h_]; \
        S_.w0 = *(const LAS f32x4*)(llw + c0_); S_.w1 = *(const LAS f32x4*)(llw + c0_ + 4); S_.b0 = *(const LAS f32x4*)(llb + c0_); S_.b1 = *(const LAS f32x4*)(llb + c0_ + 4); } while (0)
#define OUT_MMA(yt_) do { \
        _Pragma("unroll") for (int i = 0; i < 2; ++i) { const int sb = (wv >> 2) * 2 + i; \
            f32x4 acc = {0.f, 0.f, 0.f, 0.f}; \
            _Pragma("unroll") for (int z = 0; z < 2; ++z) { \
                const u32x2 f = Af[i][z]; \
                acc[0] += bflo(f.x); acc[1] += bfhi(f.x); acc[2] += bflo(f.y); acc[3] += bfhi(f.y); \
                _Pragma("unroll") for (int ks = 0; ks < 2; ++ks) { \
                    const bf16x8 a = __builtin_bit_cast(bf16x8, (u32x4){Aa[i][z][ks][0].x, Aa[i][z][ks][0].y, Aa[i][z][ks][1].x, Aa[i][z][ks][1].y}); \
                    const bf16x8 bq = __builtin_bit_cast(bf16x8, (u32x4){Ab[i][z][ks][0].x, Ab[i][z][ks][0].y, Ab[i][z][ks][1].x, Ab[i][z][ks][1].y}); \
                    acc = __builtin_amdgcn_mfma_f32_16x16x32_bf16(a, bq, acc, 0, 0, 0); } } \
            _Pragma("unroll") for (int e = 0; e < 4; ++e) yt_[(sb * 16 + 4 * g + e) * 64 + vb * 16 + l15] = acc[e]; } } while (0)
#define OUT_NORM(S_, u_, yt_) do { const int h_ = (u_) & 31, m_ = (u_) >> 5, t_ = m_ * 64 + tk, c0_ = h_ * HD + cg * 8; const size_t o_ = (size_t)t_ * D + c0_; \
        const float sbv = S_.s0 + S_.s1; \
        const f32x4 y0 = *(const LAS f32x4*)(yt_ + tk * 64 + cg * 8), y1 = *(const LAS f32x4*)(yt_ + tk * 64 + cg * 8 + 4); \
        float sum = y0[0] + y0[1] + y0[2] + y0[3] + y1[0] + y1[1] + y1[2] + y1[3]; \
        sum += __shfl_xor(sum, 1); sum += __shfl_xor(sum, 2); sum += __shfl_xor(sum, 4); \
        const float mu = sum * (1.f / 64.f); \
        float yv[8], wv8[8], bv8[8], gv[8], vv[8]; \
        _Pragma("unroll") for (int e = 0; e < 4; ++e) { yv[e] = y0[e] - mu; yv[4 + e] = y1[e] - mu; wv8[e] = S_.w0[e]; wv8[4 + e] = S_.w1[e]; bv8[e] = S_.b0[e]; bv8[4 + e] = S_.b1[e]; } \
        _Pragma("unroll") for (int j = 0; j < 8; ++j) gv[j] = (j & 1) ? bfhi(S_.gw[j >> 1]) : bflo(S_.gw[j >> 1]); \
        _Pragma("unroll") for (int j = 0; j < 8; ++j) vv[j] = (j & 1) ? bfhi(S_.vw[j >> 1]) : bflo(S_.vw[j >> 1]); \
        float sq = 0.f; \
        _Pragma("unroll") for (int j = 0; j < 8; ++j) sq += yv[j] * yv[j]; \
        sq += __shfl_xor(sq, 1); sq += __shfl_xor(sq, 2); sq += __shfl_xor(sq, 4); \
        const float rs = rsqrtf(sq * (1.f / 64.f) + 64e-5f); \
        float ov[8]; \
        _Pragma("unroll") for (int j = 0; j < 8; ++j) ov[j] = (yv[j] * rs * wv8[j] + bv8[j] + sbv * vv[j]) * gv[j]; \
        u32x4 pw; pw.x = pk2(ov[0], ov[1]); pw.y = pk2(ov[2], ov[3]); pw.z = pk2(ov[4], ov[5]); pw.w = pk2(ov[6], ov[7]); \
        *(u32x4*)(Z + o_) = pw; } while (0)
    LAS float* yt0 = (LAS float*)lds; LAS float* yt1 = yt0 + 4096;
    LAS float* llw = yt0 + 8192; LAS float* llb = llw + D;
    for (int i = tid; i < D / 4; i += NTHR) { *(LAS f32x4*)(llw + i * 4) = *(const f32x4*)(lw + i * 4); *(LAS f32x4*)(llb + i * 4) = *(const f32x4*)(lb + i * 4); }
    __syncthreads();
    int u = blockIdx.x;
    if (u < NU) { OUT_LOADA(u); OUT_LOADB(B0, u); }
    for (; u < NU; u += 2 * GS) {
        OUT_MMA(yt0);
        const int u1 = u + GS;
        if (u1 < NU) { OUT_LOADA(u1); OUT_LOADB(B1, u1); }
        lds_barrier();
        OUT_NORM(B0, u, yt0);
        if (u1 >= NU) break;
        OUT_MMA(yt1);
        const int u2 = u1 + GS;
        if (u2 < NU) { OUT_LOADA(u2); OUT_LOADB(B0, u2); }
        lds_barrier();
        OUT_NORM(B1, u1, yt1);
    }
#undef OUT_LOADA
#undef OUT_LOADB
#undef OUT_MMA
#undef OUT_NORM
}

__device__ __forceinline__ void ph_final(CPar& p, LAS char* lds) {
    const int tid = otid(), lane = tid & 63, gw = blockIdx.x * 8 + (tid >> 6), nw = gridDim.x * 8;
    float* h3 = p.out; const bf16_t* y = (const bf16_t*)(p.ws + WS_Y); const float* g = p.in[3];
    LAS float* lg = (LAS float*)lds;
    for (int i = tid; i < D / 4; i += NTHR) *(LAS f32x4*)(lg + i * 4) = *(const f32x4*)(g + i * 4);
    __syncthreads();
    for (int t = gw; t < T; t += nw) {
        f32x4 x[8]; float ss = 0.f;
#pragma unroll
        for (int j = 0; j < 8; ++j) {
            const int d0 = (j * 64 + lane) * 4;
            x[j] = *(const f32x4*)(h3 + (size_t)t * D + d0);
            const u32x2 a = *(const u32x2*)(y + (size_t)(2 * t) * D + d0), b = *(const u32x2*)(y + (size_t)(2 * t + 1) * D + d0);
            x[j][0] += bflo(a.x) + bflo(b.x); x[j][1] += bfhi(a.x) + bfhi(b.x); x[j][2] += bflo(a.y) + bflo(b.y); x[j][3] += bfhi(a.y) + bfhi(b.y);
            ss += x[j][0] * x[j][0] + x[j][1] * x[j][1] + x[j][2] * x[j][2] + x[j][3] * x[j][3];
        }
        ss = wave_sum(ss);
        const float inv = rsqrtf(ss * (1.f / D) + 1e-6f);
#pragma unroll
        for (int j = 0; j < 8; ++j) {
            const int d0 = (j * 64 + lane) * 4;
            const f32x4 gv = *(const LAS f32x4*)(lg + d0);
            f32x4 o = {x[j][0] * inv * gv[0], x[j][1] * inv * gv[1], x[j][2] * inv * gv[2], x[j][3] * inv * gv[3]};
            *(f32x4*)(h3 + (size_t)t * D + d0) = o;
        }
    }
}

constexpr int NPH = 19;
extern __shared__ __attribute__((aligned(16))) char smem[];
__global__ void __launch_bounds__(NTHR, 2) fwd(Params p_unused, int lo, int hi) {
    LAS char* lds = (LAS char*)smem;
    CPar* pp = (CPar*)__builtin_amdgcn_kernarg_segment_ptr();
    if (threadIdx.x == 0) *(LAS u32x4*)(lds + LDS_XB) = (u32x4){0u, 0u, 0u, 0u};
    __syncthreads();
    XcdBarrier bar;
    const bool multi = (hi - lo) > 1;
    if (multi) bar = xcd_barrier_post((unsigned*)(pp->ws + WS_CTL) + CW_BAR, (volatile LAS unsigned*)(lds + LDS_XB));
#define IN(k) (lo <= (k) && (k) < hi)
#define SEAM(k) do { if (IN(k) && IN((k) + 1)) xcd_barrier(bar); } while (0)
#define PHASE(k, call) do { if (IN(k)) { asm volatile("" : "+s"(pp)); CPar& p = *pp; call; } } while (0)
    PHASE(0, ph_prologue(p, lds));
    SEAM(0);
    PHASE(1, ph_qkv(p, lds));
    SEAM(1);
    PHASE(2, ph_attn(p, lds));
    SEAM(2);
    PHASE(3, ph_oproj(p, lds, (const bf16_t*)(p.ws + WS_AO), (const bf16_t*)(p.ws + WS_WONA), p.in[8], p.in[0], p.out));
    SEAM(3);
    PHASE(4, ph_router(p, lds, p.out, 0));
    SEAM(4);
    PHASE(6, ph_moe(p, lds, 0));
    SEAM(6);
    PHASE(7, ph_combine_mix(p, lds));
    SEAM(7);
    PHASE(9, ph_rwkv_proj(p, lds));
    SEAM(9);
    PHASE(11, ph_gate(p, lds));
    PHASE(11, ph_scan_prep(p, lds));
    SEAM(11);
    PHASE(12, ph_scan_state(p));
    SEAM(12);
    PHASE(13, ph_scan_out(p, lds));
    SEAM(13);
    PHASE(14, ph_oproj(p, lds, (const bf16_t*)(p.ws + WS_Z), (const bf16_t*)(p.ws + WS_WORW), nullptr, (const float*)(p.ws + WS_HB), p.out));
    SEAM(14);
    PHASE(15, ph_router(p, lds, p.out, 1));
    SEAM(15);
    PHASE(17, ph_moe(p, lds, 1));
    SEAM(17);
    PHASE(18, ph_final(p, lds));
}

extern "C" void kernel_launch(void* const* d_in, const int* in_sizes, int n_in, void* d_out, int out_size, void* d_ws, size_t ws_size, hipStream_t stream) {
    static int grid = 0;
    if (grid == 0) {
        if (n_in != 34 || out_size != T * D || ws_size < WS_END) { fprintf(stderr, "kernel_launch: unexpected shapes (n_in %d out %d ws %zu)\n", n_in, out_size, ws_size); grid = -1; return; }
        int dev = 0, cus = 0, per_cu = 0;
        if (hipGetDevice(&dev) != hipSuccess || hipDeviceGetAttribute(&cus, hipDeviceAttributeMultiprocessorCount, dev) != hipSuccess) { grid = -1; return; }
        if (hipFuncSetAttribute((const void*)fwd, hipFuncAttributeMaxDynamicSharedMemorySize, LDS_BYTES) != hipSuccess) { fprintf(stderr, "kernel_launch: hipFuncSetAttribute failed\n"); grid = -1; return; }
        if (hipOccupancyMaxActiveBlocksPerMultiprocessor(&per_cu, (const void*)fwd, NTHR, LDS_BYTES) != hipSuccess || per_cu < 1) { fprintf(stderr, "kernel_launch: occupancy query failed (%d)\n", per_cu); grid = -1; return; }
        if (cus < 256) { fprintf(stderr, "kernel_launch: built for a 256-CU device (got %d)\n", cus); grid = -1; return; }
        grid = 256;
    }
    if (grid < 0) return;
    (void)hipMemsetAsync((char*)d_ws + WS_CTL, 0, 1 * MiB, stream);
    Params p{};
    for (int i = 0; i < 34; ++i) p.in[i] = (const float*)d_in[i];
    p.out = (float*)d_out; p.ws = (unsigned char*)d_ws;
#if MK_FUSED
    hipLaunchKernelGGL(fwd, dim3(grid), dim3(NTHR), LDS_BYTES, stream, p, 0, NPH);
#else
    for (int k = 0; k < NPH; ++k) hipLaunchKernelGGL(fwd, dim3(grid), dim3(NTHR), LDS_BYTES, stream, p, k, k + 1);
#endif
}
```

```cpp
#include <hip/hip_runtime.h>
#include <cstdint>
#include <cstdio>

#define LAS __attribute__((address_space(3)))
typedef unsigned short bf16_t;
typedef short bf16x8 __attribute__((ext_vector_type(8)));
typedef float f32x4 __attribute__((ext_vector_type(4)));
typedef float f32x16 __attribute__((ext_vector_type(16)));
typedef unsigned u32x4 __attribute__((ext_vector_type(4)));
typedef unsigned u32x2 __attribute__((ext_vector_type(2)));

constexpr int T = 8192, D = 2048, NH = 32, HD = 64, GW = 64, ROWS = 128;
constexpr int NEXP = 32, FF = 512;
constexpr int NTHR = 512;
#ifndef MK_FUSED
#define MK_FUSED 1
#endif

constexpr size_t MiB = 1u << 20;
constexpr size_t WS_CTL = 0;
constexpr size_t WS_LIST = 1 * MiB;
constexpr size_t WS_CW = 3 * MiB;
constexpr size_t WS_RGF = 3 * MiB + 256 * 1024;
constexpr size_t WS_REF = 3 * MiB + 384 * 1024;
constexpr size_t WS_WQKV = 4 * MiB;
constexpr size_t WS_WONA = 28 * MiB;
constexpr size_t WS_WR = 36 * MiB, WS_WK = 44 * MiB, WS_WV = 52 * MiB, WS_WORW = 60 * MiB;
constexpr size_t WS_W1T = 68 * MiB, WS_A1T = 69 * MiB, WS_G1T = 70 * MiB;
constexpr size_t WS_W2T = 71 * MiB, WS_A2T = 72 * MiB;
constexpr size_t WS_G2T = 73 * MiB;
constexpr size_t WS_GB = 74 * MiB;
constexpr size_t WS_FB = 138 * MiB;
constexpr size_t WS_GYB = 330 * MiB;
constexpr size_t WS_HS = 394 * MiB;
constexpr size_t WS_HB = 458 * MiB;
constexpr size_t WS_HN = 522 * MiB;
constexpr size_t WS_SBON = 522 * MiB;
constexpr size_t WS_ACT = 554 * MiB;
constexpr size_t WS_ACT1 = 666 * MiB;
constexpr size_t WS_Y = 570 * MiB;
constexpr size_t WS_Z = 570 * MiB;
constexpr size_t WS_FYB = 602 * MiB;
constexpr size_t WS_Q = 634 * MiB, WS_K = 666 * MiB, WS_VT = 698 * MiB, WS_AO = 730 * MiB;
constexpr size_t WS_MIX = 698 * MiB;
constexpr size_t WS_G = 698 * MiB;
constexpr size_t WS_R = 890 * MiB, WS_K2 = 922 * MiB, WS_V2 = 954 * MiB;
constexpr size_t WS_LW = 986 * MiB, WS_LA = 990 * MiB, WS_GL = 994 * MiB;
constexpr size_t WS_END = 998 * MiB;

constexpr int CW_BAR = 4096;
constexpr int CW_CNT0 = 16384, CW_CNT1 = 16384 + 1024;
constexpr int CNS = 32;
constexpr int CW_MOEQ = 20480;
constexpr int CW_MOEMT = 24576;

constexpr int LDS_MISC = 159744;
constexpr int LDS_PREF = LDS_MISC;
constexpr int LDS_XB = LDS_MISC + 256;
constexpr int LDS_SEG = LDS_MISC + 512;
constexpr int LDS_ELEND = LDS_MISC + 1024;
constexpr int LDS_TILE_E = LDS_MISC + 2048;
constexpr int LDS_MOEQ = LDS_MISC + 3072;
constexpr int LDS_ROWL = LDS_MISC + 512;
constexpr int LDS_BYTES = 163840;

struct Params {
    const float* in[34];
    float* out;
    unsigned char* ws;
};
typedef const __attribute__((address_space(4))) Params CPar;

typedef float f32x2_t __attribute__((ext_vector_type(2)));
typedef __bf16 bf16x2_t __attribute__((ext_vector_type(2)));
__device__ __forceinline__ unsigned pk2(float lo, float hi) { const f32x2_t v = {lo, hi}; return __builtin_bit_cast(unsigned, __builtin_convertvector(v, bf16x2_t)); }
__device__ __forceinline__ unsigned f2bf(float f) { return pk2(f, 0.f) & 0xffffu; }
__device__ __forceinline__ float bflo(unsigned u) { return __builtin_bit_cast(float, u << 16); }
__device__ __forceinline__ float bfhi(unsigned u) { return __builtin_bit_cast(float, u & 0xffff0000u); }
__device__ __forceinline__ float bf2f(bf16_t b) { return __builtin_bit_cast(float, (unsigned)b << 16); }
__device__ __forceinline__ void lds_barrier() { asm volatile("s_waitcnt lgkmcnt(0)" ::: "memory"); __builtin_amdgcn_s_barrier(); asm volatile("" ::: "memory"); }
__device__ __forceinline__ float wave_sum(float v) {
#pragma unroll
    for (int o = 32; o; o >>= 1) v += __shfl_xor(v, o);
    return v;
}
template <int CTRL>
__device__ __forceinline__ float dpp_mov(float src) { return __builtin_bit_cast(float, __builtin_amdgcn_update_dpp(0, __builtin_bit_cast(int, src), CTRL, 0xF, 0xF, false)); }
__device__ __forceinline__ float sum8(float v) { v += dpp_mov<0xB1>(v); v += dpp_mov<0x4E>(v); v += dpp_mov<0x141>(v); return v; }
__device__ __forceinline__ int otid() { int t = threadIdx.x; asm volatile("" : "+v"(t)); return t; }
__device__ __forceinline__ float tanhf_(float x) { return 1.f - 2.f * __builtin_amdgcn_rcpf(1.f + __expf(2.f * x)); }
__device__ __forceinline__ float sigmoidf_(float x) { return __builtin_amdgcn_rcpf(1.f + __expf(-x)); }

#define XB_TMO      128
#define XB_XCNT(j)  (256  + 64 * (j))
#define XB_XSUB(j)  (1280 + 64 * (j))
#define XB_XGEN(j)  (2304 + 64 * (j))
#define XB_TOP      3328
#define XB_TOPGEN   3392
#define XCD_BAR_WORDS 3456
#define XB_SPIN_CAP (1u << 18)
__device__ __forceinline__ unsigned xb_ld(unsigned* p)              { return __hip_atomic_load(p, __ATOMIC_RELAXED, __HIP_MEMORY_SCOPE_AGENT); }
__device__ __forceinline__ unsigned xb_add(unsigned* p, unsigned v) { return __hip_atomic_fetch_add(p, v, __ATOMIC_RELAXED, __HIP_MEMORY_SCOPE_AGENT); }
__device__ __forceinline__ unsigned xb_xcc_id() { return (unsigned)__builtin_amdgcn_s_getreg((3 << 11) | 20) & 0xFu; }
#define XB_SPIN(cond, bar) do { unsigned _sp = 0; while (cond) { __builtin_amdgcn_s_sleep(1); \
    if ((++_sp & 255u) == 0u) { if (xb_ld(&(bar)[XB_TMO])) break; if (_sp > XB_SPIN_CAP) { atomicAdd(&(bar)[XB_TMO], 1u); break; } } } } while (0)
struct XcdBarrier { unsigned* bar; unsigned x; volatile LAS unsigned* st; };
__device__ __forceinline__ XcdBarrier xcd_barrier_post(unsigned* bar, volatile LAS unsigned* st) {
    XcdBarrier b; b.bar = bar; b.x = xb_xcc_id(); b.st = st;
    if (threadIdx.x == 0) (void)xb_add(&bar[XB_XCNT(b.x)], 1u);
    return b;
}
__device__ __forceinline__ void xcd_barrier_complete(unsigned* bar, unsigned x, unsigned& nloc, unsigned& nx) {
    const unsigned G = gridDim.x * gridDim.y * gridDim.z;
    unsigned sum, cnt, mine, sp = 0u;
    for (;;) {
        sum = 0u; cnt = 0u; mine = 0u;
#pragma unroll
        for (unsigned j = 0; j < 16; ++j) { const unsigned c = xb_ld(&bar[XB_XCNT(j)]); sum += c; cnt += (c > 0u) ? 1u : 0u; mine = (j == x) ? c : mine; }
        if (sum == G) break;
        __builtin_amdgcn_s_sleep(1);
        if ((++sp & 255u) == 0u) { if (xb_ld(&bar[XB_TMO])) break; if (sp > XB_SPIN_CAP) { atomicAdd(&bar[XB_TMO], 1u); break; } }
    }
    nloc = mine > 0u ? mine : 1u; nx = cnt > 0u ? cnt : 1u;
}
__device__ __forceinline__ void xcd_barrier(const XcdBarrier& b) {
    asm volatile("s_waitcnt vmcnt(0)" ::: "memory");
    __syncthreads();
    if (threadIdx.x == 0) {
        unsigned* bar = b.bar;
        __builtin_amdgcn_s_waitcnt(0);
        unsigned nloc = b.st[0], nx = b.st[1];
        if (nloc == 0u) { xcd_barrier_complete(bar, b.x, nloc, nx); b.st[0] = nloc; b.st[1] = nx; }
        const unsigned old = xb_add(&bar[XB_XSUB(b.x)], 1u);
        const unsigned gen = old / nloc;
        if (old + 1u == (gen + 1u) * nloc) {
            __builtin_amdgcn_fence(__ATOMIC_RELEASE, "agent");
            asm volatile("s_waitcnt vmcnt(0)" ::: "memory");
            const unsigned og = xb_add(&bar[XB_TOP], 1u);
            const unsigned tg = og / nx;
            if (og + 1u == (tg + 1u) * nx) xb_add(&bar[XB_TOPGEN], 1u);
            else XB_SPIN(xb_ld(&bar[XB_TOPGEN]) == tg, bar);
            __builtin_amdgcn_fence(__ATOMIC_ACQUIRE, "agent");
            xb_add(&bar[XB_XGEN(b.x)], 1u);
            asm volatile("s_waitcnt vmcnt(0)" ::: "memory");
        } else {
            XB_SPIN(xb_ld(&bar[XB_XGEN(b.x)]) == gen, bar);
            __builtin_amdgcn_fence(__ATOMIC_ACQUIRE, "agent");
            asm volatile("s_waitcnt vmcnt(0)" ::: "memory");
        }
    }
    __syncthreads();
}

template <class Epi>
__device__ __forceinline__ void gemm_tile_moe(const int tid, LAS char* lds, const bf16_t* __restrict__ A, int lda, const int* __restrict__ rows, int nvalid, int rshift,
                                              const float* __restrict__ bsrc, int ldn, int K, const Epi& epi) {
    const int lane = tid & 63, wid = tid >> 6, wm = wid >> 1, wn = wid & 1;
    const int srow = tid >> 3, sch = tid & 7;
    unsigned offA[4];
#pragma unroll
    for (int i = 0; i < 4; ++i) {
        const int r = srow + i * 64;
        const int rr = r < nvalid ? r : 0;
        const int pr = rows[rr];
        if (sch == 0) ((LAS int*)(lds + LDS_ROWL))[r] = pr;
        offA[i] = (unsigned)(pr >> rshift) * (unsigned)lda + sch * 8;
    }
#define MOE_KEY(r_) ((((r_) >> 2) & 7) ^ ((((r_) >> 1) & 1) << 2))
    const unsigned ldsw = srow * 128 + ((sch ^ MOE_KEY(srow)) << 4);
    const int nq = tid & 31, kq = tid >> 5;
    unsigned ldsb[4];
#pragma unroll
    for (int c = 0; c < 4; ++c) { const int rho = nq * 4 + c; ldsb[c] = 32768u + rho * 128 + ((((kq >> 1)) ^ MOE_KEY(rho)) << 4) + (kq & 1) * 8; }
    const float* bp = bsrc + (size_t)(kq * 4) * ldn;
    const int l31 = lane & 31, lh = lane >> 5, key = MOE_KEY(l31);
    const unsigned ra = (wm * 64 + l31) * 128;
    const unsigned rb = 32768 + (wn * 64 + l31) * 128;
    unsigned kc[4];
#pragma unroll
    for (int ks = 0; ks < 4; ++ks) kc[ks] = ((ks * 2 + lh) ^ key) << 4;
    f32x16 acc[2][2];
#pragma unroll
    for (int mi = 0; mi < 2; ++mi)
#pragma unroll
        for (int nj = 0; nj < 2; ++nj)
#pragma unroll
            for (int e = 0; e < 16; ++e) acc[mi][nj][e] = 0.f;
    u32x4 xa[4], ya[4]; f32x4 xb[4], yb[4];
    const int nt = K >> 6;
#define MOE_LOAD(ra_, rb_, tt) do { _Pragma("unroll") for (int i = 0; i < 4; ++i) { ra_[i] = *(const u32x4*)(A + offA[i] + (tt) * 64); rb_[i] = *(const f32x4*)(bp + (size_t)((tt) * 64 + i) * ldn); } } while (0)
#define MOE_STORE(ra_, rb_, so_) do { _Pragma("unroll") for (int i = 0; i < 4; ++i) *(LAS u32x4*)(lds + (so_) + ldsw + i * 8192) = ra_[i]; \
        _Pragma("unroll") for (int c = 0; c < 4; ++c) { u32x2 o; o.x = pk2(rb_[0][c], rb_[1][c]); o.y = pk2(rb_[2][c], rb_[3][c]); *(LAS u32x2*)(lds + (so_) + ldsb[c]) = o; } } while (0)
#define MOE_FRAGS(so_, ks, AF, BQ) do { _Pragma("unroll") for (int mi = 0; mi < 2; ++mi) AF[mi] = *(const LAS bf16x8*)(lds + (so_) + ra + mi * 4096 + kc[ks]); \
        _Pragma("unroll") for (int nj = 0; nj < 2; ++nj) BQ[nj] = *(const LAS bf16x8*)(lds + (so_) + rb + nj * 4096 + kc[ks]); } while (0)
#define MOE_MMA(AF, BQ) do { _Pragma("unroll") for (int mi = 0; mi < 2; ++mi) _Pragma("unroll") for (int nj = 0; nj < 2; ++nj) \
        acc[mi][nj] = __builtin_amdgcn_mfma_f32_32x32x16_bf16(BQ[nj], AF[mi], acc[mi][nj], 0, 0, 0); } while (0)
#define MOE_SB __builtin_amdgcn_sched_barrier(0)
#define MOE_COMPUTE(so_) do { bf16x8 afA[2], bqA[2], afB[2], bqB[2]; \
        MOE_FRAGS(so_, 0, afA, bqA); MOE_FRAGS(so_, 1, afB, bqB); MOE_SB; MOE_MMA(afA, bqA); MOE_SB; \
        MOE_FRAGS(so_, 2, afA, bqA); MOE_SB; MOE_MMA(afB, bqB); MOE_SB; \
        MOE_FRAGS(so_, 3, afB, bqB); MOE_SB; MOE_MMA(afA, bqA); MOE_SB; MOE_MMA(afB, bqB); } while (0)
#define MOE_STEP(tt, SA_, SB_, LA_, LB_) do { \
        if ((tt) + 2 < nt) MOE_LOAD(LA_, LB_, (tt) + 2); \
        __builtin_amdgcn_sched_barrier(0); \
        MOE_COMPUTE(((tt) & 1) * 49152u); \
        __builtin_amdgcn_sched_barrier(0); \
        if ((tt) + 1 < nt) MOE_STORE(SA_, SB_, (((tt) + 1) & 1) * 49152u); \
        __syncthreads(); } while (0)
    MOE_LOAD(xa, xb, 0);
    MOE_STORE(xa, xb, 0u);
    if (nt > 1) MOE_LOAD(xa, xb, 1);
    __syncthreads();
    for (int t = 0; t < nt; t += 8) {
        MOE_STEP(t, xa, xb, ya, yb); MOE_STEP(t + 1, ya, yb, xa, xb); MOE_STEP(t + 2, xa, xb, ya, yb); MOE_STEP(t + 3, ya, yb, xa, xb);
        MOE_STEP(t + 4, xa, xb, ya, yb); MOE_STEP(t + 5, ya, yb, xa, xb); MOE_STEP(t + 6, xa, xb, ya, yb); MOE_STEP(t + 7, ya, yb, xa, xb);
    }
#undef MOE_STEP
#undef MOE_COMPUTE
#undef MOE_FRAGS
#undef MOE_MMA
#undef MOE_SB
#undef MOE_LOAD
#undef MOE_STORE
#undef MOE_KEY
    epi(acc, wm, wn, l31, lh);
}

typedef __attribute__((address_space(1))) unsigned gu32;
struct EpiMoeGU3 {
    bf16_t* act; const float* cw; const int* rows; int nvalid; int f0; LAS char* lds; int tid; gu32* mtc;
    __device__ __forceinline__ void operator()(const f32x16 (&acc)[2][2], int wm, int wn, int l31, int lh) const {
#pragma unroll
        for (int mi = 0; mi < 2; ++mi) {
            const int ml = wm * 64 + mi * 32 + l31;
            const float w = ml < nvalid ? cw[((const LAS int*)(lds + LDS_ROWL))[ml]] : 0.f;
#pragma unroll
            for (int rg = 0; rg < 4; ++rg) {
                float o[4];
#pragma unroll
                for (int e = 0; e < 4; ++e) { const float g = acc[mi][0][4 * rg + e], u = acc[mi][1][4 * rg + e]; o[e] = g * sigmoidf_(g) * u * w; }
                u32x2 ov; ov.x = pk2(o[0], o[1]); ov.y = pk2(o[2], o[3]);
                *(LAS u32x2*)(lds + ml * 144 + (wn * 32 + 8 * rg + 4 * lh) * 2) = ov;
            }
        }
        __syncthreads();
        const __amdgpu_buffer_rsrc_t rs = __builtin_amdgcn_make_buffer_rsrc((void*)act, 0, 2 * T * FF * 2, 0x00020000);
#pragma unroll
        for (int i = 0; i < 4; ++i) {
            const int row = (tid >> 3) + 64 * i, pc = tid & 7;
            if (row < nvalid) {
                const u32x4 v = *(const LAS u32x4*)(lds + row * 144 + pc * 16);
                __builtin_amdgcn_raw_buffer_store_b128(v, rs, (((const LAS int*)(lds + LDS_ROWL))[row] * FF + f0 + pc * 8) * 2, 0,   16);
            }
        }
        asm volatile("s_waitcnt vmcnt(0)" ::: "memory");
        if ((tid & 63) == 0) (void)__hip_atomic_fetch_add(mtc, 1u, __ATOMIC_RELAXED, __HIP_MEMORY_SCOPE_AGENT);
        __syncthreads();
    }
};
struct EpiMoeD2 {
    bf16_t* y; const int* rows; int nvalid; int n0; LAS char* lds; int tid;
    __device__ __forceinline__ void operator()(const f32x16 (&acc)[2][2], int wm, int wn, int l31, int lh) const {
#pragma unroll
        for (int mi = 0; mi < 2; ++mi) {
            const int ml = wm * 64 + mi * 32 + l31;
#pragma unroll
            for (int nj = 0; nj < 2; ++nj)
#pragma unroll
                for (int rg = 0; rg < 4; ++rg) {
                    u32x2 o; o.x = pk2(acc[mi][nj][4 * rg], acc[mi][nj][4 * rg + 1]); o.y = pk2(acc[mi][nj][4 * rg + 2], acc[mi][nj][4 * rg + 3]);
                    *(LAS u32x2*)(lds + ml * 272 + (wn * 64 + nj * 32 + 8 * rg + 4 * lh) * 2) = o;
                }
        }
        __syncthreads();
#pragma unroll
        for (int i = 0; i < 8; ++i) {
            const int row = (tid >> 4) + 32 * i, pc = tid & 15;
            if (row < nvalid) {
                const u32x4 v = *(const LAS u32x4*)(lds + row * 272 + pc * 16);
                *(u32x4*)(y + (size_t)((const LAS int*)(lds + LDS_ROWL))[row] * D + n0 + pc * 8) = v;
            }
        }
        __syncthreads();
    }
};
namespace pg8 {
#define PG8_LAS __attribute__((address_space(3)))
typedef unsigned short bf16_t;
typedef short bf16x8 __attribute__((ext_vector_type(8)));
typedef float f32x4 __attribute__((ext_vector_type(4)));
typedef unsigned u32x4 __attribute__((ext_vector_type(4)));
constexpr int BM = 256, BK = 64, HALF = 128, HTB = HALF * BK * 2  , STAGE_BYTES = 8 * HTB, NXCD = 8, WGM = 8;

__host__ __device__ __forceinline__ int lds_byte(int r, int c) { const int st = (r >> 4) * 2 + (c >> 5), rr = r & 15, cc = c & 31, ob = rr * 64 + cc * 2; return st * 1024 + (ob ^ (((ob >> 9) & 1) << 5)); }
__host__ __device__ __forceinline__ void stage_rc(int b, int& R, int& C) { const int st = b / 1024, sb = b % 1024, swz = sb ^ (((sb >> 9) & 1) << 5); R = (st >> 1) * 16 + swz / 64; C = (st & 1) * 32 + (swz % 64) / 2; }
__host__ __device__ __forceinline__ int perm32(int rho) { const int n = rho >> 4, i = rho & 15; return 8 * (i >> 2) + 4 * n + (i & 3); }

struct Unit { int pm, pn; };
struct Gemm { const bf16_t* A; const bf16_t* Bt; int M, N, K; };

struct StaticOrder {
    int nM, nN, nwg, G, c;
    __host__ __device__ void init(int M, int N, int G_, int c_) { nM = M / BM; nN = N / BM; nwg = nM * nN; G = G_; c = c_; }
    __host__ __device__ bool next(int i, Unit& u) const {
        const long L = (long)i * G + c; if (L >= nwg) return false;
        int wgid = (int)L; { const int q = nwg / NXCD, r = nwg % NXCD, xcd = wgid % NXCD, off = wgid / NXCD; wgid = (xcd < r ? xcd * (q + 1) : r * (q + 1) + (xcd - r) * q) + off; }
        const int nig = WGM * nN, gid = wgid / nig, fm = gid * WGM, gsz = (nM - fm) < WGM ? (nM - fm) : WGM;
        u.pm = fm + ((wgid % nig) % gsz); u.pn = (wgid % nig) / gsz; return true;
    }
    __device__ __forceinline__ void a_ready(const Unit&) const {}
    __device__ __forceinline__ void done(const Unit&) const {}
};

__device__ __forceinline__ unsigned cvt_pk_bf16(float lo, float hi) { unsigned r; asm volatile("v_cvt_pk_bf16_f32 %0, %1, %2" : "=v"(r) : "v"(lo), "v"(hi)); return r; }

template <class Epi, class Sched, bool ALIGN_EPI = false, bool SP2 = false>
__device__ __forceinline__ void gemm_phase(const int tid, PG8_LAS unsigned char* lds, const Gemm g, const Sched& S, const Epi& E) {
    const int wid = __builtin_amdgcn_readfirstlane(tid >> 6), lane = tid & 63, wr = wid >> 2, wc = wid & 3, fr = lane & 15, fq = lane >> 4;
    const int K = g.K, nt = K / BK;
    unsigned voffA[2], voffB[2];
#pragma unroll
    for (int i = 0; i < 2; ++i) { int R, C; stage_rc(tid * 16 + i * 8192, R, C); const int Rb = Epi::PERM ? ((R & ~31) + perm32(R & 31)) : R;
        voffA[i] = (unsigned)(R * K + C) * 2u; voffB[i] = (unsigned)(Rb * K + C) * 2u; }
    const size_t kstep = (size_t)(BK * 2);
    const size_t hstep = (size_t)HALF * K * 2;
    const size_t tstep = 2 * hstep;
    const unsigned ldsw = (unsigned)wid * 1024u;
    const int aoff = lds_byte(wr * 64 + fr, fq * 8), boff = lds_byte(wc * 32 + fr, fq * 8);
#define PG8_SA(b, h) (((b) * 2 + (h)) * HTB)
#define PG8_SB(b, h) ((4 + (b) * 2 + (h)) * HTB)
#define PG8_STAGE(bufoff, gbase, voff) do { _Pragma("unroll") for (int _i = 0; _i < 2; ++_i) \
        __builtin_amdgcn_global_load_lds((const unsigned*)((const char*)(gbase) + (voff)[_i]), (PG8_LAS unsigned*)(lds + (bufoff) + ldsw + _i * 8192), 16, 0, 0); } while (0)
#define PG8_LDA(dst, b, h) do { _Pragma("unroll") for (int m = 0; m < 4; ++m) _Pragma("unroll") for (int k = 0; k < 2; ++k) dst[m][k] = *(const PG8_LAS bf16x8*)(lds + PG8_SA(b, h) + aoff + m * 2048 + k * 1024); } while (0)
#define PG8_LDB(dst, b, h) do { _Pragma("unroll") for (int n = 0; n < 2; ++n) _Pragma("unroll") for (int k = 0; k < 2; ++k) dst[n][k] = *(const PG8_LAS bf16x8*)(lds + PG8_SB(b, h) + boff + n * 2048 + k * 1024); } while (0)
#define PG8_MMA(ai, bj, At, Bt) do { __builtin_amdgcn_s_setprio(1); _Pragma("unroll") for (int m = 0; m < 4; ++m) _Pragma("unroll") for (int n = 0; n < 2; ++n) _Pragma("unroll") for (int k = 0; k < 2; ++k) \
        acc[ai][bj][m][n] = __builtin_amdgcn_mfma_f32_16x16x32_bf16(Bt[n][k], At[m][k], acc[ai][bj][m][n], 0, 0, 0); __builtin_amdgcn_s_setprio(0); } while (0)
#define PG8_WAIT_V(n) asm volatile("s_waitcnt vmcnt(" #n ")" ::: "memory")
#define PG8_WAIT_L(n) asm volatile("s_waitcnt lgkmcnt(" #n ")" ::: "memory")
#define PG8_BAR __builtin_amdgcn_s_barrier()
#define PG8_SCHED __builtin_amdgcn_sched_barrier(0)
    Unit cur, nxt; int ui = 0;
    if (!S.next(0, cur)) return;
    f32x4 acc[2][2][4][2];
#pragma unroll
    for (int a = 0; a < 2; ++a)
#pragma unroll
        for (int b = 0; b < 2; ++b)
#pragma unroll
            for (int m = 0; m < 4; ++m)
#pragma unroll
                for (int n = 0; n < 2; ++n) acc[a][b][m][n] = (f32x4){0.f, 0.f, 0.f, 0.f};
    bf16x8 At[4][2], B0[2][2], B1[2][2];
    const char* cA = (const char*)g.A + (size_t)cur.pm * tstep; const char* cB = (const char*)g.Bt + (size_t)cur.pn * tstep;
    S.a_ready(cur);
    if constexpr (SP2) {
        PG8_STAGE(PG8_SB(0, 0), cB, voffB); PG8_STAGE(PG8_SB(0, 1), cB + hstep, voffB); PG8_STAGE(PG8_SA(0, 0), cA, voffA); PG8_STAGE(PG8_SA(0, 1), cA + hstep, voffA);
        if (wr == 1) PG8_BAR;
        PG8_WAIT_V(2); PG8_BAR;
        PG8_STAGE(PG8_SB(1, 0), cB + kstep, voffB); PG8_STAGE(PG8_SA(1, 0), cA + kstep, voffA); PG8_STAGE(PG8_SB(1, 1), cB + hstep + kstep, voffB);
        PG8_WAIT_V(6); PG8_BAR;
    } else {
        PG8_STAGE(PG8_SB(0, 0), cB, voffB); PG8_STAGE(PG8_SA(0, 0), cA, voffA); PG8_STAGE(PG8_SB(0, 1), cB + hstep, voffB); PG8_STAGE(PG8_SA(0, 1), cA + hstep, voffA);
        if (wr == 1) PG8_BAR;
        PG8_WAIT_V(4); PG8_BAR;
        PG8_STAGE(PG8_SB(1, 0), cB + kstep, voffB); PG8_STAGE(PG8_SA(1, 0), cA + kstep, voffA); PG8_STAGE(PG8_SB(1, 1), cB + hstep + kstep, voffB);
        PG8_WAIT_V(6); PG8_BAR;
    }
    for (;;) {
        const bool has_next = S.next(ui + 1, nxt);
        const char* nA = has_next ? (const char*)g.A + (size_t)nxt.pm * tstep : cA; const char* nB = has_next ? (const char*)g.Bt + (size_t)nxt.pn * tstep : cB;
        for (int t = 0; t < nt; t += 2) {
            const bool last = (t == nt - 2);
            const char* a1 = cA + (size_t)(t + 1) * kstep;
            const char* a2 = last ? nA : cA + (size_t)(t + 2) * kstep; const char* b2 = last ? nB : cB + (size_t)(t + 2) * kstep;
            const char* a3 = a2 + kstep; const char* b3 = b2 + kstep;
            if (last && has_next) S.a_ready(nxt);
            if constexpr (SP2) {
            PG8_LDB(B0, 0, 0); PG8_LDB(B1, 0, 1); PG8_SCHED; PG8_LDA(At, 0, 0); PG8_STAGE(PG8_SA(1, 1), a1 + hstep, voffA);
            PG8_WAIT_V(8); PG8_WAIT_L(0); PG8_BAR; PG8_MMA(0, 0, At, B0); PG8_MMA(0, 1, At, B1); PG8_BAR; PG8_SCHED;
            PG8_LDA(At, 0, 1); PG8_STAGE(PG8_SB(0, 0), b2, voffB); PG8_STAGE(PG8_SB(0, 1), b2 + hstep, voffB); PG8_STAGE(PG8_SA(0, 0), a2, voffA);
            PG8_WAIT_V(8); PG8_WAIT_L(0); PG8_BAR; PG8_MMA(1, 0, At, B0); PG8_MMA(1, 1, At, B1); PG8_BAR; PG8_SCHED;
            PG8_LDB(B0, 1, 0); PG8_LDB(B1, 1, 1); PG8_SCHED; PG8_LDA(At, 1, 0); PG8_STAGE(PG8_SA(0, 1), a2 + hstep, voffA);
            PG8_WAIT_V(8); PG8_WAIT_L(0); PG8_BAR; PG8_MMA(0, 0, At, B0); PG8_MMA(0, 1, At, B1); PG8_BAR; PG8_SCHED;
            PG8_LDA(At, 1, 1); PG8_STAGE(PG8_SB(1, 0), b3, voffB); PG8_STAGE(PG8_SB(1, 1), b3 + hstep, voffB); PG8_STAGE(PG8_SA(1, 0), a3, voffA);
            PG8_WAIT_V(8); PG8_WAIT_L(0); PG8_BAR; PG8_MMA(1, 0, At, B0); PG8_MMA(1, 1, At, B1); PG8_BAR; PG8_SCHED;
            } else {
            PG8_LDB(B0, 0, 0); PG8_SCHED; PG8_LDA(At, 0, 0); PG8_STAGE(PG8_SA(1, 1), a1 + hstep, voffA);
            PG8_WAIT_L(8); PG8_BAR; PG8_WAIT_L(0); PG8_MMA(0, 0, At, B0); PG8_BAR; PG8_SCHED;
            PG8_LDB(B1, 0, 1); PG8_STAGE(PG8_SB(0, 0), b2, voffB);
            PG8_BAR; PG8_WAIT_L(0); PG8_MMA(0, 1, At, B1); PG8_BAR;
            PG8_LDA(At, 0, 1); PG8_STAGE(PG8_SA(0, 0), a2, voffA);
            PG8_BAR; PG8_WAIT_L(0); PG8_MMA(1, 0, At, B0); PG8_BAR; PG8_SCHED;
            PG8_STAGE(PG8_SB(0, 1), b2 + hstep, voffB);
            PG8_WAIT_V(6); PG8_BAR; PG8_MMA(1, 1, At, B1); PG8_BAR;
            PG8_LDB(B0, 1, 0); PG8_SCHED; PG8_LDA(At, 1, 0); PG8_STAGE(PG8_SA(0, 1), a2 + hstep, voffA);
            PG8_WAIT_L(8); PG8_BAR; PG8_WAIT_L(0); PG8_MMA(0, 0, At, B0); PG8_BAR; PG8_SCHED;
            PG8_LDB(B1, 1, 1); PG8_STAGE(PG8_SB(1, 0), b3, voffB);
            PG8_BAR; PG8_WAIT_L(0); PG8_MMA(0, 1, At, B1); PG8_BAR;
            PG8_LDA(At, 1, 1); PG8_STAGE(PG8_SA(1, 0), a3, voffA);
            PG8_BAR; PG8_WAIT_L(0); PG8_MMA(1, 0, At, B0); PG8_BAR; PG8_SCHED;
            PG8_STAGE(PG8_SB(1, 1), b3 + hstep, voffB);
            PG8_WAIT_V(6); PG8_BAR; PG8_MMA(1, 1, At, B1); PG8_BAR;
            }
        }
        if constexpr (ALIGN_EPI) { if (wr == 0) PG8_BAR; }
        if constexpr (!Epi::AFTER_DRAIN) { E(acc, cur, wr, wc, fr, fq); S.done(cur); }
        if (!has_next) break;
#pragma unroll
        for (int a = 0; a < 2; ++a)
#pragma unroll
            for (int b = 0; b < 2; ++b)
#pragma unroll
                for (int m = 0; m < 4; ++m)
#pragma unroll
                    for (int n = 0; n < 2; ++n) acc[a][b][m][n] = (f32x4){0.f, 0.f, 0.f, 0.f};
        cur = nxt; cA = nA; cB = nB; ++ui;
        if constexpr (ALIGN_EPI) { if (wr == 1) PG8_BAR; }
    }
    PG8_WAIT_V(0);
    if constexpr (!ALIGN_EPI) { if (wr == 0) PG8_BAR; }
    PG8_BAR;
    if constexpr (Epi::AFTER_DRAIN) { E.fused(acc, cur, wr, wc, fr, fq, lds, wid, lane); S.done(cur); }
#undef PG8_SA
#undef PG8_SB
#undef PG8_STAGE
#undef PG8_LDA
#undef PG8_LDB
#undef PG8_MMA
#undef PG8_WAIT_V
#undef PG8_WAIT_L
#undef PG8_BAR
#undef PG8_SCHED
}

struct PEpiQK {
    static constexpr bool PERM = true, AFTER_DRAIN = false;
    bf16_t* q; bf16_t* k; const float* bias;
    __device__ __forceinline__ void operator()(const f32x4 (&acc)[2][2][4][2], const Unit& u, int wr, int wc, int fr, int fq) const {
        const int row0 = u.pm * BM + wr * 64 + fr, colt = u.pn * BM;
        const bool isq = colt < 2048; const float sc = isq ? 0.125f : 1.f;
        const int cbase = (isq ? colt : colt - 2048) + wc * 32 + 8 * fq, bcol = colt + wc * 32 + 8 * fq;
#pragma unroll
        for (int bj = 0; bj < 2; ++bj) {
            const f32x4 b0 = *(const f32x4*)(bias + bcol + bj * HALF), b1 = *(const f32x4*)(bias + bcol + bj * HALF + 4);
            const int kc = cbase + bj * HALF, hh = kc >> 6, d0 = kc & 63;
#pragma unroll
            for (int ai = 0; ai < 2; ++ai)
#pragma unroll
                for (int m = 0; m < 4; ++m) {
                    const f32x4 v0 = (acc[ai][bj][m][0] + b0) * sc, v1 = (acc[ai][bj][m][1] + b1) * sc;
                    u32x4 w; w.x = cvt_pk_bf16(v0[0], v0[1]); w.y = cvt_pk_bf16(v0[2], v0[3]); w.z = cvt_pk_bf16(v1[0], v1[1]); w.w = cvt_pk_bf16(v1[2], v1[3]);
                    const int tok = row0 + ai * HALF + m * 16;
                    if (isq) *(u32x4*)(q + (size_t)tok * 2048 + kc) = w;
                    else { const int R = tok >> 6, c = tok & 63;
                        *(u32x4*)(k + ((((((size_t)(R * 32 + hh) * 8 + (c >> 3)) * 2 + ((c >> 2) & 1)) * 2 + (d0 >> 5)) * 4 + (c & 3)) * 4 + ((d0 >> 3) & 3)) * 8) = w; }
                }
        }
    }
};
struct PEpiVT {
    static constexpr bool PERM = true, AFTER_DRAIN = false;
    bf16_t* vt; const float* bias;
    __device__ __forceinline__ void operator()(const f32x4 (&acc)[2][2][4][2], const Unit& u, int wr, int wc, int fr, int fq) const {
        const int row0 = u.pm * BM + wr * 64 + fr, col0 = u.pn * BM + wc * 32 + 8 * fq;
#pragma unroll
        for (int ai = 0; ai < 2; ++ai)
#pragma unroll
            for (int m = 0; m < 4; ++m) {
                const int c = row0 + ai * HALF + m * 16; const float b = bias[c];
#pragma unroll
                for (int bj = 0; bj < 2; ++bj) {
                    const f32x4 v0 = acc[ai][bj][m][0] + b, v1 = acc[ai][bj][m][1] + b;
                    u32x4 w; w.x = cvt_pk_bf16(v0[0], v0[1]); w.y = cvt_pk_bf16(v0[2], v0[3]); w.z = cvt_pk_bf16(v1[0], v1[1]); w.w = cvt_pk_bf16(v1[2], v1[3]);
                    { const int tok = col0 + bj * HALF, R = tok >> 6, cgp = (tok & 63) >> 3;
                      *(u32x4*)(vt + ((((size_t)(R * 32 + (c >> 6)) * 8 + cgp) * 64 + (c & 63)) * 8)) = w; }
                }
            }
    }
};
template <bool SB>
struct PEpiResid {
    static constexpr bool PERM = false, AFTER_DRAIN = false;
    const float* src; float* dst; const float* bias;
    __device__ __forceinline__ void operator()(const f32x4 (&acc)[2][2][4][2], const Unit& u, int wr, int wc, int fr, int fq) const {
        const int row0 = u.pm * BM + wr * 64 + fr, col0 = u.pn * BM + wc * 32 + 4 * fq;
        f32x4 bv[2][2];
#pragma unroll
        for (int bj = 0; bj < 2; ++bj)
#pragma unroll
            for (int n = 0; n < 2; ++n) bv[bj][n] = bias ? *(const f32x4*)(bias + col0 + bj * HALF + n * 16) : (f32x4){0.f, 0.f, 0.f, 0.f};
#pragma unroll
        for (int ai = 0; ai < 2; ++ai)
#pragma unroll
            for (int mh = 0; mh < 2; ++mh) {
                f32x4 sv[2][2][2];
#pragma unroll
                for (int ml = 0; ml < 2; ++ml)
#pragma unroll
                    for (int bj = 0; bj < 2; ++bj)
#pragma unroll
                        for (int n = 0; n < 2; ++n) {
                            const size_t o_ = (size_t)(row0 + ai * HALF + (mh * 2 + ml) * 16) * 2048 + col0 + bj * HALF + n * 16;
                            if (SB) { const unsigned long long q_ = *(const unsigned long long*)((const unsigned short*)src + o_); const unsigned lo_ = (unsigned)q_, hi_ = (unsigned)(q_ >> 32);
                                sv[ml][bj][n] = (f32x4){__builtin_bit_cast(float, lo_ << 16), __builtin_bit_cast(float, lo_ & 0xffff0000u), __builtin_bit_cast(float, hi_ << 16), __builtin_bit_cast(float, hi_ & 0xffff0000u)}; }
                            else sv[ml][bj][n] = *(const f32x4*)(src + o_);
                        }
                asm volatile("" ::: "memory");
#pragma unroll
                for (int ml = 0; ml < 2; ++ml)
#pragma unroll
                    for (int bj = 0; bj < 2; ++bj)
#pragma unroll
                        for (int n = 0; n < 2; ++n) *(f32x4*)(dst + (size_t)(row0 + ai * HALF + (mh * 2 + ml) * 16) * 2048 + col0 + bj * HALF + n * 16) = sv[ml][bj][n] + acc[ai][bj][mh * 2 + ml][n] + bv[bj][n];
                asm volatile("" ::: "memory");
            }
    }
};
struct PEpiRwkv {
    static constexpr bool PERM = true, AFTER_DRAIN = false;
    bf16_t* rkv;
    bf16_t* lw; bf16_t* la; bf16_t* gl;
    __device__ __forceinline__ void operator()(const f32x4 (&acc)[2][2][4][2], const Unit& u, int wr, int wc, int fr, int fq) const {
        const int which = u.pm >> 5, row0 = (u.pm & 31) * BM + wr * 64 + fr;
#pragma unroll
        for (int bj = 0; bj < 2; ++bj)
#pragma unroll
            for (int ai = 0; ai < 2; ++ai)
#pragma unroll
                for (int m = 0; m < 4; ++m) {
                    f32x4 v0 = acc[ai][bj][m][0], v1 = acc[ai][bj][m][1];
                    const int t = row0 + ai * HALF + m * 16;
                    bf16_t* dp;
                    if (which < 3) dp = rkv + (size_t)which * 8192 * 2048 + (size_t)t * 2048 + (u.pn - which * 8) * BM + bj * HALF + wc * 32 + 8 * fq;
                    else {
                        const int j = bj * HALF + wc * 32 + 8 * fq;
#pragma unroll
                        for (int e = 0; e < 4; ++e) {
                            if (which == 3) { v0[e] = tanhf_(v0[e]); v1[e] = tanhf_(v1[e]); }
                            else if (which == 5) { v0[e] = __builtin_amdgcn_rcpf(1.f + __expf(-v0[e])); v1[e] = __builtin_amdgcn_rcpf(1.f + __expf(-v1[e])); }
                        }
                        dp = which == 5 ? gl + (size_t)t * 256 + j : (which == 3 ? lw : la) + ((((size_t)(j >> 7) * 512 + (t >> 4)) * 4 + ((j & 127) >> 5)) * 64 + ((j >> 3) & 3) * 16 + (t & 15)) * 8;
                    }
                    u32x4 w; w.x = cvt_pk_bf16(v0[0], v0[1]); w.y = cvt_pk_bf16(v0[2], v0[3]); w.z = cvt_pk_bf16(v1[0], v1[1]); w.w = cvt_pk_bf16(v1[2], v1[3]);
                    *(u32x4*)dp = w;
                }
    }
};
struct PEpiPlain {
    static constexpr bool PERM = true, AFTER_DRAIN = false;
    bf16_t* dst;
    __device__ __forceinline__ void operator()(const f32x4 (&acc)[2][2][4][2], const Unit& u, int wr, int wc, int fr, int fq) const {
        const int row0 = u.pm * BM + wr * 64 + fr, col0 = u.pn * BM + wc * 32 + 8 * fq;
#pragma unroll
        for (int ai = 0; ai < 2; ++ai)
#pragma unroll
            for (int m = 0; m < 4; ++m)
#pragma unroll
                for (int bj = 0; bj < 2; ++bj) {
                    const f32x4 v0 = acc[ai][bj][m][0], v1 = acc[ai][bj][m][1];
                    u32x4 w; w.x = cvt_pk_bf16(v0[0], v0[1]); w.y = cvt_pk_bf16(v0[2], v0[3]); w.z = cvt_pk_bf16(v1[0], v1[1]); w.w = cvt_pk_bf16(v1[2], v1[3]);
                    *(u32x4*)(dst + (size_t)(row0 + ai * HALF + m * 16) * 2048 + col0 + bj * HALF) = w;
                }
    }
};
struct RwkvOrder {
    int G, c;
    __device__ bool next(int i, Unit& u) const {
        const int L = i * G + ((c & 7) * (G >> 3) + (c >> 3));
        if (L >= 864) return false;
        if (L < 768) { const int which = L >> 8, r = L & 255; u.pm = which * 32 + (r >> 3); u.pn = which * 8 + (r & 7); }
        else { const int r = L - 768, which = 3 + (r >> 5); u.pm = which * 32 + (r & 31); u.pn = 32 + (which - 3); }
        return true;
    }
    __device__ __forceinline__ void a_ready(const Unit&) const {}
    __device__ __forceinline__ void done(const Unit&) const {}
};
}

struct ConvJob { const float* src; bf16_t* dst; int ldn, Kreal, Nreal, k0, n0, ldk, mode; };
constexpr int CONV_LDS = 64 * 132 * 4;
__device__ __forceinline__ void conv_load(const int tid, const ConvJob& j, f32x4 (&w)[4]) {
    const int kq = tid >> 5, nc = (tid & 31) * 4;
#pragma unroll
    for (int i = 0; i < 4; ++i) {
        const int k = j.k0 + kq * 4 + i;
        w[i] = (f32x4){0.f, 0.f, 0.f, 0.f};
        if (k < j.Kreal && j.n0 + nc < j.Nreal) w[i] = __builtin_nontemporal_load((const f32x4*)(j.src + (size_t)k * j.ldn + j.n0 + nc));
    }
}
__device__ __forceinline__ void conv_stage(const int tid, LAS char* lb, const f32x4 (&w)[4]) {
    const int kq = tid >> 5, nc = (tid & 31) * 4;
#pragma unroll
    for (int i = 0; i < 4; ++i) *(LAS f32x4*)(lb + ((kq * 4 + i) * 132 + nc) * 4) = w[i];
}
__device__ __forceinline__ void conv_finish(const int tid, const LAS char* lb, const ConvJob& j) {
    const int n = tid >> 2, part = tid & 3;
    float w[16];
#pragma unroll
    for (int i = 0; i < 16; ++i) w[i] = *(const LAS float*)(lb + ((part * 16 + i) * 132 + n) * 4);
    u32x4 o0, o1;
    o0.x = pk2(w[0], w[1]); o0.y = pk2(w[2], w[3]); o0.z = pk2(w[4], w[5]); o0.w = pk2(w[6], w[7]);
    o1.x = pk2(w[8], w[9]); o1.y = pk2(w[10], w[11]); o1.z = pk2(w[12], w[13]); o1.w = pk2(w[14], w[15]);
    if (j.mode == 3) {
        const int nn = j.n0 + n, kk = j.k0 + part * 16;
        bf16_t* dp = j.dst + ((((size_t)(nn >> 4) * 4 + (kk >> 5)) * 64 + ((kk >> 3) & 3) * 16 + (nn & 15)) * 8);
        *(u32x4*)dp = o0; *(u32x4*)(dp + 128) = o1;
    } else {
        bf16_t* dp = j.dst + (size_t)(j.n0 + n) * j.ldk + j.k0 + part * 16;
        *(u32x4*)dp = o0; *(u32x4*)(dp + 8) = o1;
    }
}
__device__ __forceinline__ ConvJob conv_decode(CPar& p, int id) {
    unsigned char* ws = p.ws;
    if (id < 1536) { const int kt = id / 48, nt = id % 48; return ConvJob{p.in[4], (bf16_t*)(ws + WS_WQKV), 3 * D, D, 3 * D, kt * 64, nt * 128, D, 0}; }
    id -= 1536;
    if (id < 2560) {
        const int w = id / 512, r = id % 512, kt = r / 16, nt = r % 16;
        const float* src = w == 0 ? p.in[7] : w == 1 ? p.in[10] : w == 2 ? p.in[11] : w == 3 ? p.in[12] : p.in[13];
        const size_t off = w == 0 ? WS_WONA : w == 1 ? WS_WR : w == 2 ? WS_WK : w == 3 ? WS_WV : WS_WORW;
        return ConvJob{src, (bf16_t*)(ws + off), D, D, D, kt * 64, nt * 128, D, 0};
    }
    id -= 2560;
    if (id < 128) {
        const int which = id / 64, r = id % 64, z = r / 32, kt = r % 32;
        const float* src = (which == 0 ? p.in[15] : p.in[18]) + (size_t)z * D * 96;
        bf16_t* dst = (bf16_t*)(ws + (which == 0 ? WS_W1T : WS_A1T)) + (size_t)z * 128 * D;
        return ConvJob{src, dst, 96, D, 96, kt * 64, 0, D, 0};
    }
    id -= 128;
    if (id < 64) { const int kt = id / 2, nt = id % 2; return ConvJob{p.in[20], (bf16_t*)(ws + WS_G1T), 256, D, 256, kt * 64, nt * 128, D, 0}; }
    id -= 64;
    if (id < 128) {
        const int which = id / 64, r = id % 64, z = r / 32, r2 = r % 32, kt = r2 / 16, nt = r2 % 16;
        const float* src = (which == 0 ? p.in[16] : p.in[19]) + (size_t)z * 96 * D;
        bf16_t* dst = (bf16_t*)(ws + (which == 0 ? WS_W2T : WS_A2T)) + (size_t)z * D * 128;
        return ConvJob{src, dst, D, 96, D, kt * 64, nt * 128, 128, 3};
    }
    id -= 128;
    const int kt = id / 16, nt = id % 16;
    return ConvJob{p.in[21], (bf16_t*)(ws + WS_G2T), D, 256, D, kt * 64, nt * 128, 256, 0};
}
constexpr int N_CONV_JOBS = 1536 + 2560 + 128 + 64 + 128 + 64;

__device__ __forceinline__ void rms_row_bf16(const f32x4 (&x)[8], const LAS float* g, bf16_t* __restrict__ dst, int lane) {
    float ss = 0.f;
#pragma unroll
    for (int j = 0; j < 8; ++j) ss += x[j][0] * x[j][0] + x[j][1] * x[j][1] + x[j][2] * x[j][2] + x[j][3] * x[j][3];
    ss = wave_sum(ss);
    const float inv = rsqrtf(ss * (1.f / D) + 1e-6f);
#pragma unroll
    for (int j = 0; j < 8; ++j) {
        const f32x4 gv = *(const LAS f32x4*)(g + (j * 64 + lane) * 4);
        u32x2 o; o.x = pk2(x[j][0] * inv * gv[0], x[j][1] * inv * gv[1]); o.y = pk2(x[j][2] * inv * gv[2], x[j][3] * inv * gv[3]);
        *(u32x2*)(dst + (j * 64 + lane) * 4) = o;
    }
}

__device__ __forceinline__ void ph_prologue(CPar& p, LAS char* lds) {
    const int tid = otid();
    {
        int id = blockIdx.x, buf = 0;
        ConvJob cur{}; f32x4 w[4];
        if (id < N_CONV_JOBS) { cur = conv_decode(p, id); conv_load(tid, cur, w); }
        for (; id < N_CONV_JOBS; id += gridDim.x) {
            LAS char* lb = lds + buf * CONV_LDS;
            conv_stage(tid, lb, w);
            __syncthreads();
            ConvJob nxt = cur;
            if (id + (int)gridDim.x < N_CONV_JOBS) { nxt = conv_decode(p, id + gridDim.x); conv_load(tid, nxt, w); }
            conv_finish(tid, lb, cur);
            cur = nxt; buf ^= 1;
        }
    }
    {
        float* rgf = (float*)(p.ws + WS_RGF); float* ref = (float*)(p.ws + WS_REF);
        for (int i = blockIdx.x * NTHR + tid; i < 2 * 8 * 4 * 64; i += gridDim.x * NTHR) {
            const int ln = i & 63, c = (i >> 6) & 3, j = (i >> 8) & 7, layer = i >> 11, d = (j * 64 + ln) * 4 + c;
            *(f32x4*)(rgf + (size_t)i * 4) = *(const f32x4*)(p.in[27] + ((size_t)layer * D + d) * 4);
        }
        for (int i = blockIdx.x * NTHR + tid; i < 2 * 4 * 8 * 4 * 2 * 64; i += gridDim.x * NTHR) {
            const int ln = i & 63, hf = (i >> 6) & 1, c = (i >> 7) & 3, j = (i >> 9) & 7, gq = (i >> 12) & 3, layer = i >> 14, d = (j * 64 + ln) * 4 + c;
            *(f32x4*)(ref + (size_t)i * 4) = *(const f32x4*)(p.in[29] + (((size_t)layer * 4 + gq) * D + d) * 8 + hf * 4);
        }
    }
    const int lane = tid & 63, gw = blockIdx.x * 8 + (tid >> 6), nw = gridDim.x * 8;
    bf16_t* hn = (bf16_t*)(p.ws + WS_HN);
    __syncthreads();
    LAS float* lg = (LAS float*)lds;
    for (int i = tid; i < D / 4; i += NTHR) *(LAS f32x4*)(lg + i * 4) = *(const f32x4*)(p.in[1] + i * 4);
    __syncthreads();
    f32x4 x[8], xn[8];
    if (gw < T) {
#pragma unroll
        for (int j = 0; j < 8; ++j) x[j] = *(const f32x4*)(p.in[0] + (size_t)gw * D + (j * 64 + lane) * 4);
    }
    for (int t = gw; t < T; t += nw) {
        const int tn = t + nw < T ? t + nw : t;
#pragma unroll
        for (int j = 0; j < 8; ++j) xn[j] = *(const f32x4*)(p.in[0] + (size_t)tn * D + (j * 64 + lane) * 4);
        rms_row_bf16(x, lg, hn + (size_t)t * D, lane);
#pragma unroll
        for (int j = 0; j < 8; ++j) x[j] = xn[j];
    }
}

__device__ __forceinline__ void ph_qkv(CPar& p, LAS char* lds) {
    const int tid = otid();
    const bf16_t* hn = (const bf16_t*)(p.ws + WS_HN); const bf16_t* w = (const bf16_t*)(p.ws + WS_WQKV);
    {
        pg8::Gemm g{hn, w, T, 2 * D, D}; pg8::StaticOrder S; S.init(T, 2 * D, (int)gridDim.x, (int)blockIdx.x);
        pg8::PEpiQK E{(bf16_t*)(p.ws + WS_Q), (bf16_t*)(p.ws + WS_K), p.in[5]};
        pg8::gemm_phase<pg8::PEpiQK, pg8::StaticOrder, true, true>(tid, (LAS unsigned char*)lds, g, S, E);
    }
    {
        pg8::Gemm g{w + (size_t)2 * D * D, hn, D, T, D}; pg8::StaticOrder S; S.init(D, T, (int)gridDim.x, (int)blockIdx.x);
        pg8::PEpiVT E{(bf16_t*)(p.ws + WS_VT), p.in[5] + 2 * D};
        pg8::gemm_phase<pg8::PEpiVT, pg8::StaticOrder, true, true>(tid, (LAS unsigned char*)lds, g, S, E);
    }
}

template <int OFF>
__device__ __forceinline__ void attn_pair(const int lane, const bf16_t* __restrict__ Q, const bf16_t* __restrict__ Kp, const bf16_t* __restrict__ Vt, bf16_t* __restrict__ AO,
                                          const LAS float* rb, const int r0, const int h, const int cb, const int rs0) {
    constexpr int NR = 8 + OFF;
    const int qi = lane & 15, g = lane >> 4;
    int bs = cb * 16 - 8; bs = bs < 0 ? 0 : (bs > 32 ? 32 : bs);
    const int qc = cb * 16 + qi;
    int wsx = qc - 8; wsx = wsx < 0 ? 0 : (wsx > 48 ? 48 : wsx);
    const size_t tq = (size_t)r0 * GW + qc;
    bf16x8 qf[2][2];
#pragma unroll
    for (int q = 0; q < 2; ++q) {
        qf[q][0] = *(const bf16x8*)(Q + (tq + q * GW) * D + h * HD + 8 * g);
        qf[q][1] = *(const bf16x8*)(Q + (tq + q * GW) * D + h * HD + 32 + 8 * g);
    }
    f32x4 s[2][8][2];
#pragma unroll
    for (int i = 0; i < NR; ++i)
#pragma unroll
        for (int tt = 0; tt < 2; ++tt) {
            const bf16_t* kp = Kp + ((((((size_t)((rs0 + i) * 32 + h) * 8 + (bs >> 3) + (qi >> 2)) * 2 + tt) * 2) * 4 + (qi & 3)) * 4 + g) * 8;
            const bf16x8 kf0 = *(const bf16x8*)kp;
            const bf16x8 kf1 = *(const bf16x8*)(kp + 128);
            if (i < 8) {
                f32x4 a = {0.f, 0.f, 0.f, 0.f};
                a = __builtin_amdgcn_mfma_f32_16x16x32_bf16(kf0, qf[0][0], a, 0, 0, 0);
                a = __builtin_amdgcn_mfma_f32_16x16x32_bf16(kf1, qf[0][1], a, 0, 0, 0);
                s[0][i][tt] = a;
            }
            if (i >= OFF) {
                f32x4 a = {0.f, 0.f, 0.f, 0.f};
                a = __builtin_amdgcn_mfma_f32_16x16x32_bf16(kf0, qf[1][0], a, 0, 0, 0);
                a = __builtin_amdgcn_mfma_f32_16x16x32_bf16(kf1, qf[1][1], a, 0, 0, 0);
                s[1][i - OFF][tt] = a;
            }
        }
    int relx[2][4]; bool okc[2][4];
#pragma unroll
    for (int tt = 0; tt < 2; ++tt)
#pragma unroll
        for (int e = 0; e < 4; ++e) {
            const int kcol = bs + 8 * g + 4 * tt + e;
            int rel = kcol - qc; rel = rel < -15 ? -15 : (rel > 15 ? 15 : rel);
            relx[tt][e] = rel + 15; okc[tt][e] = (kcol >= wsx) && (kcol < wsx + 16);
        }
    float inv[2];
    u32x4 pw[2][8];
#pragma unroll
    for (int q = 0; q < 2; ++q) {
        float mx = -1e30f;
#pragma unroll
        for (int j = 0; j < 8; ++j) {
            const int ri = (rs0 + q * OFF + j) - (r0 + q) + 7;
#pragma unroll
            for (int tt = 0; tt < 2; ++tt)
#pragma unroll
                for (int e = 0; e < 4; ++e) {
                    const float bv = rb[ri * 31 + relx[tt][e]];
                    const float v = okc[tt][e] ? s[q][j][tt][e] + bv : -1e30f;
                    s[q][j][tt][e] = v; mx = fmaxf(mx, v);
                }
        }
        mx = fmaxf(mx, __shfl_xor(mx, 16)); mx = fmaxf(mx, __shfl_xor(mx, 32));
        float sum = 0.f;
#pragma unroll
        for (int j = 0; j < 8; ++j) {
            float pv[2][4];
#pragma unroll
            for (int tt = 0; tt < 2; ++tt)
#pragma unroll
                for (int e = 0; e < 4; ++e) { pv[tt][e] = __expf(s[q][j][tt][e] - mx); sum += pv[tt][e]; }
            pw[q][j].x = pk2(pv[0][0], pv[0][1]); pw[q][j].y = pk2(pv[0][2], pv[0][3]); pw[q][j].z = pk2(pv[1][0], pv[1][1]); pw[q][j].w = pk2(pv[1][2], pv[1][3]);
        }
        sum += __shfl_xor(sum, 16); sum += __shfl_xor(sum, 32);
        inv[q] = 1.f / sum;
    }
    f32x4 o[2][4];
#pragma unroll
    for (int q = 0; q < 2; ++q)
#pragma unroll
        for (int dt = 0; dt < 4; ++dt) o[q][dt] = (f32x4){0.f, 0.f, 0.f, 0.f};
#pragma unroll
    for (int i0 = 0; i0 < NR; i0 += 3) {
        u32x4 va[3][4];
#pragma unroll
        for (int ii = 0; ii < 3; ++ii)
            if (i0 + ii < NR) {
                const bf16_t* vp = Vt + (((size_t)((rs0 + i0 + ii) * 32 + h) * 8 + (bs >> 3) + g) * 64 + qi) * 8;
#pragma unroll
                for (int dt = 0; dt < 4; ++dt) va[ii][dt] = *(const u32x4*)(vp + dt * 128);
            }
#pragma unroll
        for (int ii = 0; ii < 3; ++ii)
            if (i0 + ii < NR) {
                const int i = i0 + ii;
                if (i < 8) {
                    const bf16x8 pf = __builtin_bit_cast(bf16x8, pw[0][i]);
#pragma unroll
                    for (int dt = 0; dt < 4; ++dt) o[0][dt] = __builtin_amdgcn_mfma_f32_16x16x32_bf16(__builtin_bit_cast(bf16x8, va[ii][dt]), pf, o[0][dt], 0, 0, 0);
                }
                if (i >= OFF) {
                    const bf16x8 pf = __builtin_bit_cast(bf16x8, pw[1][i - OFF]);
#pragma unroll
                    for (int dt = 0; dt < 4; ++dt) o[1][dt] = __builtin_amdgcn_mfma_f32_16x16x32_bf16(__builtin_bit_cast(bf16x8, va[ii][dt]), pf, o[1][dt], 0, 0, 0);
                }
            }
    }
#pragma unroll
    for (int q = 0; q < 2; ++q)
#pragma unroll
        for (int dt = 0; dt < 4; ++dt) {
            u32x2 ov; ov.x = pk2(o[q][dt][0] * inv[q], o[q][dt][1] * inv[q]); ov.y = pk2(o[q][dt][2] * inv[q], o[q][dt][3] * inv[q]);
            *(u32x2*)(AO + (tq + q * GW) * D + h * HD + dt * 16 + 4 * g) = ov;
        }
}
__device__ __forceinline__ void ph_attn(CPar& p, LAS char* lds) {
    const int tid = otid(), lane = tid & 63, gw = blockIdx.x * 8 + __builtin_amdgcn_readfirstlane(tid >> 6), nw = gridDim.x * 8;
    const bf16_t* Q = (const bf16_t*)(p.ws + WS_Q); const bf16_t* Kp = (const bf16_t*)(p.ws + WS_K); const bf16_t* Vt = (const bf16_t*)(p.ws + WS_VT);
    bf16_t* AO = (bf16_t*)(p.ws + WS_AO);
    LAS float* rpbs = (LAS float*)lds;
    {
        f32x4 tb[8];
#pragma unroll
        for (int k = 0; k < 8; ++k) { const int i4 = tid + k * NTHR; tb[k] = i4 < NH * 15 * 31 / 4 ? *(const f32x4*)(p.in[6] + i4 * 4) : (f32x4){0.f, 0.f, 0.f, 0.f}; }
#pragma unroll
        for (int k = 0; k < 8; ++k) { const int i4 = tid + k * NTHR; if (i4 < NH * 15 * 31 / 4) *(LAS f32x4*)(rpbs + i4 * 4) = tb[k]; }
    }
    __syncthreads();
    for (int u = gw; u < (ROWS / 2) * NH * 4; u += nw) {
        const int cb = u & 3, h = (u >> 2) & 31, r0 = (u >> 7) * 2;
        int rs0 = r0 - 4; rs0 = rs0 < 0 ? 0 : (rs0 > ROWS - 8 ? ROWS - 8 : rs0);
        int rs1 = r0 - 3; rs1 = rs1 < 0 ? 0 : (rs1 > ROWS - 8 ? ROWS - 8 : rs1);
        const LAS float* rb = rpbs + h * 15 * 31;
        if (rs1 != rs0) attn_pair<1>(lane, Q, Kp, Vt, AO, rb, r0, h, cb, rs0);
        else attn_pair<0>(lane, Q, Kp, Vt, AO, rb, r0, h, cb, rs0);
    }
}

template <bool SB>
__device__ __forceinline__ void ph_oproj(CPar& p, LAS char* lds, const bf16_t* A, const bf16_t* W, const float* bias, const float* src, float* dst) {
    const int tid = otid();
    pg8::Gemm g{A, W, T, D, D}; pg8::StaticOrder S; S.init(T, D, (int)gridDim.x, (int)blockIdx.x);
    pg8::PEpiResid<SB> E{src, dst, bias};
    pg8::gemm_phase<pg8::PEpiResid<SB>, pg8::StaticOrder, true, true>(tid, (LAS unsigned char*)lds, g, S, E);
}

__device__ __forceinline__ void ph_router(CPar& p, LAS char* lds, const float* __restrict__ h, int layer) {
    const int tid = otid(), lane = tid & 63, gw = blockIdx.x * 8 + (tid >> 6), nw = gridDim.x * 8;
    bf16_t* hn = (bf16_t*)(p.ws + WS_HN);
    const float* brg = p.in[28] + layer * 4;
    LAS float* g = (LAS float*)lds; LAS float* wrg = (LAS float*)(lds + 8192);
    {
        const float* gsrc = p.in[2] + layer * D; const float* wsrc = (const float*)(p.ws + WS_RGF) + (size_t)layer * 8 * 4 * 64 * 4;
        for (int i = tid; i < D / 4; i += NTHR) *(LAS f32x4*)(g + i * 4) = *(const f32x4*)(gsrc + i * 4);
        {
            f32x4 tb[4];
#pragma unroll
            for (int k = 0; k < 4; ++k) tb[k] = *(const f32x4*)(wsrc + (tid + k * NTHR) * 4);
#pragma unroll
            for (int k = 0; k < 4; ++k) *(LAS f32x4*)(wrg + (tid + k * NTHR) * 4) = tb[k];
        }
        __syncthreads();
    }
    const float* wre = (const float*)(p.ws + WS_REF) + (size_t)layer * 4 * 8 * 4 * 2 * 64 * 4; const float* bre = p.in[30] + layer * 32;
    unsigned* cnt = (unsigned*)(p.ws + WS_CTL) + (layer ? CW_CNT1 : CW_CNT0);
    int* list = (int*)(p.ws + WS_LIST) + (size_t)layer * NEXP * T;
    float* cw = (float*)(p.ws + WS_CW) + (size_t)layer * 2 * T;
    for (int t0 = gw; t0 < T; t0 += 2 * nw) {
        const float* hrow[2]; float inv[2];
#pragma unroll
        for (int k = 0; k < 2; ++k) hrow[k] = h + (size_t)(t0 + k * nw) * D;
        {
            float ss[2] = {0.f, 0.f};
#pragma unroll 2
            for (int j = 0; j < 8; ++j)
#pragma unroll
                for (int k = 0; k < 2; ++k) { const f32x4 xv = *(const f32x4*)(hrow[k] + (j * 64 + lane) * 4); ss[k] += xv[0] * xv[0] + xv[1] * xv[1] + xv[2] * xv[2] + xv[3] * xv[3]; }
#pragma unroll
            for (int k = 0; k < 2; ++k) inv[k] = rsqrtf(wave_sum(ss[k]) * (1.f / D) + 1e-6f);
        }
        float gl[2][4];
#pragma unroll
        for (int k = 0; k < 2; ++k)
#pragma unroll
            for (int e = 0; e < 4; ++e) gl[k][e] = 0.f;
#pragma unroll 4
        for (int j = 0; j < 8; ++j) {
            const int d0 = (j * 64 + lane) * 4;
            const f32x4 gv = *(const LAS f32x4*)(g + d0);
            f32x4 wr4[4];
#pragma unroll
            for (int c = 0; c < 4; ++c) wr4[c] = *(const LAS f32x4*)(wrg + ((j * 4 + c) * 64 + lane) * 4);
#pragma unroll
            for (int k = 0; k < 2; ++k) {
                f32x4 xv = *(const f32x4*)(hrow[k] + d0);
                xv[0] *= inv[k] * gv[0]; xv[1] *= inv[k] * gv[1]; xv[2] *= inv[k] * gv[2]; xv[3] *= inv[k] * gv[3];
                u32x2 o; o.x = pk2(xv[0], xv[1]); o.y = pk2(xv[2], xv[3]);
                *(u32x2*)(hn + (size_t)(t0 + k * nw) * D + d0) = o;
#pragma unroll
                for (int c = 0; c < 4; ++c) { gl[k][0] += xv[c] * wr4[c][0]; gl[k][1] += xv[c] * wr4[c][1]; gl[k][2] += xv[c] * wr4[c][2]; gl[k][3] += xv[c] * wr4[c][3]; }
            }
        }
        int gi[2]; float gwt[2];
#pragma unroll
        for (int k = 0; k < 2; ++k) {
            const float l0 = wave_sum(gl[k][0]) + brg[0], l1 = wave_sum(gl[k][1]) + brg[1], l2 = wave_sum(gl[k][2]) + brg[2], l3 = wave_sum(gl[k][3]) + brg[3];
            int gq = 0; float gm = l0;
            if (l1 > gm) { gm = l1; gq = 1; }
            if (l2 > gm) { gm = l2; gq = 2; }
            if (l3 > gm) { gm = l3; gq = 3; }
            gwt[k] = 1.f / (__expf(l0 - gm) + __expf(l1 - gm) + __expf(l2 - gm) + __expf(l3 - gm));
            gi[k] = __builtin_amdgcn_readfirstlane(gq);
        }
        float el[2][8];
#pragma unroll
        for (int k = 0; k < 2; ++k)
#pragma unroll
            for (int e = 0; e < 8; ++e) el[k][e] = 0.f;
#pragma unroll 2
        for (int j = 0; j < 8; ++j) {
            const int d0 = (j * 64 + lane) * 4;
            const f32x4 gv = *(const LAS f32x4*)(g + d0);
#pragma unroll
            for (int k = 0; k < 2; ++k) {
                const float* we = wre + (size_t)gi[k] * 8 * 4 * 2 * 64 * 4;
                f32x4 xv = *(const f32x4*)(hrow[k] + d0);
                xv[0] *= inv[k] * gv[0]; xv[1] *= inv[k] * gv[1]; xv[2] *= inv[k] * gv[2]; xv[3] *= inv[k] * gv[3];
#pragma unroll
                for (int c = 0; c < 4; ++c) {
                    const f32x4 w0 = *(const f32x4*)(we + ((size_t)((j * 4 + c) * 2) * 64 + lane) * 4), w1 = *(const f32x4*)(we + ((size_t)((j * 4 + c) * 2 + 1) * 64 + lane) * 4);
                    el[k][0] += xv[c] * w0[0]; el[k][1] += xv[c] * w0[1]; el[k][2] += xv[c] * w0[2]; el[k][3] += xv[c] * w0[3];
                    el[k][4] += xv[c] * w1[0]; el[k][5] += xv[c] * w1[1]; el[k][6] += xv[c] * w1[2]; el[k][7] += xv[c] * w1[3];
                }
            }
        }
#pragma unroll
        for (int k = 0; k < 2; ++k) {
            const int t = t0 + k * nw;
            int i1 = 0; float m1 = -1e30f;
#pragma unroll
            for (int e = 0; e < 8; ++e) { el[k][e] = wave_sum(el[k][e]) + bre[gi[k] * 8 + e]; if (el[k][e] > m1) { m1 = el[k][e]; i1 = e; } }
            int i2 = 0; float m2 = -1e30f;
#pragma unroll
            for (int e = 0; e < 8; ++e) { if (e != i1 && el[k][e] > m2) { m2 = el[k][e]; i2 = e; } }
            const float e21 = __expf(m2 - m1);
            const float w1 = 1.f / (1.f + e21), w2 = e21 / (1.f + e21);
            if (lane == 0) {
                const int ea = gi[k] * 8 + i1, eb = gi[k] * 8 + i2;
                const unsigned pa = atomicAdd(&cnt[ea * CNS], 1u); list[ea * T + pa] = 2 * t; cw[2 * t] = gwt[k] * w1;
                const unsigned pb = atomicAdd(&cnt[eb * CNS], 1u); list[eb * T + pb] = 2 * t + 1; cw[2 * t + 1] = gwt[k] * w2;
            }
        }
    }
}

__device__ __forceinline__ void moe_prefix(const int tid, CPar& p, LAS char* lds, int layer) {
    const unsigned* cnt = (const unsigned*)(p.ws + WS_CTL) + (layer ? CW_CNT1 : CW_CNT0);
    LAS int* pref = (LAS int*)(lds + LDS_PREF);
    __syncthreads();
    if (tid < 64) {
        const int n = tid < NEXP ? (int)((cnt[tid * CNS] + 255u) >> 8) : 0;
        int incl = n;
#pragma unroll
        for (int o = 1; o < 64; o <<= 1) { const int v = __shfl_up(incl, o); if (tid >= o) incl += v; }
        const int excl = incl - n;
        if (tid <= NEXP) pref[tid] = excl;
        LAS int* te = (LAS int*)(lds + LDS_TILE_E);
        for (int k = 0; k < n; ++k) te[excl + k] = tid;
    }
    __syncthreads();
}
__device__ __forceinline__ void ph_moe(CPar& p, LAS char* lds, int layer) {
    const int tid0 = otid();
    moe_prefix(tid0, p, lds, layer);
    LAS int* pref = (LAS int*)(lds + LDS_PREF);
    LAS int* curp = (LAS int*)(lds + LDS_MOEQ);
    const unsigned* cnt = (const unsigned*)(p.ws + WS_CTL) + (layer ? CW_CNT1 : CW_CNT0);
    gu32* qh = (gu32*)((unsigned*)(p.ws + WS_CTL) + CW_MOEQ + layer * 64);
    gu32* mtc0 = (gu32*)((unsigned*)(p.ws + WS_CTL) + CW_MOEMT + layer * 4096);
    unsigned* tmo = (unsigned*)(p.ws + WS_CTL) + CW_BAR + XB_TMO;
    const int* list = (const int*)(p.ws + WS_LIST) + (size_t)layer * NEXP * T;
    const float* cw = (const float*)(p.ws + WS_CW) + (size_t)layer * 2 * T;
    const bf16_t* hn = (const bf16_t*)(p.ws + WS_HN);
    bf16_t* act = (bf16_t*)(p.ws + (layer ? WS_ACT1 : WS_ACT));
    const int ntile = pref[NEXP], ngu = ntile * 8, total = ntile * 24;
    const int qbase = (int)gridDim.x;
    int cur = (int)blockIdx.x;
    while (cur < total) {
        int tid = tid0; asm volatile("" : "+v"(tid));
        unsigned nxt = 0u;
        if (tid == 0) { int z = 0; asm volatile("" : "+v"(z)); nxt = __hip_atomic_fetch_add(qh + z, 1u, __ATOMIC_RELAXED, __HIP_MEMORY_SCOPE_AGENT) + (unsigned)qbase; }
        if (cur < ngu) {
            const int mt = cur >> 3, j = cur & 7;
            const int e = ((LAS int*)(lds + LDS_TILE_E))[mt];
            const int lt = mt - pref[e];
            const int nvalid = min(256, (int)cnt[e * CNS] - lt * 256);
            const int* rows = list + e * T + lt * 256;
            const int rho0 = (tid & 31) * 4;
            const float* wsrc = ((rho0 >> 5) & 1 ? p.in[32] : p.in[31]) + (size_t)(layer * NEXP + e) * D * FF + j * 64 + (rho0 >> 6) * 32 + (rho0 & 31);
            EpiMoeGU3 ep{act, cw, rows, nvalid, j * 64, lds, tid, mtc0 + mt * 32};
            gemm_tile_moe(tid, lds, hn, D, rows, nvalid, 1, wsrc, FF, D, ep);
        } else {
            const int d = cur - ngu, mt = d >> 4, pn = d & 15;
            if ((tid >> 6) == 0) {
                gu32* c = mtc0 + mt * 32;
                unsigned sp = 0u;
                while ((unsigned)__builtin_amdgcn_readfirstlane(__hip_atomic_load(c, __ATOMIC_RELAXED, __HIP_MEMORY_SCOPE_AGENT)) < 64u) {
                    __builtin_amdgcn_s_sleep(1);
                    if ((++sp & 255u) == 0u) { if (xb_ld(tmo)) break; if (sp > XB_SPIN_CAP) { atomicAdd(tmo, 1u); break; } }
                }
                __builtin_amdgcn_fence(__ATOMIC_ACQUIRE, "agent");
                asm volatile("s_waitcnt vmcnt(0)" ::: "memory");
            }
            __syncthreads();
            const int e = ((LAS int*)(lds + LDS_TILE_E))[mt];
            const int lt = mt - pref[e];
            const int nvalid = min(256, (int)cnt[e * CNS] - lt * 256);
            const int* rows = list + e * T + lt * 256;
            const float* wsrc = p.in[33] + (size_t)(layer * NEXP + e) * FF * D + pn * 128 + (tid & 31) * 4;
            EpiMoeD2 ep{(bf16_t*)(p.ws + WS_Y), rows, nvalid, pn * 128, lds, tid};
            gemm_tile_moe(tid, lds, act, FF, rows, nvalid, 0, wsrc, D, FF, ep);
        }
        if (tid == 0) curp[0] = (int)nxt;
        __syncthreads();
        cur = __builtin_amdgcn_readfirstlane(curp[0]);
    }
}

__device__ __forceinline__ void ph_combine_mix(CPar& p, LAS char* lds) {
    const int tid = otid(), lane = tid & 63, gw = blockIdx.x * 8 + (tid >> 6), nw = gridDim.x * 8;
    const float* h1 = p.out; float* h2 = (float*)(p.ws + WS_HB);
    const bf16_t* y = (const bf16_t*)(p.ws + WS_Y); const float* g = p.in[1] + D; bf16_t* mixo = (bf16_t*)(p.ws + WS_MIX); const float* mix = p.in[9];
    LAS float* lg = (LAS float*)lds; LAS float* lmix = (LAS float*)(lds + 8192);
    for (int i = tid; i < D / 4; i += NTHR) *(LAS f32x4*)(lg + i * 4) = *(const f32x4*)(g + i * 4);
    {
        f32x4 tb[6];
#pragma unroll
        for (int k = 0; k < 6; ++k) tb[k] = *(const f32x4*)(mix + (tid + k * NTHR) * 4);
#pragma unroll
        for (int k = 0; k < 6; ++k) *(LAS f32x4*)(lmix + (tid + k * NTHR) * 4) = tb[k];
    }
    __syncthreads();
#define CM_ROW(dst, r, own) do { const int r_ = (r); \
        if (r_ < 0 || r_ >= T) { _Pragma("unroll") for (int j = 0; j < 8; ++j) dst[j] = (f32x4){0.f, 0.f, 0.f, 0.f}; } \
        else { float ss = 0.f; \
            _Pragma("unroll") for (int j = 0; j < 8; ++j) { const int d0 = (j * 64 + lane) * 4; \
                f32x4 x = *(const f32x4*)(h1 + (size_t)r_ * D + d0); \
                const u32x2 a = *(const u32x2*)(y + (size_t)(2 * r_) * D + d0), bq = *(const u32x2*)(y + (size_t)(2 * r_ + 1) * D + d0); \
                x[0] += bflo(a.x) + bflo(bq.x); x[1] += bfhi(a.x) + bfhi(bq.x); x[2] += bflo(a.y) + bflo(bq.y); x[3] += bfhi(a.y) + bfhi(bq.y); \
                if (own) { u32x2 hb_; hb_.x = pk2(x[0], x[1]); hb_.y = pk2(x[2], x[3]); __builtin_nontemporal_store(hb_, (u32x2*)((bf16_t*)h2 + (size_t)r_ * D + d0)); } \
                ss += x[0] * x[0] + x[1] * x[1] + x[2] * x[2] + x[3] * x[3]; dst[j] = x; } \
            const float inv = rsqrtf(wave_sum(ss) * (1.f / D) + 1e-6f); \
            _Pragma("unroll") for (int j = 0; j < 8; ++j) { const f32x4 gv = *(const LAS f32x4*)(lg + (j * 64 + lane) * 4); dst[j] = dst[j] * gv * inv; } } } while (0)
    for (int run = gw; run < T / 4; run += nw) {
        const int t0 = run * 4;
        f32x4 pv[8], cu[8], nx[8];
        CM_ROW(pv, t0 - 1, false);
        CM_ROW(cu, t0, true);
#pragma unroll 1
        for (int i = 0; i < 4; ++i) {
            const int t = t0 + i;
            CM_ROW(nx, t + 1, i < 3);
            unsigned mo = 8192u; asm volatile("" : "+s"(mo));
            const LAS float* mx = (const LAS float*)(lds + mo);
#pragma unroll
            for (int j = 0; j < 8; ++j) {
                const int d0 = (j * 64 + lane) * 4;
                const f32x4 xx = (pv[j] + nx[j]) * 0.5f - cu[j];
#pragma unroll
                for (int m = 0; m < 6; ++m) {
                    const f32x4 mv = *(const LAS f32x4*)(mx + m * D + d0);
                    const f32x4 o = cu[j] + xx * mv;
                    u32x2 ov; ov.x = pk2(o[0], o[1]); ov.y = pk2(o[2], o[3]);
                    const int slot = m == 1 ? 3 : (m == 2 ? 1 : (m == 3 ? 2 : m));
                    __builtin_nontemporal_store(ov, (u32x2*)(mixo + ((size_t)slot * T + t) * D + d0));
                }
                pv[j] = cu[j]; cu[j] = nx[j];
            }
        }
    }
#undef CM_ROW
}
__device__ __forceinline__ void ph_rwkv_proj(CPar& p, LAS char* lds) {
    const int tid = otid();
    pg8::Gemm g{(const bf16_t*)(p.ws + WS_MIX), (const bf16_t*)(p.ws + WS_WR), 6 * T, 35 * 256, D};
    pg8::RwkvOrder S{(int)gridDim.x, (int)blockIdx.x};
    pg8::PEpiRwkv E{(bf16_t*)(p.ws + WS_R), (bf16_t*)(p.ws + WS_LW), (bf16_t*)(p.ws + WS_LA), (bf16_t*)(p.ws + WS_GL)};
    pg8::gemm_phase<pg8::PEpiRwkv, pg8::RwkvOrder, true, true>(tid, (LAS unsigned char*)lds, g, S, E);
}
__device__ __forceinline__ unsigned toff(int row, int col) { return (unsigned)(row * 128 + ((((col >> 3) ^ (row >> 1)) & 7) << 4) + (col & 7) * 2); }
constexpr unsigned T_AQ = 0, T_RQ = 8192, T_BK = 16384, T_KK = 24576, T_V = 32768, T_L = 40960, T_DL = 49152  ,
                   T_TII = 53248  , T_MAK = 55296, T_MRB = 63488, T_MRK = 71680, T_ZS = 79872,
                   T_W0A = T_AQ, T_W0B = T_MAK,
                   T_LIN = 40960, T_AS = 57344;
__device__ __forceinline__ f32x4 tile_mm(LAS char* lds, unsigned abase, unsigned bbase, int mblk, int nblk, int l15, int g, f32x4 acc, int nks) {
    for (int ks = 0; ks < nks; ++ks) {
        const bf16x8 a = *(const LAS bf16x8*)(lds + abase + toff(mblk * 16 + l15, ks * 32 + 8 * g));
        const bf16x8 b = *(const LAS bf16x8*)(lds + bbase + toff(nblk * 16 + l15, ks * 32 + 8 * g));
        acc = __builtin_amdgcn_mfma_f32_16x16x32_bf16(a, b, acc, 0, 0, 0);
    }
    return acc;
}
__device__ __forceinline__ void tile_st(LAS char* lds, unsigned base, int n, int m0, f32x4 v) {
    u32x2 o; o.x = pk2(v[0], v[1]); o.y = pk2(v[2], v[3]);
    *(LAS u32x2*)(lds + base + toff(n, m0)) = o;
}

typedef short v4i16_t __attribute__((ext_vector_type(4)));
__device__ __forceinline__ bf16x8 frag_row(LAS char* lds, unsigned base, int blk, int ks, int l15, int g) {
    return *(const LAS bf16x8*)(lds + base + toff(blk * 16 + l15, ks * 32 + 8 * g));
}
__device__ __forceinline__ bf16x8 frag_tr(LAS char* lds, unsigned base, int blk, int ks, int l15, int g) {
    const int q = l15 >> 2, pp = l15 & 3;
    const v4i16_t v0 = __builtin_amdgcn_ds_read_tr16_b64_v4i16((LAS v4i16_t*)(lds + base + toff(ks * 32 + 8 * g + q, blk * 16 + 4 * pp)));
    const v4i16_t v1 = __builtin_amdgcn_ds_read_tr16_b64_v4i16((LAS v4i16_t*)(lds + base + toff(ks * 32 + 8 * g + 4 + q, blk * 16 + 4 * pp)));
    return (bf16x8){v0[0], v0[1], v0[2], v0[3], v1[0], v1[1], v1[2], v1[3]};
}
template <bool ATR, bool BTR>
__device__ __forceinline__ f32x4 tile_mm2(LAS char* lds, unsigned abase, unsigned bbase, int mblk, int nblk, int l15, int g, f32x4 acc, int nks) {
    for (int ks = 0; ks < nks; ++ks) {
        const bf16x8 a = ATR ? frag_tr(lds, abase, mblk, ks, l15, g) : frag_row(lds, abase, mblk, ks, l15, g);
        const bf16x8 b = BTR ? frag_tr(lds, bbase, nblk, ks, l15, g) : frag_row(lds, bbase, nblk, ks, l15, g);
        acc = __builtin_amdgcn_mfma_f32_16x16x32_bf16(a, b, acc, 0, 0, 0);
    }
    return acc;
}

__device__ __forceinline__ void ph_gate(CPar& p, LAS char* lds) {
    const int tid = otid();
    pg8::Gemm g{(const bf16_t*)(p.ws + WS_GL), (const bf16_t*)(p.ws + WS_G2T), T, D, 256}; pg8::StaticOrder S; S.init(T, D, (int)gridDim.x, (int)blockIdx.x);
    pg8::PEpiPlain E{(bf16_t*)(p.ws + WS_G)};
    pg8::gemm_phase<pg8::PEpiPlain, pg8::StaticOrder, true, true>(tid, (LAS unsigned char*)lds, g, S, E);
    __syncthreads();
}
__device__ __forceinline__ void ph_scan_prep(CPar& p, LAS char* lds) {
    const int tid0 = otid(), wv = tid0 >> 6;
    const bf16_t* R = (const bf16_t*)(p.ws + WS_R); const bf16_t* K2 = (const bf16_t*)(p.ws + WS_K2); const bf16_t* V2 = (const bf16_t*)(p.ws + WS_V2);
    const float* k_k = p.in[22]; const float* k_a = p.in[23]; const float* r_k = p.in[24];
    for (int u = blockIdx.x; u < NH * 128; u += gridDim.x) {
        int tid = tid0; asm volatile("" : "+v"(tid));
        const int lane = tid & 63, l15 = lane & 15, g = lane >> 4;
        const int h = u & 31, m = u >> 5;
        {
            const int z = wv >> 2, nblk = wv & 3;
            LAS char* ldz = lds + z * T_ZS;
            LAS float* LIN = (LAS float*)(ldz + T_LIN); LAS float* AS = (LAS float*)(ldz + T_AS); LAS float* lendp = (LAS float*)(lds + LDS_SEG) + z * 64;
            bf16x8 afr[2][4][3], bfr[2][3];
            float bias[2];
#pragma unroll
            for (int isa = 0; isa < 2; ++isa) {
                const bf16_t* lsrc = (const bf16_t*)(p.ws + (isa ? WS_LA : WS_LW)) + (size_t)z * 512 * 4 * 64 * 8;
                const bf16_t* wsrc = (const bf16_t*)(p.ws + (isa ? WS_A2T : WS_W2T)) + (size_t)z * D * 128 + ((size_t)(h * 4 + nblk) * 4 * 64 + g * 16 + l15) * 8;
                bias[isa] = (isa ? p.in[17] : p.in[14])[z * D + h * HD + nblk * 16 + l15];
#pragma unroll
                for (int ks = 0; ks < 3; ++ks) bfr[isa][ks] = *(const bf16x8*)(wsrc + ks * 512);
#pragma unroll
                for (int mblk = 0; mblk < 4; ++mblk) {
                    const int tb = m * 4 + (z ? 3 - mblk : mblk), r15 = z ? 15 - l15 : l15;
#pragma unroll
                    for (int ks = 0; ks < 3; ++ks) afr[isa][mblk][ks] = *(const bf16x8*)(lsrc + (((size_t)tb * 4 + ks) * 64 + g * 16 + r15) * 8);
                }
            }
            float carry = 0.f;
#pragma unroll
            for (int mblk = 0; mblk < 4; ++mblk) {
                f32x4 accw = {0.f, 0.f, 0.f, 0.f}, acca = {0.f, 0.f, 0.f, 0.f};
#pragma unroll
                for (int ks = 0; ks < 3; ++ks) { accw = __builtin_amdgcn_mfma_f32_16x16x32_bf16(afr[0][mblk][ks], bfr[0][ks], accw, 0, 0, 0); acca = __builtin_amdgcn_mfma_f32_16x16x32_bf16(afr[1][mblk][ks], bfr[1][ks], acca, 0, 0, 0); }
                float o[4], oa[4];
#pragma unroll
                for (int e = 0; e < 4; ++e) {
                    oa[e] = sigmoidf_(acca[e] + bias[1]);
                    o[e] = -0.60653066f * sigmoidf_(accw[e] + bias[0]);
                }
                o[1] += o[0]; o[2] += o[1]; o[3] += o[2];
                const float tot = o[3];
                const float u1 = __shfl_up(tot, 16); const float s2 = tot + (g >= 1 ? u1 : 0.f);
                const float u2 = __shfl_up(s2, 32); const float incl = s2 + (g >= 2 ? u2 : 0.f);
                const float tt = __shfl(incl, 48 + l15);
                const float base = carry + incl - tot;
                carry += tt;
#pragma unroll
                for (int e = 0; e < 4; ++e) { LIN[(mblk * 16 + 4 * g + e) * 64 + nblk * 16 + l15] = o[e] + base; AS[(mblk * 16 + 4 * g + e) * 64 + nblk * 16 + l15] = oa[e]; }
            }
            if (g == 0) lendp[nblk * 16 + l15] = carry;
        }
        __syncthreads();
        {
            const int tau = tid >> 3, cg = tid & 7, c0 = h * HD + cg * 8;
            const int t = m * 64 + tau; const size_t o = (size_t)t * D + c0;
            const u32x4 kw = *(const u32x4*)(K2 + o), rw = *(const u32x4*)(R + o), vw = *(const u32x4*)(V2 + o);
            float kx[8], rx[8], kk[8], kac[8], rkc[8];
            float n2 = 0.f;
#pragma unroll
            for (int q4 = 0; q4 < 2; ++q4) {
                const f32x4 k4 = *(const f32x4*)(k_k + c0 + q4 * 4), ka4 = *(const f32x4*)(k_a + c0 + q4 * 4), rk4 = *(const f32x4*)(r_k + c0 + q4 * 4);
#pragma unroll
                for (int e = 0; e < 4; ++e) {
                    const int j = q4 * 4 + e; const unsigned kwj = kw[j >> 1], rwj = rw[j >> 1];
                    kx[j] = (j & 1) ? bfhi(kwj) : bflo(kwj); rx[j] = (j & 1) ? bfhi(rwj) : bflo(rwj);
                    kk[j] = kx[j] * k4[e]; n2 += kk[j] * kk[j]; kac[j] = ka4[e]; rkc[j] = rk4[e];
                }
            }
            n2 = sum8(n2);
            const float rn = __builtin_amdgcn_rcpf(fmaxf(sqrtf(n2), 1e-12f));
#pragma unroll
            for (int j = 0; j < 8; ++j) kk[j] *= rn;
#pragma unroll
            for (int z = 0; z < 2; ++z) {
                LAS char* ldz = lds + z * T_ZS;
                LAS float* LIN = (LAS float*)(ldz + T_LIN); LAS float* AS = (LAS float*)(ldz + T_AS); LAS float* lendp = (LAS float*)(lds + LDS_SEG) + z * 64;
                LAS float* elend = (LAS float*)(lds + LDS_ELEND) + z * 64;
                float* sbon = (float*)(p.ws + WS_SBON) + (size_t)z * T * NH;
                const int sidx = z ? 63 - tau : tau;
                float lin[8], lex[8], av[8];
#pragma unroll
                for (int q4 = 0; q4 < 2; ++q4) {
                    const f32x4 a4 = *(const LAS f32x4*)(AS + sidx * 64 + cg * 8 + q4 * 4), l4 = *(const LAS f32x4*)(LIN + sidx * 64 + cg * 8 + q4 * 4);
                    f32x4 p4 = {0.f, 0.f, 0.f, 0.f};
                    if (sidx > 0) p4 = *(const LAS f32x4*)(LIN + (sidx - 1) * 64 + cg * 8 + q4 * 4);
#pragma unroll
                    for (int e = 0; e < 4; ++e) { av[q4 * 4 + e] = a4[e]; lin[q4 * 4 + e] = l4[e]; lex[q4 * 4 + e] = p4[e]; }
                }
                float kd[8], sb = 0.f;
#pragma unroll
                for (int j = 0; j < 8; ++j) { kd[j] = kx[j] * (1.f + (av[j] - 1.f) * kac[j]); sb += rx[j] * kd[j] * rkc[j]; }
                sb = sum8(sb);
                if (cg == 0) sbon[(size_t)h * T + t] = sb;
                float aq[8], rq[8], bk[8], kq[8];
#pragma unroll
                for (int j = 0; j < 8; ++j) {
                    const float b = kk[j] * av[j];
                    const float elin = __expf(lin[j]), elex = __expf(lex[j]), enl = __expf(-lin[j]);
                    aq[j] = -kk[j] * elex; bk[j] = b * enl; kq[j] = kd[j] * enl; rq[j] = rx[j] * elin;
                }
                const unsigned wo = toff(sidx, cg * 8);
                *(LAS u32x4*)(ldz + T_AQ + wo) = (u32x4){pk2(aq[0], aq[1]), pk2(aq[2], aq[3]), pk2(aq[4], aq[5]), pk2(aq[6], aq[7])};
                *(LAS u32x4*)(ldz + T_RQ + wo) = (u32x4){pk2(rq[0], rq[1]), pk2(rq[2], rq[3]), pk2(rq[4], rq[5]), pk2(rq[6], rq[7])};
                *(LAS u32x4*)(ldz + T_BK + wo) = (u32x4){pk2(bk[0], bk[1]), pk2(bk[2], bk[3]), pk2(bk[4], bk[5]), pk2(bk[6], bk[7])};
                *(LAS u32x4*)(ldz + T_KK + wo) = (u32x4){pk2(kq[0], kq[1]), pk2(kq[2], kq[3]), pk2(kq[4], kq[5]), pk2(kq[6], kq[7])};
                *(LAS u32x4*)(ldz + T_V + wo) = vw;
                if (tau == 0) {
#pragma unroll
                    for (int q4 = 0; q4 < 2; ++q4) { const f32x4 e4 = *(const LAS f32x4*)(lendp + cg * 8 + q4 * 4);
#pragma unroll
                        for (int e = 0; e < 4; ++e) elend[cg * 8 + q4 * 4 + e] = __expf(e4[e]); }
                }
            }
        }
        __syncthreads();
        {
            const int wvs = __builtin_amdgcn_readfirstlane(wv), z = wvs >> 2, pid = wvs & 3;
            LAS char* ldz = lds + z * T_ZS;
            const unsigned ab = (pid & 1) ? T_KK : T_BK, bb = pid < 2 ? T_AQ : T_RQ;
            const unsigned db = pid == 0 ? T_L : (pid == 1 ? T_MAK : (pid == 2 ? T_MRB : T_MRK));
            const int strict = pid < 2 ? 1 : 0;
#pragma unroll
            for (int nblk = 0; nblk < 4; ++nblk)
#pragma unroll
                for (int mblk = 0; mblk < 4; ++mblk) {
                    f32x4 acc = {0.f, 0.f, 0.f, 0.f};
                    if (mblk <= nblk) {
                        acc = tile_mm(ldz, ab, bb, mblk, nblk, l15, g, acc, 2);
                        if (mblk == nblk) {
                            const int n = l15, m0 = 4 * g;
#pragma unroll
                            for (int e = 0; e < 4; ++e) acc[e] = (m0 + e + strict <= n) ? acc[e] : 0.f;
                            if (pid == 0) *(LAS f32x4*)(ldz + T_DL + ((nblk * 16 + l15) * 16 + 4 * g) * 4) = acc;
                        }
                    }
                    tile_st(ldz, db, nblk * 16 + l15, mblk * 16 + 4 * g, acc);
                }
        }
        __syncthreads();
        f32x4 xacc[2][4];
        const int wcol = (wv & 3) * 16 + l15;
#pragma unroll
        for (int z = 0; z < 2; ++z) {
            LAS char* ldz = lds + z * T_ZS;
            if (wv >= 4) {
#pragma unroll
                for (int sb = 0; sb < 4; ++sb) {
                    f32x4 acc = {0.f, 0.f, 0.f, 0.f};
                    xacc[z][sb] = tile_mm2<false, true>(ldz, T_MAK, T_V, sb, wv - 4, l15, g, acc, sb < 2 ? 1 : 2);
                }
            } else {
#pragma unroll
                for (int sb = 0; sb < 4; ++sb) {
                    const v4i16_t w = __builtin_amdgcn_ds_read_tr16_b64_v4i16((LAS v4i16_t*)(ldz + T_AQ + toff(sb * 16 + 4 * g + (l15 >> 2), (wv & 3) * 16 + 4 * (l15 & 3))));
                    xacc[z][sb] = (f32x4){bf2f((bf16_t)w[0]), bf2f((bf16_t)w[1]), bf2f((bf16_t)w[2]), bf2f((bf16_t)w[3])};
                }
            }
        }
        if (wv < 2) {
            LAS char* ldz = lds + wv * T_ZS;
            float tc[16];
#pragma unroll
            for (int r = 0; r < 16; ++r) {
                float v = (r == l15) ? 1.f : 0.f;
#pragma unroll
                for (int q4 = 0; q4 < (r + 3) / 4; ++q4) {
                    const f32x4 lr = *(const LAS f32x4*)(ldz + T_DL + ((g * 16 + r) * 16 + q4 * 4) * 4);
#pragma unroll
                    for (int e = 0; e < 4; ++e) if (q4 * 4 + e < r) v += lr[e] * tc[q4 * 4 + e];
                }
                tc[r] = v;
                *(LAS bf16_t*)(ldz + T_TII + ((g * 16 + r) * 16 + l15) * 2) = (bf16_t)f2bf(v);
            }
        }
        __syncthreads();
#pragma unroll
        for (int z = 0; z < 2; ++z) {
            LAS char* ldz = lds + z * T_ZS;
            const unsigned wbase = (wv < 4 ? T_W0A : T_W0B);
            unsigned wp[4][2];
#pragma unroll
            for (int i = 0; i < 4; ++i) {
                f32x4 r = xacc[z][i];
                if (i >= 1) {
                    const u32x2 l0 = *(const LAS u32x2*)(ldz + T_L + toff(i * 16 + l15, 4 * g));
                    u32x2 l1 = {0u, 0u};
                    if (i >= 2) l1 = *(const LAS u32x2*)(ldz + T_L + toff(i * 16 + l15, 16 + 4 * g));
                    const u32x4 aw = {l0.x, l0.y, l1.x, l1.y};
                    const u32x4 bw = {wp[0][0], wp[0][1], i >= 2 ? wp[1][0] : 0u, i >= 2 ? wp[1][1] : 0u};
                    r = __builtin_amdgcn_mfma_f32_16x16x32_bf16(__builtin_bit_cast(bf16x8, aw), __builtin_bit_cast(bf16x8, bw), r, 0, 0, 0);
                }
                if (i == 3) {
                    const u32x2 l2 = *(const LAS u32x2*)(ldz + T_L + toff(48 + l15, 32 + 4 * g));
                    const u32x4 aw = {l2.x, l2.y, 0u, 0u};
                    const u32x4 bw = {wp[2][0], wp[2][1], 0u, 0u};
                    r = __builtin_amdgcn_mfma_f32_16x16x32_bf16(__builtin_bit_cast(bf16x8, aw), __builtin_bit_cast(bf16x8, bw), r, 0, 0, 0);
                }
                const u32x2 tw = *(const LAS u32x2*)(ldz + T_TII + ((i * 16 + l15) * 16 + 4 * g) * 2);
                const u32x4 aw = {tw.x, tw.y, 0u, 0u};
                const u32x4 bw = {pk2(r[0], r[1]), pk2(r[2], r[3]), 0u, 0u};
                f32x4 w = {0.f, 0.f, 0.f, 0.f};
                w = __builtin_amdgcn_mfma_f32_16x16x32_bf16(__builtin_bit_cast(bf16x8, aw), __builtin_bit_cast(bf16x8, bw), w, 0, 0, 0);
                wp[i][0] = pk2(w[0], w[1]); wp[i][1] = pk2(w[2], w[3]);
                *(LAS u32x2*)(ldz + wbase + toff(wcol, i * 16 + 4 * g)) = (u32x2){wp[i][0], wp[i][1]};
            }
        }
        __syncthreads();
#pragma unroll
        for (int z = 0; z < 2; ++z) {
            LAS char* ldz = lds + z * T_ZS;
            LAS float* elend = (LAS float*)(lds + LDS_ELEND) + z * 64;
            const int cc = z ? 127 - m : m;
            const size_t uc = ((size_t)(z * NH + h) * 128 + cc) * 4096, um = ((size_t)(z * NH + h) * 128 + m) * 4096;
            bf16_t* GB = (bf16_t*)(p.ws + WS_GB) + uc; bf16_t* FB = (bf16_t*)(p.ws + WS_FB) + uc;
            bf16_t* GYB = (bf16_t*)(p.ws + WS_GYB) + um; bf16_t* FYB = (bf16_t*)(p.ws + WS_FYB) + um;
#pragma unroll
            for (int i = 0; i < 2; ++i) {
                const int mblk = 2 * i + (wv >> 2), nblk = wv & 3;
                const int n = nblk * 16 + l15, m0 = mblk * 16 + 4 * g;
                {
                    f32x4 acc = {0.f, 0.f, 0.f, 0.f};
                    acc = tile_mm2<false, true>(ldz, T_W0A, T_BK, mblk, nblk, l15, g, acc, 2);
                    const float el = elend[n];
#pragma unroll
                    for (int e = 0; e < 4; ++e) acc[e] = (acc[e] + (m0 + e == n ? 1.f : 0.f)) * el;
                    u32x2 o; o.x = pk2(acc[0], acc[1]); o.y = pk2(acc[2], acc[3]);
                    __builtin_nontemporal_store(o, (u32x2*)(GB + ((nblk * 4 + mblk) * 64 + lane) * 4));
                }
                {
                    f32x4 acc = {0.f, 0.f, 0.f, 0.f};
                    acc = tile_mm2<true, false>(ldz, T_BK, T_W0B, mblk, nblk, l15, g, acc, 2);
                    acc = tile_mm2<true, true>(ldz, T_KK, T_V, mblk, nblk, l15, g, acc, 2);
                    const f32x4 el4 = *(const LAS f32x4*)(elend + m0);
                    u32x2 o; o.x = pk2(acc[0] * el4[0], acc[1] * el4[1]); o.y = pk2(acc[2] * el4[2], acc[3] * el4[3]);
                    __builtin_nontemporal_store(o, (u32x2*)(FB + ((nblk * 4 + mblk) * 64 + lane) * 4));
                }
                {
                    const int mbg = wv & 3, nbg = 2 * i + (wv >> 2), ng = nbg * 16 + l15, mg0 = mbg * 16 + 4 * g;
                    f32x4 acc = {0.f, 0.f, 0.f, 0.f};
                    acc = tile_mm(ldz, T_W0A, T_MRB, mbg, nbg, l15, g, acc, i == 0 ? 1 : 2);
                    const u32x2 rq = *(const LAS u32x2*)(ldz + T_RQ + toff(ng, mg0));
                    acc[0] += bflo(rq.x); acc[1] += bfhi(rq.x); acc[2] += bflo(rq.y); acc[3] += bfhi(rq.y);
                    u32x2 o; o.x = pk2(acc[0], acc[1]); o.y = pk2(acc[2], acc[3]);
                    __builtin_nontemporal_store(o, (u32x2*)(GYB + (z ? (((3 - nbg) * 4 + mbg) * 64 + g * 16 + 15 - l15) : ((nbg * 4 + mbg) * 64 + lane)) * 4));
                }
                {
                    f32x4 acc = {0.f, 0.f, 0.f, 0.f};
                    acc = tile_mm(ldz, T_MRB, T_W0B, mblk, nblk, l15, g, acc, i == 0 ? 1 : 2);
                    acc = tile_mm2<false, true>(ldz, T_MRK, T_V, mblk, nblk, l15, g, acc, i == 0 ? 1 : 2);
                    u32x2 o;
                    if (z) { o.x = pk2(acc[3], acc[2]); o.y = pk2(acc[1], acc[0]); __builtin_nontemporal_store(o, (u32x2*)(FYB + ((nblk * 4 + (3 - mblk)) * 64 + (3 - g) * 16 + l15) * 4)); }
                    else { o.x = pk2(acc[0], acc[1]); o.y = pk2(acc[2], acc[3]); __builtin_nontemporal_store(o, (u32x2*)(FYB + ((nblk * 4 + mblk) * 64 + lane) * 4)); }
                }
            }
        }
        lds_barrier();
    }
}

__device__ __forceinline__ void ph_scan_state(CPar& p, LAS char* lds) {
    const int tid = otid(), lane = tid & 63, wv = tid >> 6;
    for (int u = blockIdx.x; u < 256; u += gridDim.x) {
        const int zh = (u & 7) * 8 + (u >> 5), vq = (u >> 3) & 3;
        const bf16_t* GB = (const bf16_t*)(p.ws + WS_GB) + (size_t)zh * 128 * 4096;
        const bf16_t* FB = (const bf16_t*)(p.ws + WS_FB) + (size_t)zh * 128 * 4096;
        bf16_t* HS = (bf16_t*)(p.ws + WS_HS) + (size_t)zh * 128 * 4096;
        if (wv == 0) {
            f32x4 acc[4];
#pragma unroll
            for (int mt = 0; mt < 4; ++mt) acc[mt] = (f32x4){0.f, 0.f, 0.f, 0.f};
#define SCAN_STEP(half_, k_, cidx) do { \
            const LAS char* gl = lds + (half_) * 40960 + (k_) * 8192 + lane * 8; \
            const LAS char* fl = lds + (half_) * 40960 + 32768 + (k_) * 2048 + lane * 8; \
            bf16_t* hp = HS + (size_t)(cidx) * 4096 + (vq * 4 * 64 + lane) * 4; \
            u32x2 hb[4]; \
            _Pragma("unroll") for (int mt = 0; mt < 4; ++mt) { hb[mt].x = pk2(acc[mt][0], acc[mt][1]); hb[mt].y = pk2(acc[mt][2], acc[mt][3]); *(u32x2*)(hp + mt * 256) = hb[mt]; } \
            bf16x8 bfr[2]; \
            _Pragma("unroll") for (int ks = 0; ks < 2; ++ks) { u32x4 w = {hb[2 * ks].x, hb[2 * ks].y, hb[2 * ks + 1].x, hb[2 * ks + 1].y}; bfr[ks] = __builtin_bit_cast(bf16x8, w); } \
            _Pragma("unroll") for (int mt = 0; mt < 4; ++mt) { \
                const u32x2 F_ = *(const LAS u32x2*)(fl + mt * 512); \
                f32x4 a = {bflo(F_.x), bfhi(F_.x), bflo(F_.y), bfhi(F_.y)}; \
                _Pragma("unroll") for (int ks = 0; ks < 2; ++ks) { \
                    const u32x2 p0 = *(const LAS u32x2*)(gl + (mt * 4 + 2 * ks) * 512), p1 = *(const LAS u32x2*)(gl + (mt * 4 + 2 * ks + 1) * 512); \
                    u32x4 w = {p0.x, p0.y, p1.x, p1.y}; \
                    a = __builtin_amdgcn_mfma_f32_16x16x32_bf16(__builtin_bit_cast(bf16x8, w), bfr[ks], a, 0, 0, 0); } \
                acc[mt] = a; } } while (0)
            __builtin_amdgcn_s_setprio(3);
            lds_barrier();
            for (int b = 0; b < 32; b += 2) {
                SCAN_STEP(0, 0, b * 4 + 0); SCAN_STEP(0, 1, b * 4 + 1); SCAN_STEP(0, 2, b * 4 + 2); SCAN_STEP(0, 3, b * 4 + 3);
                lds_barrier();
                SCAN_STEP(1, 0, b * 4 + 4); SCAN_STEP(1, 1, b * 4 + 5); SCAN_STEP(1, 2, b * 4 + 6); SCAN_STEP(1, 3, b * 4 + 7);
                lds_barrier();
            }
            __builtin_amdgcn_s_setprio(0);
#undef SCAN_STEP
        } else {
            const int lt = tid - 64;
            const bf16_t* src[6]; unsigned dst[6];
#pragma unroll
            for (int j = 0; j < 6; ++j) {
                int idx = j * 448 + lt; idx = idx < 2559 ? idx : 2559;
                const int f = idx - 2048;
                src[j] = idx < 2048 ? GB + idx * 8 : FB + (size_t)(f >> 7) * 4096 + vq * 1024 + (f & 127) * 8;
                dst[j] = idx < 2048 ? (unsigned)idx * 16u : 32768u + (unsigned)f * 16u;
            }
            u32x4 sa[6], sb[6], sc[6], sd[6];
#define ST_LD(S_, b_) do { const size_t bo = (size_t)((b_) < 31 ? (b_) : 31) * 16384; _Pragma("unroll") for (int j = 0; j < 6; ++j) S_[j] = j == 5 ? __builtin_nontemporal_load((const u32x4*)(src[j] + bo)) : *(const u32x4*)(src[j] + bo); } while (0)
#define ST_ST(S_, half_) do { _Pragma("unroll") for (int j = 0; j < 6; ++j) *(LAS u32x4*)(lds + (half_) * 40960 + dst[j]) = S_[j]; } while (0)
            ST_LD(sa, 0); ST_LD(sb, 1); ST_LD(sc, 2); ST_LD(sd, 3);
            ST_ST(sa, 0); ST_LD(sa, 4);
            lds_barrier();
            for (int b = 0; b < 24; b += 4) {
                ST_ST(sb, 1); ST_LD(sb, b + 5); lds_barrier();
                ST_ST(sc, 0); ST_LD(sc, b + 6); lds_barrier();
                ST_ST(sd, 1); ST_LD(sd, b + 7); lds_barrier();
                ST_ST(sa, 0); ST_LD(sa, b + 8); lds_barrier();
            }
            ST_ST(sb, 1); ST_LD(sb, 29); lds_barrier();
            ST_ST(sc, 0); ST_LD(sc, 30); lds_barrier();
            ST_ST(sd, 1); ST_LD(sd, 31); lds_barrier();
            ST_ST(sa, 0); lds_barrier();
            ST_ST(sb, 1); lds_barrier();
            ST_ST(sc, 0); lds_barrier();
            ST_ST(sd, 1); lds_barrier();
            lds_barrier();
#undef ST_LD
#undef ST_ST
        }
    }
}

__device__ __forceinline__ void ph_scan_out(CPar& p, LAS char* lds) {
    const int tid = otid(), lane = tid & 63, wv = tid >> 6, l15 = lane & 15, g = lane >> 4;
    const bf16_t* V2 = (const bf16_t*)(p.ws + WS_V2); const bf16_t* G = (const bf16_t*)(p.ws + WS_G); bf16_t* Z = (bf16_t*)(p.ws + WS_Z);
    const float* sbon = (const float*)(p.ws + WS_SBON); const float* lw = p.in[25]; const float* lb = p.in[26];
    const int wz = wv >> 2, wa = (wv >> 1) & 1, wbp = wv & 1, tk = tid >> 3, cg = tid & 7;
    const int NU = NH * 128, GS = gridDim.x;
    u32x2 Af[2][2], Aa[2][2][2], Ab[2][2][2];
    struct BSet { u32x4 vw, gw; f32x4 w0, w1, b0, b1; float s0, s1; };
    BSet B0, B1;
#define OUT_LOADA(u_) do { const int h_ = (u_) & 31, m_ = (u_) >> 5; const int cc = wz ? 127 - m_ : m_; \
        const bf16_t* gy = (const bf16_t*)(p.ws + WS_GYB) + ((size_t)(wz * NH + h_) * 128 + m_) * 4096; \
        const bf16_t* fy = (const bf16_t*)(p.ws + WS_FYB) + ((size_t)(wz * NH + h_) * 128 + m_) * 4096; \
        const bf16_t* hs = (const bf16_t*)(p.ws + WS_HS) + ((size_t)(wz * NH + h_) * 128 + cc) * 4096; \
        _Pragma("unroll") for (int i = 0; i < 2; ++i) { const int sb = wa * 2 + i; \
            _Pragma("unroll") for (int j = 0; j < 2; ++j) Af[i][j] = __builtin_nontemporal_load((const u32x2*)(fy + (((wbp * 2 + j) * 4 + sb) * 64 + lane) * 4)); \
            _Pragma("unroll") for (int ks = 0; ks < 2; ++ks) { \
                const bf16_t* gyp = gy + ((sb * 4 + 2 * ks + (g >> 1)) * 64 + (2 * (g & 1)) * 16 + l15) * 4;        \
                Aa[i][ks][0] = __builtin_nontemporal_load((const u32x2*)gyp); Aa[i][ks][1] = __builtin_nontemporal_load((const u32x2*)(gyp + 64)); \
                const bf16_t* hsp = hs + (((wbp * 2 + i) * 4 + 2 * ks + (g >> 1)) * 64 + (2 * (g & 1)) * 16 + l15) * 4;        \
                Ab[i][ks][0] = __builtin_nontemporal_load((const u32x2*)hsp); Ab[i][ks][1] = __builtin_nontemporal_load((const u32x2*)(hsp + 64)); } } } while (0)
#define OUT_LOADB(S_, u_) do { const int h_ = (u_) & 31, m_ = (u_) >> 5, t_ = m_ * 64 + tk, c0_ = h_ * HD + cg * 8; const size_t o_ = (size_t)t_ * D + c0_; \
        S_.vw = __builtin_nontemporal_load((const u32x4*)(V2 + o_)); S_.gw = __builtin_nontemporal_load((const u32x4*)(G + o_)); \
        S_.s0 = sbon[(size_t)h_ * T + t_]; S_.s1 = sbon[(size_t)T * NH + (size_t)h_ * T + t_]; \
        S_.w0 = *(const LAS f32x4*)(llw + c0_); S_.w1 = *(const LAS f32x4*)(llw + c0_ + 4); S_.b0 = *(const LAS f32x4*)(llb + c0_); S_.b1 = *(const LAS f32x4*)(llb + c0_ + 4); } while (0)
#define OUT_MMA(yt_) do { LAS float* yz_ = (yt_) + wz * 4096; \
        _Pragma("unroll") for (int i = 0; i < 2; ++i) { const int sb = wa * 2 + i; \
            _Pragma("unroll") for (int j = 0; j < 2; ++j) { const int vb = wbp * 2 + j; \
                const u32x2 f = Af[i][j]; \
                f32x4 acc = {bflo(f.x), bfhi(f.x), bflo(f.y), bfhi(f.y)}; \
                _Pragma("unroll") for (int ks = 0; ks < 2; ++ks) { \
                    const bf16x8 a = __builtin_bit_cast(bf16x8, (u32x4){Aa[i][ks][0].x, Aa[i][ks][0].y, Aa[i][ks][1].x, Aa[i][ks][1].y}); \
                    const bf16x8 bq = __builtin_bit_cast(bf16x8, (u32x4){Ab[j][ks][0].x, Ab[j][ks][0].y, Ab[j][ks][1].x, Ab[j][ks][1].y}); \
                    acc = __builtin_amdgcn_mfma_f32_16x16x32_bf16(a, bq, acc, 0, 0, 0); } \
                _Pragma("unroll") for (int e = 0; e < 4; ++e) yz_[(sb * 16 + 4 * g + e) * 64 + vb * 16 + l15] = acc[e]; } } } while (0)
#define OUT_NORM(S_, u_, yt_) do { const int h_ = (u_) & 31, m_ = (u_) >> 5, t_ = m_ * 64 + tk, c0_ = h_ * HD + cg * 8; const size_t o_ = (size_t)t_ * D + c0_; \
        const float sbv = S_.s0 + S_.s1; \
        const f32x4 y0 = *(const LAS f32x4*)(yt_ + tk * 64 + cg * 8) + *(const LAS f32x4*)(yt_ + 4096 + tk * 64 + cg * 8), y1 = *(const LAS f32x4*)(yt_ + tk * 64 + cg * 8 + 4) + *(const LAS f32x4*)(yt_ + 4096 + tk * 64 + cg * 8 + 4); \
        float sum = y0[0] + y0[1] + y0[2] + y0[3] + y1[0] + y1[1] + y1[2] + y1[3]; \
        sum = sum8(sum); \
        const float mu = sum * (1.f / 64.f); \
        float yv[8], wv8[8], bv8[8], gv[8], vv[8]; \
        _Pragma("unroll") for (int e = 0; e < 4; ++e) { yv[e] = y0[e] - mu; yv[4 + e] = y1[e] - mu; wv8[e] = S_.w0[e]; wv8[4 + e] = S_.w1[e]; bv8[e] = S_.b0[e]; bv8[4 + e] = S_.b1[e]; } \
        _Pragma("unroll") for (int j = 0; j < 8; ++j) gv[j] = (j & 1) ? bfhi(S_.gw[j >> 1]) : bflo(S_.gw[j >> 1]); \
        _Pragma("unroll") for (int j = 0; j < 8; ++j) vv[j] = (j & 1) ? bfhi(S_.vw[j >> 1]) : bflo(S_.vw[j >> 1]); \
        float sq = 0.f; \
        _Pragma("unroll") for (int j = 0; j < 8; ++j) sq += yv[j] * yv[j]; \
        sq = sum8(sq); \
        const float rs = rsqrtf(sq * (1.f / 64.f) + 64e-5f); \
        float ov[8]; \
        _Pragma("unroll") for (int j = 0; j < 8; ++j) ov[j] = (yv[j] * rs * wv8[j] + bv8[j] + sbv * vv[j]) * gv[j]; \
        u32x4 pw; pw.x = pk2(ov[0], ov[1]); pw.y = pk2(ov[2], ov[3]); pw.z = pk2(ov[4], ov[5]); pw.w = pk2(ov[6], ov[7]); \
        __builtin_nontemporal_store(pw, (u32x4*)(Z + o_)); } while (0)
    LAS float* yt0 = (LAS float*)lds; LAS float* yt1 = yt0 + 8192;
    LAS float* llw = yt0 + 16384; LAS float* llb = llw + D;
    for (int i = tid; i < D / 4; i += NTHR) { *(LAS f32x4*)(llw + i * 4) = *(const f32x4*)(lw + i * 4); *(LAS f32x4*)(llb + i * 4) = *(const f32x4*)(lb + i * 4); }
    __syncthreads();
    int u = blockIdx.x;
    if (u < NU) { OUT_LOADA(u); OUT_LOADB(B0, u); }
    for (; u < NU; u += 2 * GS) {
        OUT_MMA(yt0);
        const int u1 = u + GS;
        if (u1 < NU) { OUT_LOADA(u1); OUT_LOADB(B1, u1); }
        lds_barrier();
        OUT_NORM(B0, u, yt0);
        if (u1 >= NU) break;
        OUT_MMA(yt1);
        const int u2 = u1 + GS;
        if (u2 < NU) { OUT_LOADA(u2); OUT_LOADB(B0, u2); }
        lds_barrier();
        OUT_NORM(B1, u1, yt1);
    }
#undef OUT_LOADA
#undef OUT_LOADB
#undef OUT_MMA
#undef OUT_NORM
}

__device__ __forceinline__ void ph_final(CPar& p, LAS char* lds) {
    const int tid = otid(), lane = tid & 63, gw = blockIdx.x * 8 + (tid >> 6), nw = gridDim.x * 8;
    float* h3 = p.out; const bf16_t* y = (const bf16_t*)(p.ws + WS_Y); const float* g = p.in[3];
    LAS float* lg = (LAS float*)lds;
    for (int i = tid; i < D / 4; i += NTHR) *(LAS f32x4*)(lg + i * 4) = *(const f32x4*)(g + i * 4);
    __syncthreads();
    for (int t = gw; t < T; t += nw) {
        f32x4 x[8]; float ss = 0.f;
#pragma unroll
        for (int j = 0; j < 8; ++j) {
            const int d0 = (j * 64 + lane) * 4;
            x[j] = __builtin_nontemporal_load((const f32x4*)(h3 + (size_t)t * D + d0));
            const u32x2 a = __builtin_nontemporal_load((const u32x2*)(y + (size_t)(2 * t) * D + d0)), b = __builtin_nontemporal_load((const u32x2*)(y + (size_t)(2 * t + 1) * D + d0));
            x[j][0] += bflo(a.x) + bflo(b.x); x[j][1] += bfhi(a.x) + bfhi(b.x); x[j][2] += bflo(a.y) + bflo(b.y); x[j][3] += bfhi(a.y) + bfhi(b.y);
            ss += x[j][0] * x[j][0] + x[j][1] * x[j][1] + x[j][2] * x[j][2] + x[j][3] * x[j][3];
        }
        ss = wave_sum(ss);
        const float inv = rsqrtf(ss * (1.f / D) + 1e-6f);
#pragma unroll
        for (int j = 0; j < 8; ++j) {
            const int d0 = (j * 64 + lane) * 4;
            const f32x4 gv = *(const LAS f32x4*)(lg + d0);
            f32x4 o = {x[j][0] * inv * gv[0], x[j][1] * inv * gv[1], x[j][2] * inv * gv[2], x[j][3] * inv * gv[3]};
            __builtin_nontemporal_store(o, (f32x4*)(h3 + (size_t)t * D + d0));
        }
    }
}

constexpr int NPH = 19;
extern __shared__ __attribute__((aligned(16))) char smem[];
__global__ void __launch_bounds__(NTHR, 2) fwd(Params p_unused, int lo, int hi) {
    LAS char* lds = (LAS char*)smem;
    CPar* pp = (CPar*)__builtin_amdgcn_kernarg_segment_ptr();
    if (threadIdx.x == 0) *(LAS u32x4*)(lds + LDS_XB) = (u32x4){0u, 0u, 0u, 0u};
    __syncthreads();
    XcdBarrier bar;
    const bool multi = (hi - lo) > 1;
    if (multi) bar = xcd_barrier_post((unsigned*)(pp->ws + WS_CTL) + CW_BAR, (volatile LAS unsigned*)(lds + LDS_XB));
#define IN(k) (lo <= (k) && (k) < hi)
#define SEAM(k) do { if (IN(k) && IN((k) + 1)) xcd_barrier(bar); } while (0)
#define PHASE(k, call) do { if (IN(k)) { asm volatile("" : "+s"(pp)); CPar& p = *pp; call; } } while (0)
    PHASE(0, ph_prologue(p, lds));
    SEAM(0);
    PHASE(1, ph_qkv(p, lds));
    SEAM(1);
    PHASE(2, ph_attn(p, lds));
    SEAM(2);
    PHASE(3, ph_oproj<false>(p, lds, (const bf16_t*)(p.ws + WS_AO), (const bf16_t*)(p.ws + WS_WONA), p.in[8], p.in[0], p.out));
    SEAM(3);
    PHASE(4, ph_router(p, lds, p.out, 0));
    SEAM(4);
    PHASE(6, ph_moe(p, lds, 0));
    SEAM(6);
    PHASE(7, ph_combine_mix(p, lds));
    SEAM(7);
    PHASE(9, ph_rwkv_proj(p, lds));
    SEAM(9);
    PHASE(11, ph_gate(p, lds));
    PHASE(11, ph_scan_prep(p, lds));
    SEAM(11);
    PHASE(12, ph_scan_state(p, lds));
    SEAM(12);
    PHASE(13, ph_scan_out(p, lds));
    SEAM(13);
    PHASE(14, ph_oproj<true>(p, lds, (const bf16_t*)(p.ws + WS_Z), (const bf16_t*)(p.ws + WS_WORW), nullptr, (const float*)(p.ws + WS_HB), p.out));
    SEAM(14);
    PHASE(15, ph_router(p, lds, p.out, 1));
    SEAM(15);
    PHASE(17, ph_moe(p, lds, 1));
    SEAM(17);
    PHASE(18, ph_final(p, lds));
}

extern "C" void kernel_launch(void* const* d_in, const int* in_sizes, int n_in, void* d_out, int out_size, void* d_ws, size_t ws_size, hipStream_t stream) {
    static int grid = 0;
    if (grid == 0) {
        if (n_in != 34 || out_size != T * D || ws_size < WS_END) { fprintf(stderr, "kernel_launch: unexpected shapes (n_in %d out %d ws %zu)\n", n_in, out_size, ws_size); grid = -1; return; }
        int dev = 0, cus = 0, per_cu = 0;
        if (hipGetDevice(&dev) != hipSuccess || hipDeviceGetAttribute(&cus, hipDeviceAttributeMultiprocessorCount, dev) != hipSuccess) { grid = -1; return; }
        if (hipFuncSetAttribute((const void*)fwd, hipFuncAttributeMaxDynamicSharedMemorySize, LDS_BYTES) != hipSuccess) { fprintf(stderr, "kernel_launch: hipFuncSetAttribute failed\n"); grid = -1; return; }
        if (hipOccupancyMaxActiveBlocksPerMultiprocessor(&per_cu, (const void*)fwd, NTHR, LDS_BYTES) != hipSuccess || per_cu < 1) { fprintf(stderr, "kernel_launch: occupancy query failed (%d)\n", per_cu); grid = -1; return; }
        if (cus < 256) { fprintf(stderr, "kernel_launch: built for a 256-CU device (got %d)\n", cus); grid = -1; return; }
        grid = 256;
    }
    if (grid < 0) return;
    (void)hipMemsetAsync((char*)d_ws + WS_CTL, 0, 128 * 1024, stream);
    Params p{};
    for (int i = 0; i < 34; ++i) p.in[i] = (const float*)d_in[i];
    p.out = (float*)d_out; p.ws = (unsigned char*)d_ws;
#if MK_FUSED
    hipLaunchKernelGGL(fwd, dim3(grid), dim3(NTHR), LDS_BYTES, stream, p, 0, NPH);
#else
    for (int k = 0; k < NPH; ++k) hipLaunchKernelGGL(fwd, dim3(grid), dim3(NTHR), LDS_BYTES, stream, p, k, k + 1);
#endif
}
```
